# Optimizing an MI355X kernel written in HIP

```python
import math
import jax, jax.numpy as jnp
from jax import lax
import numpy as np

D_MODEL = 2048
BATCH = 2
SEQ = 8192
DEPTH = 2

GRID_W = 64
CTX_LEN = 256
Q_BLOCK = 128
ROPE_BASE = 10000.0
EPS = 1e-6

MLA_HEADS = 4
MLA_Q_RANK = 384
MLA_KV_RANK = 256
MLA_NOPE = 128
MLA_ROPE = 64
MLA_V = 128
DIFF_HEADS = 4
DIFF_QK = 64
DIFF_V = 128
FNET_GROUPS = 4
FNET_GROUP_DIM = 128
FNET_WIDTH = FNET_GROUPS * FNET_GROUP_DIM
CONV_WIDTH = 512
CONV_KERNEL = 31
CONV_GROUPS = 4
N_BRANCH = 4
BRANCH_W = 512
IN_MLA = MLA_Q_RANK + MLA_KV_RANK + MLA_ROPE
IN_DIFF = DIFF_HEADS * (4 * DIFF_QK + DIFF_V)
IN_FNET = FNET_WIDTH
IN_CONV = 2 * CONV_WIDTH
D_IN = IN_MLA + IN_DIFF + IN_FNET + IN_CONV
PEER_HEADS = 8
PEER_NKEYS = 128
PEER_EXPERTS = PEER_NKEYS * PEER_NKEYS
PEER_DKEY = 256
PEER_TOPK = 16
PEER_CHUNK = 128

kernel_name = "hybrid_gated_mla_diff_fnet_conformer_peer"


def rms_norm(x, g):
    xf = x.astype(jnp.float32)
    y = xf * lax.rsqrt(jnp.mean(xf * xf, axis=-1, keepdims=True) + EPS)
    return (y * g.astype(jnp.float32)).astype(x.dtype)


def modulate(h, shift, scale):
    return h * (1 + scale) + shift


def axial_rope_tables(L, dim):
    rows = L // GRID_W
    row = jnp.repeat(jnp.arange(rows, dtype=jnp.float32), GRID_W)
    col = jnp.tile(jnp.arange(GRID_W, dtype=jnp.float32), rows)
    nf = dim // 4
    inv = ROPE_BASE ** (-jnp.arange(nf, dtype=jnp.float32) / nf)
    ang = jnp.concatenate([row[:, None] * inv, col[:, None] * inv], axis=-1)
    return (jnp.cos(ang), jnp.sin(ang))


def apply_rope(x, cs):
    if cs is None:
        return x
    cos, sin = cs
    half = x.shape[-1] // 2
    shape = (1, x.shape[1]) + (1,) * (x.ndim - 3) + (half,)
    cos = cos.reshape(shape)
    sin = sin.reshape(shape)
    xf = x.astype(jnp.float32)
    x1, x2 = xf[..., :half], xf[..., half:]
    return jnp.concatenate([x1 * cos - x2 * sin, x2 * cos + x1 * sin], axis=-1).astype(x.dtype)


def mixer_projections(hn, p, rope_mla, rope_diff):
    B, L, _ = hn.shape
    z = hn @ p["w_in"]
    offs = list(np.cumsum([MLA_Q_RANK, MLA_KV_RANK, MLA_ROPE, IN_DIFF, IN_FNET]))
    q_lat, kv_lat, k_rope, zd, zf, zc = jnp.split(z, offs, axis=-1)
    q = (rms_norm(q_lat, p["g_q_mla"]) @ p["w_uq"]).reshape(B, L, MLA_HEADS, MLA_NOPE + MLA_ROPE)
    q_nope = q[..., :MLA_NOPE]
    q_rope = apply_rope(q[..., MLA_NOPE:], rope_mla)
    kv = (rms_norm(kv_lat, p["g_kv_mla"]) @ p["w_ukv"]).reshape(B, L, MLA_HEADS, MLA_NOPE + MLA_V)
    k_nope = kv[..., :MLA_NOPE]
    v_mla = kv[..., MLA_NOPE:]
    k_rope = apply_rope(k_rope, rope_mla)
    dq, dk, dv = jnp.split(zd, 3, axis=-1)
    dq = apply_rope(dq.reshape(B, L, DIFF_HEADS, 2, DIFF_QK), rope_diff)
    dk = apply_rope(dk.reshape(B, L, DIFF_HEADS, 2, DIFF_QK), rope_diff)
    dv = dv.reshape(B, L, DIFF_HEADS, DIFF_V)
    return dict(q_nope=q_nope, q_rope=q_rope, k_nope=k_nope, k_rope=k_rope, v_mla=v_mla,
                dq=dq, dk=dk, dv=dv, zf=zf, zc=zc)


def mla_attend(q_nope, q_rope, k_nope, k_rope, v):
    scale = (MLA_NOPE + MLA_ROPE) ** -0.5
    s = (jnp.einsum('bqhd,bkhd->bhqk', q_nope, k_nope)
         + jnp.einsum('bqhd,bkd->bhqk', q_rope, k_rope)) * scale
    pr = jax.nn.softmax(s.astype(jnp.float32), axis=-1).astype(v.dtype)
    return jnp.einsum('bhqk,bkhd->bqhd', pr, v)


def diff_attend(q, k, v, lam):
    s = jnp.einsum('bqhcd,bkhcd->bchqk', q, k) * (DIFF_QK ** -0.5)
    pr = jax.nn.softmax(s.astype(jnp.float32), axis=-1)
    a = pr[:, 0] - lam * pr[:, 1]
    return jnp.einsum('bhqk,bkhd->bqhd', a.astype(v.dtype), v)


def sweep_blocks(fn, qs, kv):
    B, L = qs[0].shape[:2]
    nb = L // Q_BLOCK
    qb = tuple(jnp.swapaxes(q.reshape((B, nb, Q_BLOCK) + q.shape[2:]), 0, 1) for q in qs)
    out = lax.map(lambda blk: fn(*blk, *kv), qb)
    return jnp.swapaxes(out, 0, 1).reshape((B, L) + out.shape[3:])


def fourier_mix(zf):
    B, L, _ = zf.shape
    f = zf.astype(jnp.float32).reshape(B, L, FNET_GROUPS, FNET_GROUP_DIM)
    y = jnp.fft.fft2(f, axes=(1, 3), norm="ortho").real
    return y.reshape(B, L, FNET_WIDTH).astype(zf.dtype)


def conformer_conv(zc, w_dw, b_dw, g, b):
    B, L, _ = zc.shape
    a, gt = jnp.split(zc, 2, axis=-1)
    u = a * jax.nn.sigmoid(gt)
    pad = CONV_KERNEL // 2
    y = lax.conv_general_dilated(u, w_dw[:, None, :], window_strides=(1,), padding=[(pad, pad)],
                                 dimension_numbers=('NWC', 'WIO', 'NWC'),
                                 feature_group_count=CONV_WIDTH) + b_dw
    yf = y.astype(jnp.float32).reshape(B, L, CONV_GROUPS, CONV_WIDTH // CONV_GROUPS)
    mu = jnp.mean(yf, axis=-1, keepdims=True)
    var = jnp.mean(jnp.square(yf - mu), axis=-1, keepdims=True)
    yn = ((yf - mu) * lax.rsqrt(var + 1e-5)).reshape(B, L, CONV_WIDTH)
    yn = yn * g.astype(jnp.float32) + b.astype(jnp.float32)
    return jax.nn.silu(yn).astype(zc.dtype)


def token_mix(hn, P, kv_mla, kv_diff, p, lam, lam_init, blocked):
    B, L, _ = hn.shape
    if blocked:
        o_mla = sweep_blocks(mla_attend, (P["q_nope"], P["q_rope"]), kv_mla)
        o_diff = sweep_blocks(diff_attend, (P["dq"],), kv_diff + (lam,))
    else:
        o_mla = mla_attend(P["q_nope"], P["q_rope"], *kv_mla)
        o_diff = diff_attend(P["dq"], *kv_diff, lam)
    o_diff = rms_norm(o_diff, p["g_subln"]) * (1.0 - lam_init)
    branches = (o_mla.reshape(B, L, BRANCH_W),
                fourier_mix(P["zf"]),
                conformer_conv(P["zc"], p["w_dw"], p["b_dw"], p["g_conv_norm"], p["b_conv_norm"]),
                o_diff.reshape(B, L, BRANCH_W))
    y = None
    for n, br in enumerate(branches):
        term = jax.nn.sigmoid(hn @ p["w_gate"][n]) * (br @ p["w_branch"][n])
        y = term if y is None else y + term
    return y @ p["w_out"]


def peer(hn, w_q, sub_keys, U, V):
    B, L, D = hn.shape
    nb = (B * L) // PEER_CHUNK

    def chunk(xc):
        C = xc.shape[0]
        q = (xc @ w_q).reshape(C, PEER_HEADS, 2, PEER_DKEY // 2)
        s = jnp.einsum('chpd,pkd->chpk', q, sub_keys)
        s1, i1 = lax.top_k(s[:, :, 0], PEER_TOPK)
        s2, i2 = lax.top_k(s[:, :, 1], PEER_TOPK)
        cand = (s1[..., :, None] + s2[..., None, :]).reshape(C, PEER_HEADS, PEER_TOPK * PEER_TOPK)
        cidx = (i1[..., :, None] * PEER_NKEYS + i2[..., None, :]).reshape(C, PEER_HEADS, PEER_TOPK * PEER_TOPK)
        sc, j = lax.top_k(cand, PEER_TOPK)
        idx = jnp.take_along_axis(cidx, j, axis=-1)
        g = jax.nn.softmax(sc.astype(jnp.float32), axis=-1).astype(xc.dtype)
        u = jnp.take(U, idx, axis=0)
        act = jax.nn.gelu(jnp.einsum('chkd,cd->chk', u, xc), approximate=False)
        v = jnp.take(V, idx, axis=0)
        return jnp.einsum('chk,chkd->cd', g * act, v)

    out = lax.map(chunk, hn.reshape(nb, PEER_CHUNK, D))
    return out.reshape(B, L, D)


def layer(xl, xc, p, mod_l, mod_c, rope_mla, rope_diff, lam_init, need_ctx):
    sh1l, sc1l, g1l, sh2l, sc2l, g2l = jnp.split(mod_l[:, None, :], 6, axis=-1)
    sh1c, sc1c, g1c, sh2c, sc2c, g2c = jnp.split(mod_c[None, None, :], 6, axis=-1)
    hl = modulate(rms_norm(xl, p["g_norm1"]), sh1l, sc1l)
    hc = modulate(rms_norm(xc, p["g_norm1"]), sh1c, sc1c)
    Pl = mixer_projections(hl, p, rope_mla, rope_diff)
    Pc = mixer_projections(hc, p, None, None)
    lq1, lk1, lq2, lk2 = (t.astype(jnp.float32) for t in (p["lam_q1"], p["lam_k1"], p["lam_q2"], p["lam_k2"]))
    lam = jnp.exp(jnp.sum(lq1 * lk1)) - jnp.exp(jnp.sum(lq2 * lk2)) + lam_init
    kv_mla_c = (Pc["k_nope"], Pc["k_rope"], Pc["v_mla"])
    kv_diff_c = (Pc["dk"], Pc["dv"])
    kv_mla_l = tuple(jnp.concatenate([a, b], axis=1) for a, b in
                     zip(kv_mla_c, (Pl["k_nope"], Pl["k_rope"], Pl["v_mla"])))
    kv_diff_l = tuple(jnp.concatenate([a, b], axis=1) for a, b in
                      zip(kv_diff_c, (Pl["dk"], Pl["dv"])))
    xl = xl + g1l * token_mix(hl, Pl, kv_mla_l, kv_diff_l, p, lam, lam_init, True)
    xl = xl + g2l * peer(modulate(rms_norm(xl, p["g_norm2"]), sh2l, sc2l),
                         p["w_peer_q"], p["peer_keys"], p["peer_u"], p["peer_v"])
    if need_ctx:
        xc = xc + g1c * token_mix(hc, Pc, kv_mla_c, kv_diff_c, p, lam, lam_init, False)
        xc = xc + g2c * peer(modulate(rms_norm(xc, p["g_norm2"]), sh2c, sc2c),
                             p["w_peer_q"], p["peer_keys"], p["peer_u"], p["peer_v"])
    return xl, xc


def setup_inputs(seed: int = 0) -> dict:
    key = jax.random.key(seed)
    ks = jax.random.split(key, 32)
    D = D_MODEL

    def nrm(k, shape, s):
        return jax.random.normal(k, shape, jnp.float32) * s

    return dict(
        x=nrm(ks[0], (BATCH, SEQ, D), 1.0),
        c=nrm(ks[1], (BATCH, D), 1.0),
        ctx=nrm(ks[2], (BATCH, CTX_LEN, D), 1.0),
        c_ctx=nrm(ks[3], (D,), 1.0),
        w_ada=nrm(ks[4], (DEPTH, D, 6 * D), 0.5 * D ** -0.5),
        b_ada=nrm(ks[5], (DEPTH, 6 * D), 0.02),
        g_norm1=1.0 + nrm(ks[6], (DEPTH, D), 0.02),
        g_norm2=1.0 + nrm(ks[7], (DEPTH, D), 0.02),
        w_in=nrm(ks[8], (DEPTH, D, D_IN), D ** -0.5),
        g_q_mla=1.0 + nrm(ks[9], (DEPTH, MLA_Q_RANK), 0.02),
        w_uq=nrm(ks[10], (DEPTH, MLA_Q_RANK, MLA_HEADS * (MLA_NOPE + MLA_ROPE)), MLA_Q_RANK ** -0.5),
        g_kv_mla=1.0 + nrm(ks[11], (DEPTH, MLA_KV_RANK), 0.02),
        w_ukv=nrm(ks[12], (DEPTH, MLA_KV_RANK, MLA_HEADS * (MLA_NOPE + MLA_V)), MLA_KV_RANK ** -0.5),
        lam_q1=nrm(ks[13], (DEPTH, DIFF_QK), 0.1),
        lam_k1=nrm(ks[14], (DEPTH, DIFF_QK), 0.1),
        lam_q2=nrm(ks[15], (DEPTH, DIFF_QK), 0.1),
        lam_k2=nrm(ks[16], (DEPTH, DIFF_QK), 0.1),
        g_subln=1.0 + nrm(ks[17], (DEPTH, DIFF_V), 0.02),
        w_dw=nrm(ks[18], (DEPTH, CONV_KERNEL, CONV_WIDTH), CONV_KERNEL ** -0.5),
        b_dw=nrm(ks[19], (DEPTH, CONV_WIDTH), 0.02),
        g_conv_norm=1.0 + nrm(ks[20], (DEPTH, CONV_WIDTH), 0.02),
        b_conv_norm=nrm(ks[21], (DEPTH, CONV_WIDTH), 0.02),
        w_gate=nrm(ks[22], (DEPTH, N_BRANCH, D, D), D ** -0.5),
        w_branch=nrm(ks[23], (DEPTH, N_BRANCH, BRANCH_W, D), BRANCH_W ** -0.5),
        w_out=nrm(ks[24], (DEPTH, D, D), D ** -0.5),
        w_peer_q=nrm(ks[25], (DEPTH, D, PEER_HEADS * PEER_DKEY), D ** -0.5),
        peer_keys=nrm(ks[26], (DEPTH, 2, PEER_NKEYS, PEER_DKEY // 2), (PEER_DKEY // 2) ** -0.5),
        peer_u=nrm(ks[27], (DEPTH, PEER_EXPERTS, D), D ** -0.5),
        peer_v=nrm(ks[28], (DEPTH, PEER_EXPERTS, D), 1.0),
        g_final=1.0 + nrm(ks[29], (D,), 0.02),
    )


def reference(x, c, ctx, c_ctx, w_ada, b_ada, g_norm1, g_norm2, w_in, g_q_mla, w_uq, g_kv_mla,
              w_ukv, lam_q1, lam_k1, lam_q2, lam_k2, g_subln, w_dw, b_dw, g_conv_norm, b_conv_norm,
              w_gate, w_branch, w_out, w_peer_q, peer_keys, peer_u, peer_v, g_final):
    L = x.shape[1]
    rope_mla = axial_rope_tables(L, MLA_ROPE)
    rope_diff = axial_rope_tables(L, DIFF_QK)
    xl, xc = x, ctx
    for i in range(DEPTH):
        p = dict(g_norm1=g_norm1[i], g_norm2=g_norm2[i], w_in=w_in[i], g_q_mla=g_q_mla[i],
                 w_uq=w_uq[i], g_kv_mla=g_kv_mla[i], w_ukv=w_ukv[i], lam_q1=lam_q1[i],
                 lam_k1=lam_k1[i], lam_q2=lam_q2[i], lam_k2=lam_k2[i], g_subln=g_subln[i],
                 w_dw=w_dw[i], b_dw=b_dw[i], g_conv_norm=g_conv_norm[i], b_conv_norm=b_conv_norm[i],
                 w_gate=w_gate[i], w_branch=w_branch[i], w_out=w_out[i], w_peer_q=w_peer_q[i],
                 peer_keys=peer_keys[i], peer_u=peer_u[i], peer_v=peer_v[i])
        mod_l = jax.nn.silu(c) @ w_ada[i] + b_ada[i]
        mod_c = jax.nn.silu(c_ctx) @ w_ada[i] + b_ada[i]
        lam_init = 0.8 - 0.6 * math.exp(-0.3 * i)
        xl, xc = layer(xl, xc, p, mod_l, mod_c, rope_mla, rope_diff, lam_init, i < DEPTH - 1)
    return rms_norm(xl, g_final)
```

```cpp
#include <hip/hip_runtime.h>
#include <cstdio>
#include <cstdint>
#include <cstddef>

#define LAS __attribute__((address_space(3)))
typedef unsigned short bf16_t;
typedef short bf16x8 __attribute__((ext_vector_type(8)));
typedef short s16x4 __attribute__((ext_vector_type(4)));
typedef float f32x4 __attribute__((ext_vector_type(4)));
typedef float f32x2 __attribute__((ext_vector_type(2)));
typedef float f32x16 __attribute__((ext_vector_type(16)));
typedef unsigned u32x4 __attribute__((ext_vector_type(4)));
typedef unsigned u32x2 __attribute__((ext_vector_type(2)));
typedef __bf16 bf16x2_t __attribute__((ext_vector_type(2)));

#ifndef MK_MULTI
#define MK_MULTI 0
#endif
#ifndef MK_DIAG
#define MK_DIAG 0
#endif
#ifndef MK_STOP
#define MK_STOP 1000
#endif

constexpr int DM = 2048, NBATCH = 2, SEQ = 8192, CTXL = 256, DEPTH = 2;
constexpr int ML = NBATCH * SEQ, MC = NBATCH * CTXL, MT = ML + MC;
constexpr int DIN = 3776, ZLD = 3840;
constexpr int ZC_QLAT = 0, ZC_KVLAT = 384, ZC_KROPE = 640, ZC_DQ = 704, ZC_DK = 1216, ZC_DV = 1728, ZC_F = 2240, ZC_C = 2752;
constexpr int NEXP = 16384;
#ifndef MK_UBITS
#define MK_UBITS 4
#endif
#ifndef MK_VBITS
#define MK_VBITS 4
#endif
constexpr int PEER_UBITS = MK_UBITS, PEER_VBITS = MK_VBITS;
constexpr int PEER_UROWB = DM * PEER_UBITS / 8, PEER_VROWB = DM * PEER_VBITS / 8;
constexpr int NTHREADS = 512, NWAVES = 8;
constexpr int LDS_BYTES = 160 * 1024;

constexpr size_t al256(size_t x) { return (x + 255) / 256 * 256; }
constexpr size_t WS_BAR   = 0;
constexpr size_t WS_MOD   = 16384;
constexpr size_t WS_DIAG  = WS_MOD + al256((size_t)DEPTH * 3 * 6 * DM * 4);
constexpr size_t WS_ZERO_END = WS_DIAG + 4096;
constexpr size_t WS_ROPE  = WS_ZERO_END;
constexpr size_t WS_WIN   = WS_ROPE + (size_t)SEQ * 32 * 2 * 4;
constexpr size_t WS_WG    = WS_WIN + (size_t)DEPTH * ZLD * DM * 2;
constexpr size_t WS_WB    = WS_WG + (size_t)DEPTH * 4 * DM * DM;
constexpr size_t WS_WO    = WS_WB + (size_t)DEPTH * 4 * DM * 512 * 2;
constexpr size_t WS_WPQ   = WS_WO + (size_t)DEPTH * DM * DM * 2;
constexpr size_t WS_WUQ   = WS_WPQ + (size_t)DEPTH * DM * DM * 2;
constexpr size_t WS_WUKV  = WS_WUQ + (size_t)DEPTH * 768 * 384 * 2;
constexpr size_t WS_KB    = WS_WUKV + (size_t)DEPTH * 1024 * 256 * 2;
constexpr size_t WS_WDFT  = WS_KB + (size_t)DEPTH * 256 * 256 * 2;
constexpr size_t WS_PU    = WS_WDFT + (size_t)512 * 1024 * 2;
constexpr size_t WS_PV    = WS_PU + (size_t)DEPTH * NEXP * PEER_UROWB;
constexpr size_t WS_XR    = WS_PV + (size_t)DEPTH * NEXP * PEER_VROWB;
constexpr size_t WS_HN    = WS_XR + (size_t)MT * DM * 4;
constexpr size_t WS_BR    = WS_HN + (size_t)MT * DM * 2;
constexpr size_t WS_Y     = WS_BR + (size_t)4 * MT * 512 * 2;
constexpr size_t WS_R     = WS_Y + (size_t)MT * DM * 2;
constexpr size_t WS_Z     = WS_R;
constexpr size_t WS_Q     = WS_Z + (size_t)MT * ZLD * 2;
constexpr size_t WS_KV    = WS_Q + (size_t)MT * 768 * 2;
constexpr size_t WS_AP    = WS_KV + (size_t)MT * 1024 * 2;
constexpr size_t WS_X     = WS_AP + (size_t)NBATCH * 128 * 2 * 64 * 512 * 2;
constexpr size_t WS_T     = WS_R;
constexpr size_t WS_S     = WS_R;
constexpr size_t WS_PART  = WS_R + (size_t)MT * DM * 4;
constexpr size_t WS_R_END = WS_R + (size_t)4 * MT * DM * 2;
static_assert(WS_PART + (size_t)8 * MC * DM * 4 <= WS_R_END, "partials must fit in region R");
constexpr size_t WS_YC    = WS_R_END;
constexpr size_t WS_WSC   = WS_YC + (size_t)4 * MC * DM * 2;
constexpr size_t WS_HN8   = WS_WSC + (size_t)DEPTH * DM * DM * 2;
constexpr size_t WS_K8    = WS_HN8 + (size_t)MT * DM;
constexpr size_t WS_KD8   = WS_K8 + (size_t)MT * 1024 + 256;
constexpr size_t WS_V8T   = WS_KD8 + (size_t)MT * 512 + 256;
constexpr size_t WS_VD8T  = WS_V8T + (size_t)4 * (MT / 64) * 8192 + 256;
constexpr size_t WS_END   = WS_VD8T + (size_t)4 * (MT / 64) * 8192 + 256;
static_assert(WS_X + (size_t)MT * 1024 * 2 <= WS_R_END, "region R overflow");
static_assert((size_t)256 * 32 * 512 * 16 <= (size_t)4 * MT * 512 * 2, "YS scratch must fit in BR");

struct Args { const float* in[30]; float* out; unsigned char* ws; int ph_lo, ph_hi; };
enum { I_X = 0, I_C, I_CTX, I_CCTX, I_WADA, I_BADA, I_GN1, I_GN2, I_WIN, I_GQ, I_WUQ, I_GKV, I_WUKV, I_LQ1, I_LK1, I_LQ2, I_LK2, I_GSUB, I_WDW, I_BDW, I_GCN, I_BCN,
       I_WGATE, I_WBR, I_WOUT, I_WPQ, I_PKEYS, I_PU, I_PV, I_GFIN };

__device__ __forceinline__ unsigned cvt_pk_bf16(float lo, float hi) { unsigned r; asm volatile("v_cvt_pk_bf16_f32 %0, %1, %2" : "=v"(r) : "v"(lo), "v"(hi)); return r; }
__device__ __forceinline__ bf16_t f2bf(float f) { unsigned u = __float_as_uint(f); u += 0x7FFFu + ((u >> 16) & 1u); return (bf16_t)(u >> 16); }
__device__ __forceinline__ float bf2f(bf16_t b) { return __uint_as_float(((unsigned)b) << 16); }
__device__ __forceinline__ float bflo(unsigned w) { return __uint_as_float(w << 16); }
__device__ __forceinline__ float bfhi(unsigned w) { return __uint_as_float(w & 0xFFFF0000u); }
__device__ __forceinline__ int tid_of_wave(int wv) { int ln; asm volatile("v_mbcnt_lo_u32_b32 %0, -1, 0\n\tv_mbcnt_hi_u32_b32 %0, -1, %0" : "=v"(ln)); return wv * 64 + ln; }
__device__ __forceinline__ unsigned char f2fp8(float v) { return (unsigned char)(__builtin_amdgcn_cvt_pk_fp8_f32(v, v, 0, false) & 0xFF); }
__device__ __forceinline__ float sigmoidf_(float x) { return __builtin_amdgcn_rcpf(1.0f + __expf(-x)); }
template <int CTRL> __device__ __forceinline__ unsigned dpp_u(unsigned x) { return (unsigned)__builtin_amdgcn_update_dpp(0, (int)x, CTRL, 0xf, 0xf, true); }
template <int CTRL> __device__ __forceinline__ float dpp_f(float x) { return __int_as_float(__builtin_amdgcn_update_dpp(0, __float_as_int(x), CTRL, 0xf, 0xf, true)); }
__device__ __forceinline__ unsigned row_max16_u(unsigned x) { unsigned y = dpp_u<0xB1>(x); x = x > y ? x : y; y = dpp_u<0x4E>(x); x = x > y ? x : y; y = dpp_u<0x141>(x); x = x > y ? x : y; y = dpp_u<0x140>(x); return x > y ? x : y; }
__device__ __forceinline__ float row_max16_f(float x) { x = fmaxf(x, dpp_f<0xB1>(x)); x = fmaxf(x, dpp_f<0x4E>(x)); x = fmaxf(x, dpp_f<0x141>(x)); return fmaxf(x, dpp_f<0x140>(x)); }
__device__ __forceinline__ float row_sum16_f(float x) { x += dpp_f<0xB1>(x); x += dpp_f<0x4E>(x); x += dpp_f<0x141>(x); return x + dpp_f<0x140>(x); }
__device__ __forceinline__ float wave_sum_dpp(float x) {
    x = row_sum16_f(x);
    const float a = __int_as_float(__builtin_amdgcn_readlane(__float_as_int(x), 0)), b = __int_as_float(__builtin_amdgcn_readlane(__float_as_int(x), 16));
    const float c = __int_as_float(__builtin_amdgcn_readlane(__float_as_int(x), 32)), d = __int_as_float(__builtin_amdgcn_readlane(__float_as_int(x), 48));
    return (a + b) + (c + d);
}
__device__ __forceinline__ float wave_sum(float v) { return wave_sum_dpp(v); }
__device__ __forceinline__ float half_sum_dpp(float x, int hi) {
    x = row_sum16_f(x);
    const float a = __int_as_float(__builtin_amdgcn_readlane(__float_as_int(x), 0)), b = __int_as_float(__builtin_amdgcn_readlane(__float_as_int(x), 16));
    const float c = __int_as_float(__builtin_amdgcn_readlane(__float_as_int(x), 32)), d = __int_as_float(__builtin_amdgcn_readlane(__float_as_int(x), 48));
    return hi ? (c + d) : (a + b);
}

#define XB_TMO      128
#define XB_XCNT(j)  (256  + 64 * (j))
#define XB_XSUB(j)  (1280 + 64 * (j))
#define XB_XGEN(j)  (2304 + 64 * (j))
#define XB_TOP      3328
#define XB_TOPGEN   3392
#define XCD_BAR_WORDS 3456
#define XB_SPIN_CAP (1u << 20)
__device__ __forceinline__ unsigned xb_ld(unsigned* p)              { return __hip_atomic_load(p, __ATOMIC_RELAXED, __HIP_MEMORY_SCOPE_AGENT); }
__device__ __forceinline__ unsigned xb_add(unsigned* p, unsigned v) { return __hip_atomic_fetch_add(p, v, __ATOMIC_RELAXED, __HIP_MEMORY_SCOPE_AGENT); }
__device__ __forceinline__ unsigned xb_xcc_id() { return (unsigned)__builtin_amdgcn_s_getreg((3 << 11) | 20) & 0xFu; }
#define XB_SPIN(cond, bar) do { unsigned _sp = 0; while (cond) { __builtin_amdgcn_s_sleep(1); \
    if ((++_sp & 255u) == 0u) { if (xb_ld(&(bar)[XB_TMO])) break; if (_sp > XB_SPIN_CAP) { atomicAdd(&(bar)[XB_TMO], 1u); break; } } } } while (0)
struct XcdBarrier { unsigned* bar; unsigned x; volatile LAS unsigned* st; };
__device__ __forceinline__ XcdBarrier xcd_barrier_post(unsigned* bar, volatile LAS unsigned* st, int tid) {
    XcdBarrier b; b.bar = bar; b.x = xb_xcc_id(); b.st = st;
    if (tid == 0) (void)xb_add(&bar[XB_XCNT(b.x)], 1u);
    return b;
}
__device__ __forceinline__ void xcd_barrier_complete(unsigned* bar, unsigned x, unsigned& nloc, unsigned& nx) {
    const unsigned G = gridDim.x * gridDim.y * gridDim.z;
    unsigned sum, cnt, mine, sp = 0u;
    for (;;) {
        sum = 0u; cnt = 0u; mine = 0u;
#pragma unroll
        for (unsigned j = 0; j < 16; ++j) { const unsigned c = xb_ld(&bar[XB_XCNT(j)]); sum += c; cnt += (c > 0u) ? 1u : 0u; mine = (j == x) ? c : mine; }
        if (sum == G) break;
        __builtin_amdgcn_s_sleep(1);
        if ((++sp & 255u) == 0u) { if (xb_ld(&bar[XB_TMO])) break; if (sp > XB_SPIN_CAP) { atomicAdd(&bar[XB_TMO], 1u); break; } }
    }
    nloc = mine > 0u ? mine : 1u; nx = cnt > 0u ? cnt : 1u;
}
__device__ __forceinline__ void xcd_barrier(const XcdBarrier& b, int tid) {
    asm volatile("s_waitcnt vmcnt(0)" ::: "memory");
    __syncthreads();
    if (tid == 0) {
        unsigned* bar = b.bar;
        __builtin_amdgcn_s_waitcnt(0);
        unsigned nloc = b.st[0], nx = b.st[1];
        if (nloc == 0u) { xcd_barrier_complete(bar, b.x, nloc, nx); b.st[0] = nloc; b.st[1] = nx; }
        const unsigned old = xb_add(&bar[XB_XSUB(b.x)], 1u);
        const unsigned gen = old / nloc;
        if (old + 1u == (gen + 1u) * nloc) {
            __builtin_amdgcn_fence(__ATOMIC_RELEASE, "agent");
            asm volatile("s_waitcnt vmcnt(0)" ::: "memory");
            const unsigned og = xb_add(&bar[XB_TOP], 1u);
            const unsigned tg = og / nx;
            if (og + 1u == (tg + 1u) * nx) xb_add(&bar[XB_TOPGEN], 1u);
            else XB_SPIN(xb_ld(&bar[XB_TOPGEN]) == tg, bar);
            __builtin_amdgcn_fence(__ATOMIC_ACQUIRE, "agent");
            xb_add(&bar[XB_XGEN(b.x)], 1u);
            asm volatile("s_waitcnt vmcnt(0)" ::: "memory");
        } else {
            XB_SPIN(xb_ld(&bar[XB_XGEN(b.x)]) == gen, bar);
            __builtin_amdgcn_fence(__ATOMIC_ACQUIRE, "agent");
            asm volatile("s_waitcnt vmcnt(0)" ::: "memory");
        }
    }
    __syncthreads();
}

namespace pg8 {
constexpr int BM = 256, BK = 64, HALF = 128, HTB = HALF * BK * 2, STAGE_BYTES = 8 * HTB, NXCD = 8, WGM = 8;
__host__ __device__ __forceinline__ int lds_byte(int r, int c) { const int st = (r >> 4) * 2 + (c >> 5), rr = r & 15, cc = c & 31, ob = rr * 64 + cc * 2; return st * 1024 + (ob ^ (((ob >> 9) & 1) << 5)); }
__host__ __device__ __forceinline__ void stage_rc(int b, int& R, int& C) { const int st = b / 1024, sb = b % 1024, swz = sb ^ (((sb >> 9) & 1) << 5); R = (st >> 1) * 16 + swz / 64; C = (st & 1) * 32 + (swz % 64) / 2; }
__host__ __device__ __forceinline__ int perm32(int rho) { const int n = rho >> 4, i = rho & 15; return 8 * (i >> 2) + 4 * n + (i & 3); }

typedef int v8i_t __attribute__((ext_vector_type(8)));
template <int ELT> struct FragT { bf16x8 k[2]; };
template <> struct FragT<1> { v8i_t v; };
struct Unit { int pm, pn; const char* a; const char* b; };
struct Gemm { int lda, ldb, K; int wv; };

__device__ __forceinline__ void tile_of(int L, int nM, int nN, int& pm, int& pn) {
    const int nwg = nM * nN; int wgid = L;
    { const int q = nwg / NXCD, r = nwg % NXCD, xcd = wgid % NXCD, off = wgid / NXCD; wgid = (xcd < r ? xcd * (q + 1) : r * (q + 1) + (xcd - r) * q) + off; }
    const int nig = WGM * nN, gid = wgid / nig, fm = gid * WGM, gsz = (nM - fm) < WGM ? (nM - fm) : WGM;
    pm = fm + ((wgid % nig) % gsz); pn = (wgid % nig) / gsz;
}
struct Sched {
    int nM, nN, G, c; const char* A; const char* B; size_t a_tile, b_tile; int a_div; size_t a_dstride; int sa0 = 0x7F7F7F7F;
    __device__ __forceinline__ int a_scale(const Unit& u) const { return (u.pn / a_div) == 0 ? sa0 : 0x7F7F7F7F; }
    __device__ __forceinline__ bool next(int i, Unit& u) const {
        const long L = (long)i * G + c; if (L >= (long)nM * nN) return false;
        tile_of((int)L, nM, nN, u.pm, u.pn);
        u.a = A + (size_t)u.pm * a_tile + (size_t)(u.pn / a_div) * a_dstride; u.b = B + (size_t)u.pn * b_tile; return true;
    }
};
struct SchedWsc {
    int G, c; const char* KB; const char* W;
    __device__ __forceinline__ bool next(int i, Unit& u) const {
        const long L = (long)i * G + c; if (L >= DEPTH * 64) return false;
        const int l = (int)L >> 6, h = ((int)L >> 3) & 7, pn = (int)L & 7; u.pm = h; u.pn = l * 8 + pn;
        u.a = KB + (size_t)l * 256 * 256 * 2; u.b = W + ((size_t)l * DM * DM + (size_t)pn * 256 * DM + h * 256) * 2; return true;
    }
};
struct SchedGate {
    int nM, G, c; const char* A; const char* B; size_t a_tile, b_tile;
    __device__ __forceinline__ int a_scale(const Unit&) const { return 0x7F7F7F7F; }
    __device__ __forceinline__ bool next(int i, Unit& u) const {
        const long L = (long)(i >> 2) * G + c; if (L >= (long)nM * 8) return false;
        int pm, pn; tile_of((int)L, nM, 8, pm, pn); const int n = i & 3;
        u.pm = pm; u.pn = n * 8 + pn; u.a = A + (size_t)pm * a_tile; u.b = B + (size_t)u.pn * b_tile; return true;
    }
};

struct EpiBf16 {
    static constexpr bool PERM = true;
    bf16_t* O; int ldc; int pn_div; size_t pn_stride;
    __device__ __forceinline__ void operator()(const f32x4 (&acc)[2][2][4][2], const Unit& u, int wr, int wc, int fr, int fq) const {
        bf16_t* base = O + (size_t)(u.pn / pn_div) * pn_stride;
        const int row0 = u.pm * BM + wr * 64 + fr, col0 = (u.pn % pn_div) * BM + wc * 32 + 8 * fq;
#pragma unroll
        for (int ai = 0; ai < 2; ++ai)
#pragma unroll
            for (int m = 0; m < 4; ++m) { bf16_t* rowp = base + (size_t)(row0 + ai * HALF + m * 16) * ldc + col0;
#pragma unroll
                for (int bj = 0; bj < 2; ++bj) { const f32x4 v0 = acc[ai][bj][m][0], v1 = acc[ai][bj][m][1];
                    u32x4 w; w.x = cvt_pk_bf16(v0[0], v0[1]); w.y = cvt_pk_bf16(v0[2], v0[3]); w.z = cvt_pk_bf16(v1[0], v1[1]); w.w = cvt_pk_bf16(v1[2], v1[3]);
                    *(u32x4*)(rowp + bj * HALF) = w; } }
    }
};
struct EpiKV {
    static constexpr bool PERM = true;
    bf16_t* O; unsigned char* K8;
    __device__ __forceinline__ void operator()(const f32x4 (&acc)[2][2][4][2], const Unit& u, int wr, int wc, int fr, int fq) const {
        const int row0 = u.pm * BM + wr * 64 + fr;
        bf16_t* ob = O + (size_t)row0 * 1024 + u.pn * BM + HALF + wc * 32 + 8 * fq; unsigned char* kb = K8 + ((size_t)row0 * 4 + u.pn) * 256 + wc * 32 + 8 * fq;
#pragma unroll
        for (int ai = 0; ai < 2; ++ai)
#pragma unroll
            for (int m = 0; m < 4; ++m) { int dr = (ai * HALF + m * 16) * 1024; asm volatile("" : "+v"(dr));
                { const f32x4 v0 = acc[ai][0][m][0], v1 = acc[ai][0][m][1]; int p0 = 0, p1 = 0;
                  p0 = __builtin_amdgcn_cvt_pk_fp8_f32(v0[0], v0[1], p0, false); p0 = __builtin_amdgcn_cvt_pk_fp8_f32(v0[2], v0[3], p0, true);
                  p1 = __builtin_amdgcn_cvt_pk_fp8_f32(v1[0], v1[1], p1, false); p1 = __builtin_amdgcn_cvt_pk_fp8_f32(v1[2], v1[3], p1, true);
                  *(u32x2*)(kb + dr) = (u32x2){(unsigned)p0, (unsigned)p1}; }
                { const f32x4 v0 = acc[ai][1][m][0], v1 = acc[ai][1][m][1];
                  u32x4 w; w.x = cvt_pk_bf16(v0[0], v0[1]); w.y = cvt_pk_bf16(v0[2], v0[3]); w.z = cvt_pk_bf16(v1[0], v1[1]); w.w = cvt_pk_bf16(v1[2], v1[3]);
                  *(u32x4*)(ob + dr) = w; } }
    }
};
struct EpiFp8 {
    static constexpr bool PERM = true;
    unsigned char* O; int ldc; int pn_div; size_t pn_stride;
    __device__ __forceinline__ void operator()(const f32x4 (&acc)[2][2][4][2], const Unit& u, int wr, int wc, int fr, int fq) const {
        unsigned char* base = O + (size_t)(u.pn / pn_div) * pn_stride;
        const int row0 = u.pm * BM + wr * 64 + fr, col0 = (u.pn % pn_div) * BM + wc * 32 + 8 * fq;
#pragma unroll
        for (int ai = 0; ai < 2; ++ai)
#pragma unroll
            for (int m = 0; m < 4; ++m) { unsigned char* rowp = base + (size_t)(row0 + ai * HALF + m * 16) * ldc + col0;
#pragma unroll
                for (int bj = 0; bj < 2; ++bj) { const f32x4 v0 = acc[ai][bj][m][0], v1 = acc[ai][bj][m][1]; int p0 = 0, p1 = 0;
                    p0 = __builtin_amdgcn_cvt_pk_fp8_f32(v0[0], v0[1], p0, false); p0 = __builtin_amdgcn_cvt_pk_fp8_f32(v0[2], v0[3], p0, true);
                    p1 = __builtin_amdgcn_cvt_pk_fp8_f32(v1[0], v1[1], p1, false); p1 = __builtin_amdgcn_cvt_pk_fp8_f32(v1[2], v1[3], p1, true);
                    *(u32x2*)(rowp + bj * HALF) = (u32x2){(unsigned)p0, (unsigned)p1}; } }
    }
};
struct EpiF32 {
    static constexpr bool PERM = false;
    float* C; int ldc;
    __device__ __forceinline__ void operator()(const f32x4 (&acc)[2][2][4][2], const Unit& u, int wr, int wc, int fr, int fq) const {
        int fr_ = fr; asm volatile("" : "+v"(fr_));
        const int row0 = u.pm * BM + wr * 64 + fr_, col0 = u.pn * BM + wc * 32 + 4 * fq;
#pragma unroll
        for (int ai = 0; ai < 2; ++ai)
#pragma unroll
            for (int m = 0; m < 4; ++m) { float* rowp = C + (size_t)(row0 + ai * HALF + m * 16) * ldc + col0;
#pragma unroll
                for (int bj = 0; bj < 2; ++bj)
#pragma unroll
                    for (int n = 0; n < 2; ++n) *(f32x4*)(rowp + bj * HALF + n * 16) = acc[ai][bj][m][n]; }
    }
};
struct SchedKSplit {
    int G, c; const char* A; const char* B; size_t a_tile, b_tile; int kbytes;
    __device__ __forceinline__ int a_scale(const Unit&) const { return 0x7F7F7F7F; }
    __device__ __forceinline__ bool next(int i, Unit& u) const {
        if (i > 0 || c >= 128) return false;
        const int cu = c >> 3, ks = c & 7; u.pm = ML / BM + (cu >> 3); u.pn = (cu & 7) + 8 * ks;
        u.a = A + (size_t)u.pm * a_tile + (size_t)ks * kbytes; u.b = B + (size_t)(cu & 7) * b_tile + (size_t)ks * kbytes; return true;
    }
};
struct EpiPart {
    static constexpr bool PERM = false;
    float* P;
    __device__ __forceinline__ void operator()(const f32x4 (&acc)[2][2][4][2], const Unit& u, int wr, int wc, int fr, int fq) const {
        int fr_ = fr; asm volatile("" : "+v"(fr_));
        const int row0 = (u.pm - ML / BM) * BM + wr * 64 + fr_, col0 = (u.pn & 7) * BM + wc * 32 + 4 * fq;
        float* base = P + (size_t)(u.pn >> 3) * MC * DM;
#pragma unroll
        for (int ai = 0; ai < 2; ++ai)
#pragma unroll
            for (int m = 0; m < 4; ++m) { float* rowp = base + (size_t)(row0 + ai * HALF + m * 16) * DM + col0;
#pragma unroll
                for (int bj = 0; bj < 2; ++bj)
#pragma unroll
                    for (int n = 0; n < 2; ++n) *(f32x4*)(rowp + bj * HALF + n * 16) = acc[ai][bj][m][n]; }
    }
};
struct EpiResGate {
    static constexpr bool PERM = false;
    float* XR; const float* resL; const float* resC; const float* modL; const float* modC;
    __device__ __forceinline__ void operator()(const f32x4 (&acc)[2][2][4][2], const Unit& u, int wr, int wc, int fr, int fq) const {
        const bool lat = u.pm < ML / BM;
        const float* res = lat ? resL + (size_t)u.pm * BM * DM : resC + (size_t)(u.pm - ML / BM) * BM * DM;
        const float* gate = lat ? modL + (size_t)(u.pm >> 5) * (6 * DM) : modC;
        int fr_ = fr; asm volatile("" : "+v"(fr_));
        const int row0 = wr * 64 + fr_, col0 = u.pn * BM + wc * 32 + 4 * fq;
        float* outp = XR + (size_t)u.pm * BM * DM;
        f32x4 gv[2][2];
#pragma unroll
        for (int bj = 0; bj < 2; ++bj)
#pragma unroll
            for (int n = 0; n < 2; ++n) gv[bj][n] = *(const f32x4*)(gate + col0 + bj * HALF + n * 16);
        f32x4 rc[2][2], rn[2][2] = {};
#define ER_LOAD(it_, r_) do { const size_t off_ = (size_t)(row0 + ((it_) >> 2) * HALF + ((it_) & 3) * 16) * DM + col0; \
        _Pragma("unroll") for (int bj = 0; bj < 2; ++bj) _Pragma("unroll") for (int n = 0; n < 2; ++n) r_[bj][n] = *(const f32x4*)(res + off_ + bj * HALF + n * 16); } while (0)
        ER_LOAD(0, rc);
#pragma unroll
        for (int it = 0; it < 8; ++it) { const int ai = it >> 2, m = it & 3; const size_t off = (size_t)(row0 + ai * HALF + m * 16) * DM + col0;
            if (it + 1 < 8) ER_LOAD(it + 1, rn);
#pragma unroll
            for (int bj = 0; bj < 2; ++bj)
#pragma unroll
                for (int n = 0; n < 2; ++n) { *(f32x4*)(outp + off + bj * HALF + n * 16) = rc[bj][n] + gv[bj][n] * acc[ai][bj][m][n]; rc[bj][n] = rn[bj][n]; }
            asm volatile("" ::: "memory"); }
#undef ER_LOAD
    }
};
struct EpiGate {
    static constexpr bool PERM = true;
    const unsigned char* T; size_t t_stride; u32x4* ys; unsigned char* Y;
    __device__ __forceinline__ void operator()(const f32x4 (&acc)[2][2][4][2], const Unit& u, int wr, int wc, int fr, int fq) const {
        const int n_br = u.pn >> 3; int tid = (wr * 4 + wc) * 64 + fq * 16 + fr; asm volatile("" : "+v"(tid));
        const int row0 = u.pm * BM + wr * 64 + fr, col0 = (u.pn & 7) * BM + wc * 32 + 8 * fq;
        const unsigned char* Tn = T + (size_t)n_br * t_stride;
        u32x2 twc[2], twn[2]; u32x4 pvc[2] = {}, pvn[2] = {};
#define EG_LOAD(it_, tw_, pv_) do { const int ai_ = (it_) >> 2, m_ = (it_) & 3; const size_t off_ = (size_t)(row0 + ai_ * HALF + m_ * 16) * DM + col0; \
        _Pragma("unroll") for (int bj = 0; bj < 2; ++bj) { tw_[bj] = *(const u32x2*)(Tn + off_ + bj * HALF); if (n_br != 0) pv_[bj] = ys[(size_t)(((ai_ * 2 + bj) * 4 + m_) * NTHREADS + tid)]; } } while (0)
        EG_LOAD(0, twc, pvc);
#pragma unroll
        for (int it = 0; it < 8; ++it) { const int ai = it >> 2, m = it & 3; const size_t off = (size_t)(row0 + ai * HALF + m * 16) * DM + col0;
            if (it + 1 < 8) EG_LOAD(it + 1, twn, pvn);
#pragma unroll
            for (int bj = 0; bj < 2; ++bj) {
                const u32x2 tw = twc[bj];
                const f32x2 t0 = __builtin_amdgcn_cvt_pk_f32_fp8((int)tw[0], false), t1 = __builtin_amdgcn_cvt_pk_f32_fp8((int)tw[0], true), t2 = __builtin_amdgcn_cvt_pk_f32_fp8((int)tw[1], false), t3 = __builtin_amdgcn_cvt_pk_f32_fp8((int)tw[1], true);
                const f32x4 a0 = acc[ai][bj][m][0], a1 = acc[ai][bj][m][1];
                float v[8];
                v[0] = sigmoidf_(a0[0]) * t0[0]; v[1] = sigmoidf_(a0[1]) * t0[1]; v[2] = sigmoidf_(a0[2]) * t1[0]; v[3] = sigmoidf_(a0[3]) * t1[1];
                v[4] = sigmoidf_(a1[0]) * t2[0]; v[5] = sigmoidf_(a1[1]) * t2[1]; v[6] = sigmoidf_(a1[2]) * t3[0]; v[7] = sigmoidf_(a1[3]) * t3[1];
                u32x4* sp = ys + (size_t)(((ai * 2 + bj) * 4 + m) * NTHREADS + tid);
                if (n_br != 0) { const u32x4 pv = pvc[bj]; v[0] += bflo(pv.x); v[1] += bfhi(pv.x); v[2] += bflo(pv.y); v[3] += bfhi(pv.y); v[4] += bflo(pv.z); v[5] += bfhi(pv.z); v[6] += bflo(pv.w); v[7] += bfhi(pv.w); }
                if (n_br != 3) { u32x4 w; w.x = cvt_pk_bf16(v[0], v[1]); w.y = cvt_pk_bf16(v[2], v[3]); w.z = cvt_pk_bf16(v[4], v[5]); w.w = cvt_pk_bf16(v[6], v[7]); *sp = w; }
                else { int p0 = 0, p1 = 0; p0 = __builtin_amdgcn_cvt_pk_fp8_f32(v[0], v[1], p0, false); p0 = __builtin_amdgcn_cvt_pk_fp8_f32(v[2], v[3], p0, true);
                    p1 = __builtin_amdgcn_cvt_pk_fp8_f32(v[4], v[5], p1, false); p1 = __builtin_amdgcn_cvt_pk_fp8_f32(v[6], v[7], p1, true);
                    *(u32x2*)(Y + off + bj * HALF) = (u32x2){(unsigned)p0, (unsigned)p1}; }
            }
            twc[0] = twn[0]; twc[1] = twn[1]; pvc[0] = pvn[0]; pvc[1] = pvn[1];
            asm volatile("" ::: "memory"); }
#undef EG_LOAD
    }
};
struct SchedGateCtx {
    int G, c; const char* A; const char* B; size_t a_tile, b_tile;
    __device__ __forceinline__ int a_scale(const Unit&) const { return 0x7F7F7F7F; }
    __device__ __forceinline__ bool next(int i, Unit& u) const {
        if (i > 0 || c >= 64) return false;
        const int tile = c >> 2, n = c & 3; u.pm = ML / BM + (tile >> 3); u.pn = n * 8 + (tile & 7);
        u.a = A + (size_t)u.pm * a_tile; u.b = B + (size_t)u.pn * b_tile; return true;
    }
};
struct EpiGateCtx {
    static constexpr bool PERM = true;
    const unsigned char* T; size_t t_stride; bf16_t* YC;
    __device__ __forceinline__ void operator()(const f32x4 (&acc)[2][2][4][2], const Unit& u, int wr, int wc, int fr, int fq) const {
        const int n_br = u.pn >> 3;
        const int row0 = u.pm * BM + wr * 64 + fr, col0 = (u.pn & 7) * BM + wc * 32 + 8 * fq;
        const unsigned char* Tn = T + (size_t)n_br * t_stride; bf16_t* Yn = YC + (size_t)n_br * MC * DM;
#pragma unroll
        for (int ai = 0; ai < 2; ++ai)
#pragma unroll
            for (int m = 0; m < 4; ++m) { const int row = row0 + ai * HALF + m * 16; const size_t off = (size_t)row * DM + col0, offc = (size_t)(row - ML) * DM + col0;
#pragma unroll
                for (int bj = 0; bj < 2; ++bj) {
                    const u32x2 tw = *(const u32x2*)(Tn + off + bj * HALF);
                    const f32x2 t0 = __builtin_amdgcn_cvt_pk_f32_fp8((int)tw[0], false), t1 = __builtin_amdgcn_cvt_pk_f32_fp8((int)tw[0], true), t2 = __builtin_amdgcn_cvt_pk_f32_fp8((int)tw[1], false), t3 = __builtin_amdgcn_cvt_pk_f32_fp8((int)tw[1], true);
                    const f32x4 a0 = acc[ai][bj][m][0], a1 = acc[ai][bj][m][1];
                    u32x4 w;
                    w.x = cvt_pk_bf16(sigmoidf_(a0[0]) * t0[0], sigmoidf_(a0[1]) * t0[1]); w.y = cvt_pk_bf16(sigmoidf_(a0[2]) * t1[0], sigmoidf_(a0[3]) * t1[1]);
                    w.z = cvt_pk_bf16(sigmoidf_(a1[0]) * t2[0], sigmoidf_(a1[1]) * t2[1]); w.w = cvt_pk_bf16(sigmoidf_(a1[2]) * t3[0], sigmoidf_(a1[3]) * t3[1]);
                    *(u32x4*)(Yn + offc + bj * HALF) = w; }
                asm volatile("" ::: "memory"); }
    }
};

template <class Epi, class Sch, int ELT = 2>
__device__ __forceinline__ void gemm_phase(LAS unsigned char* lds, const Gemm g, const Sch& S, const Epi& E) {
    int tid_ = tid_of_wave(g.wv); asm volatile("" : "+v"(tid_));
    const int tid = tid_, wid = __builtin_amdgcn_readfirstlane(tid >> 6), lane = tid & 63, wr = wid >> 2, wc = wid & 3, fr = lane & 15, fq = lane >> 4;
    const int K = g.K, nt = K * ELT / (BK * 2);
    unsigned voffA[2], voffB[2];
#pragma unroll
    for (int i = 0; i < 2; ++i) { int R, C; stage_rc(tid * 16 + i * 8192, R, C); const int Rb = Epi::PERM ? ((R & ~31) + perm32(R & 31)) : R;
        voffA[i] = (unsigned)(R * g.lda * ELT + C * 2); voffB[i] = (unsigned)(Rb * g.ldb * ELT + C * 2); }
    const size_t kstep = (size_t)(BK * 2);
    const size_t hstepA = (size_t)HALF * g.lda * ELT, hstepB = (size_t)HALF * g.ldb * ELT;
    const unsigned ldsw = (unsigned)wid * 1024u;
    const int aoff = lds_byte(wr * 64 + fr, ELT == 2 ? fq * 8 : fq * 16), boff = lds_byte(wc * 32 + fr, ELT == 2 ? fq * 8 : fq * 16);
#define PG8_SA(b, h) (((b) * 2 + (h)) * HTB)
#define PG8_SB(b, h) ((4 + (b) * 2 + (h)) * HTB)
#define PG8_STAGE(bufoff, gbase, voff) do { _Pragma("unroll") for (int _i = 0; _i < 2; ++_i) \
        __builtin_amdgcn_global_load_lds((const unsigned*)((const char*)(gbase) + (voff)[_i]), (LAS unsigned*)(lds + (bufoff) + ldsw + _i * 8192), 16, 0, 0); } while (0)
#define PG8_LD1(dstf, addr) do { if constexpr (ELT == 2) { (dstf).k[0] = *(const LAS bf16x8*)(lds + (addr)); (dstf).k[1] = *(const LAS bf16x8*)(lds + (addr) + 1024); } \
        else { const u32x4 lo_ = *(const LAS u32x4*)(lds + (addr)), hi_ = *(const LAS u32x4*)(lds + (addr) + 16); \
               (dstf).v = (v8i_t){(int)lo_[0], (int)lo_[1], (int)lo_[2], (int)lo_[3], (int)hi_[0], (int)hi_[1], (int)hi_[2], (int)hi_[3]}; } } while (0)
#define PG8_LDA(dst, b, h) do { _Pragma("unroll") for (int m = 0; m < 4; ++m) PG8_LD1(dst[m], PG8_SA(b, h) + aoff + m * 2048); } while (0)
#define PG8_LDB(dst, b, h) do { _Pragma("unroll") for (int n = 0; n < 2; ++n) PG8_LD1(dst[n], PG8_SB(b, h) + boff + n * 2048); } while (0)
#define PG8_MMA(ai, bj, At, Bt) do { __builtin_amdgcn_s_setprio(1); _Pragma("unroll") for (int m = 0; m < 4; ++m) _Pragma("unroll") for (int n = 0; n < 2; ++n) { \
        if constexpr (ELT == 2) { _Pragma("unroll") for (int k = 0; k < 2; ++k) acc[ai][bj][m][n] = __builtin_amdgcn_mfma_f32_16x16x32_bf16(Bt[n].k[k], At[m].k[k], acc[ai][bj][m][n], 0, 0, 0); } \
        else asm volatile("v_mfma_scale_f32_16x16x128_f8f6f4 %0, %1, %2, %0, %3, %4 op_sel_hi:[0,0,0]" : "+v"(acc[ai][bj][m][n]) : "v"(Bt[n].v), "v"(At[m].v), "v"(scB_), "v"(scA_)); } \
        __builtin_amdgcn_s_setprio(0); } while (0)
#define PG8_WAIT_V(n) asm volatile("s_waitcnt vmcnt(" #n ")" ::: "memory")
#define PG8_WAIT_L(n) asm volatile("s_waitcnt lgkmcnt(" #n ")" ::: "memory")
#define PG8_BAR __builtin_amdgcn_s_barrier()
#define PG8_SCHED __builtin_amdgcn_sched_barrier(0)
    Unit cur, nxt; int ui = 0;
    if (!S.next(0, cur)) return;
    f32x4 acc[2][2][4][2];
#pragma unroll
    for (int a = 0; a < 2; ++a)
#pragma unroll
        for (int b = 0; b < 2; ++b)
#pragma unroll
            for (int m = 0; m < 4; ++m)
#pragma unroll
                for (int n = 0; n < 2; ++n) acc[a][b][m][n] = (f32x4){0.f, 0.f, 0.f, 0.f};
    FragT<ELT> At[4], B0[2], B1[2];
    int scB_ = 0x79797979, scA_ = 0x7F7F7F7F;
    asm volatile("" : "+v"(scB_), "+v"(scA_));
    const char* cA = cur.a; const char* cB = cur.b;
    PG8_STAGE(PG8_SB(0, 0), cB, voffB); PG8_STAGE(PG8_SA(0, 0), cA, voffA); PG8_STAGE(PG8_SB(0, 1), cB + hstepB, voffB); PG8_STAGE(PG8_SA(0, 1), cA + hstepA, voffA);
    if (wr == 1) PG8_BAR;
    PG8_WAIT_V(4); PG8_BAR;
    PG8_STAGE(PG8_SB(1, 0), cB + kstep, voffB); PG8_STAGE(PG8_SA(1, 0), cA + kstep, voffA); PG8_STAGE(PG8_SB(1, 1), cB + hstepB + kstep, voffB);
    PG8_WAIT_V(6); PG8_BAR;
    for (;;) {
        const bool has_next = S.next(ui + 1, nxt);
        const char* nA = has_next ? nxt.a : cA; const char* nB = has_next ? nxt.b : cB;
        if constexpr (ELT == 1) { scA_ = S.a_scale(cur); asm volatile("" : "+v"(scA_)); }
        for (int t = 0; t < nt; t += 2) {
            const bool last = (t == nt - 2);
            const char* a1 = cA + (size_t)(t + 1) * kstep;
            const char* a2 = last ? nA : cA + (size_t)(t + 2) * kstep; const char* b2 = last ? nB : cB + (size_t)(t + 2) * kstep;
            const char* a3 = a2 + kstep; const char* b3 = b2 + kstep;
            PG8_LDB(B0, 0, 0); PG8_SCHED; PG8_LDA(At, 0, 0); PG8_STAGE(PG8_SA(1, 1), a1 + hstepA, voffA);
            PG8_WAIT_L(8); PG8_BAR; PG8_WAIT_L(0); PG8_MMA(0, 0, At, B0); PG8_BAR; PG8_SCHED;
            PG8_LDB(B1, 0, 1); PG8_STAGE(PG8_SB(0, 0), b2, voffB);
            PG8_BAR; PG8_WAIT_L(0); PG8_MMA(0, 1, At, B1); PG8_BAR;
            PG8_LDA(At, 0, 1); PG8_STAGE(PG8_SA(0, 0), a2, voffA);
            PG8_BAR; PG8_WAIT_L(0); PG8_MMA(1, 0, At, B0); PG8_BAR; PG8_SCHED;
            PG8_STAGE(PG8_SB(0, 1), b2 + hstepB, voffB);
            PG8_WAIT_V(6); PG8_BAR; PG8_MMA(1, 1, At, B1); PG8_BAR;
            PG8_LDB(B0, 1, 0); PG8_SCHED; PG8_LDA(At, 1, 0); PG8_STAGE(PG8_SA(0, 1), a2 + hstepA, voffA);
            PG8_WAIT_L(8); PG8_BAR; PG8_WAIT_L(0); PG8_MMA(0, 0, At, B0); PG8_BAR; PG8_SCHED;
            PG8_LDB(B1, 1, 1); PG8_STAGE(PG8_SB(1, 0), b3, voffB);
            PG8_BAR; PG8_WAIT_L(0); PG8_MMA(0, 1, At, B1); PG8_BAR;
            PG8_LDA(At, 1, 1); PG8_STAGE(PG8_SA(1, 0), a3, voffA);
            PG8_BAR; PG8_WAIT_L(0); PG8_MMA(1, 0, At, B0); PG8_BAR; PG8_SCHED;
            PG8_STAGE(PG8_SB(1, 1), b3 + hstepB, voffB);
            PG8_WAIT_V(6); PG8_BAR; PG8_MMA(1, 1, At, B1); PG8_BAR;
        }
        if constexpr (ELT == 1) { PG8_SCHED; asm volatile("s_nop 15\n\ts_nop 15" ::: "memory"); PG8_SCHED; }
        E(acc, cur, wr, wc, fr, fq);
        if (!has_next) break;
#pragma unroll
        for (int a = 0; a < 2; ++a)
#pragma unroll
            for (int b = 0; b < 2; ++b)
#pragma unroll
                for (int m = 0; m < 4; ++m)
#pragma unroll
                    for (int n = 0; n < 2; ++n) acc[a][b][m][n] = (f32x4){0.f, 0.f, 0.f, 0.f};
        cur = nxt; cA = nA; cB = nB; ++ui;
    }
    PG8_WAIT_V(0);
    if (wr == 0) PG8_BAR;
    PG8_BAR;
#undef PG8_SA
#undef PG8_SB
#undef PG8_STAGE
#undef PG8_LD1
#undef PG8_LDA
#undef PG8_LDB
#undef PG8_MMA
#undef PG8_WAIT_V
#undef PG8_WAIT_L
#undef PG8_BAR
#undef PG8_SCHED
}
}

struct Ctx {
    typedef __attribute__((address_space(4))) const unsigned long long* karg_t;
    karg_t tab;
    float* out; unsigned char* ws; LAS unsigned char* lds; int tid, wid, lane, G, bid; int wv;
    __device__ __forceinline__ void fresh() { int t = tid_of_wave(wv); asm volatile("" : "+v"(t)); tid = t; lane = t & 63; wid = __builtin_amdgcn_readfirstlane(t >> 6);
        karg_t tb = (karg_t)__builtin_amdgcn_kernarg_segment_ptr(); asm volatile("" : "+s"(tb)); tab = tb; out = (float*)(__attribute__((address_space(1))) float*)tb[30]; ws = (unsigned char*)(__attribute__((address_space(1))) unsigned char*)tb[31];
        int b_ = blockIdx.x, g_ = gridDim.x; asm volatile("" : "+s"(b_), "+s"(g_)); bid = b_; G = g_; }
    __device__ __forceinline__ const float* inp(int i) const { return (const float*)(__attribute__((address_space(1))) const float*)tab[i]; }
    __device__ __forceinline__ bf16_t* bf(size_t off) const { return (bf16_t*)(ws + off); }
    __device__ __forceinline__ float* f32(size_t off) const { return (float*)(ws + off); }
    __device__ __forceinline__ const float* mod(int l, int v, int k) const { return (const float*)(ws + WS_MOD) + ((size_t)(l * 3 + v) * 6 + k) * DM; }
};

struct TDesc { const float* src; bf16_t* dst; int N, ldd, k0, n0, fp8; };
__device__ __forceinline__ void transpose_load(const Ctx& F, const TDesc& d, f32x4 (&v)[2]) {
    const int tid = F.tid, r = tid >> 4, c4 = (tid & 15) * 4;
#pragma unroll
    for (int i = 0; i < 2; ++i) v[i] = *(const f32x4*)(d.src + (size_t)(d.k0 + r + 32 * i) * d.N + d.n0 + c4);
}
__device__ __forceinline__ void transpose_finish(const Ctx& F, const TDesc& d, const f32x4 (&vv)[2]) {
    LAS float* tile = (LAS float*)F.lds;
    const int tid = F.tid, r = tid >> 4, c4 = (tid & 15) * 4;
    const int N = d.N, ldd = d.ldd, k0 = d.k0, n0 = d.n0; bf16_t* dst = d.dst; (void)N;
#pragma unroll
    for (int i = 0; i < 2; ++i) { const int rr = r + 32 * i; const f32x4 v = vv[i];
        tile[rr * 65 + c4 + 0] = v[0]; tile[rr * 65 + c4 + 1] = v[1]; tile[rr * 65 + c4 + 2] = v[2]; tile[rr * 65 + c4 + 3] = v[3]; }
    __syncthreads();
    if (d.fp8) { if (tid < 256) { const int n = tid >> 2, k16 = (tid & 3) * 16; u32x4 w;
#pragma unroll
            for (int q = 0; q < 4; ++q) { int pk = 0; pk = __builtin_amdgcn_cvt_pk_fp8_f32(tile[(k16 + 4 * q) * 65 + n] * 64.f, tile[(k16 + 4 * q + 1) * 65 + n] * 64.f, pk, false);
                pk = __builtin_amdgcn_cvt_pk_fp8_f32(tile[(k16 + 4 * q + 2) * 65 + n] * 64.f, tile[(k16 + 4 * q + 3) * 65 + n] * 64.f, pk, true); w[q] = (unsigned)pk; }
            *(u32x4*)((unsigned char*)dst + (size_t)(n0 + n) * ldd + k0 + k16) = w; }
        __syncthreads(); return; }
    const int n = tid >> 3, k8 = (tid & 7) * 8;
    float v[8];
#pragma unroll
    for (int j = 0; j < 8; ++j) v[j] = tile[(k8 + j) * 65 + n];
    u32x4 w; w.x = cvt_pk_bf16(v[0], v[1]); w.y = cvt_pk_bf16(v[2], v[3]); w.z = cvt_pk_bf16(v[4], v[5]); w.w = cvt_pk_bf16(v[6], v[7]);
    *(u32x4*)(dst + (size_t)(n0 + n) * ldd + k0 + k8) = w;
    __syncthreads();
}

__device__ __forceinline__ void p0_prologue(const Ctx& F) {
    const int tid = F.tid;
    constexpr int T_WIN = 32 * 59, T_G = 1024, T_B = 256, T_UQ = 72, T_UKV = 64;
    constexpr int O_G = T_WIN, O_B = O_G + 4 * T_G, O_O = O_B + 4 * T_B, O_PQ = O_O + T_G, O_UQ = O_PQ, O_UKV = O_UQ + T_UQ, T_LAYER = O_UKV + T_UKV;
    auto desc = [&](int t) -> TDesc {
        const int l = t / T_LAYER; int j = t % T_LAYER;
        const float* src; bf16_t* dst; int K, N, ldd, fp8 = 0;
        if (j < O_G)        { src = F.inp(I_WIN) + (size_t)l * DM * DIN; dst = (bf16_t*)(F.ws + WS_WIN + (size_t)l * ZLD * DM); K = DM; N = DIN; ldd = DM; fp8 = 1; }
        else if (j < O_B)   { j -= O_G; const int nb = j / T_G; j %= T_G; src = F.inp(I_WGATE) + ((size_t)l * 4 + ((0x1320 >> (4 * nb)) & 3)) * DM * DM; dst = (bf16_t*)(F.ws + WS_WG + ((size_t)l * 4 + nb) * DM * DM); K = DM; N = DM; ldd = DM; fp8 = 1; }
        else if (j < O_O)   { j -= O_B; const int nb = j / T_B; j %= T_B; src = F.inp(I_WBR) + ((size_t)l * 4 + ((0x1320 >> (4 * nb)) & 3)) * 512 * DM; dst = (bf16_t*)(F.ws + WS_WB + ((size_t)l * 4 + nb) * DM * 512); K = 512; N = DM; ldd = 512; fp8 = 1; }
        else if (j < O_PQ)  { j -= O_O; src = F.inp(I_WOUT) + (size_t)l * DM * DM; dst = (bf16_t*)(F.ws + WS_WO + (size_t)l * DM * DM); K = DM; N = DM; ldd = DM; fp8 = 1; }
        else if (j < O_UKV) { j -= O_UQ; src = F.inp(I_WUQ) + (size_t)l * 384 * 768; dst = F.bf(WS_WUQ) + (size_t)l * 768 * 384; K = 384; N = 768; ldd = 384; }
        else                { j -= O_UKV; src = F.inp(I_WUKV) + (size_t)l * 256 * 1024; dst = F.bf(WS_WUKV) + (size_t)l * 1024 * 256; K = 256; N = 1024; ldd = 256; }
        (void)K; const int nnt = N / 64; const int tn = j % nnt, tk = j / nnt;
        return TDesc{src, dst, N, ldd, tk * 64, tn * 64, fp8}; };
    { f32x4 vc[2], vn[2] = {}; TDesc dc = desc(F.bid < DEPTH * T_LAYER ? F.bid : 0), dn = dc;
      if (F.bid < DEPTH * T_LAYER) transpose_load(F, dc, vc);
      for (int t = F.bid; t < DEPTH * T_LAYER; t += F.G) {
          if (t + F.G < DEPTH * T_LAYER) { dn = desc(t + F.G); transpose_load(F, dn, vn); }
          transpose_finish(F, dc, vc);
          dc = dn; vc[0] = vn[0]; vc[1] = vn[1]; } }
    const size_t gtid = (size_t)F.bid * NTHREADS + tid, gsz = (size_t)F.G * NTHREADS;
    for (size_t i = gtid; i < (size_t)DEPTH * DM * DM / 8; i += gsz) { const float* sp = F.inp(I_WPQ) + i * 8; const f32x4 a = *(const f32x4*)sp, b = *(const f32x4*)(sp + 4);
        u32x4 w; w.x = cvt_pk_bf16(a[0], a[1]); w.y = cvt_pk_bf16(a[2], a[3]); w.z = cvt_pk_bf16(b[0], b[1]); w.w = cvt_pk_bf16(b[2], b[3]); *(u32x4*)(F.bf(WS_WPQ) + i * 8) = w; }
    for (size_t i = gtid; i < (size_t)DEPTH * 64 * DM / 16; i += gsz) { const size_t l = i / (64 * DM / 16), r = i % (64 * DM / 16);
        *(u32x4*)(F.ws + WS_WIN + (l * ZLD + DIN) * DM + r * 16) = (u32x4){0u, 0u, 0u, 0u}; }
    if constexpr (PEER_UBITS == 4 && PEER_VBITS == 4) {
        const int nrow = 2 * DEPTH * NEXP, gw = (int)(gtid >> 6), nw = (int)(gsz >> 6), lane = F.lane;
        f32x4 cur[8], nxt[8] = {}, nx2[8] = {};
        auto ld = [&](int r, f32x4 (&d)[8]) { const float* sp = (r < DEPTH * NEXP ? F.inp(I_PU) + (size_t)r * DM : F.inp(I_PV) + (size_t)(r - DEPTH * NEXP) * DM) + lane * 4;
            _Pragma("unroll") for (int q = 0; q < 8; ++q) d[q] = *(const f32x4*)(sp + q * 256); };
        if (gw < nrow) ld(gw, cur);
        if (gw + nw < nrow) ld(gw + nw, nxt);
        for (int r = gw; r < nrow; r += nw) {
            if (r + 2 * nw < nrow) ld(r + 2 * nw, nx2);
            const bool isU = r < DEPTH * NEXP; const float sc = isU ? 90.50966799187809f : 2.0f;
            unsigned char* dst = F.ws + (isU ? WS_PU + (size_t)r * 1024 : WS_PV + (size_t)(r - DEPTH * NEXP) * 1024) + lane * 2;
#pragma unroll
            for (int q = 0; q < 8; ++q) { unsigned w = 0u;
#pragma unroll
                for (int e = 0; e < 4; ++e) { const float y = cur[q][e] * sc; const float ay = fabsf(y);
                    unsigned code = ay < 0.25f ? 0u : ay < 0.75f ? 1u : ay < 1.25f ? 2u : ay < 1.75f ? 3u : ay < 2.5f ? 4u : ay < 3.5f ? 5u : ay < 5.0f ? 6u : 7u;
                    code |= y < 0.f ? 8u : 0u; w |= code << (4 * e); }
                *(unsigned short*)(dst + q * 128) = (unsigned short)w; cur[q] = nxt[q]; nxt[q] = nx2[q]; }
        }
    } else
    { const size_t nch = (size_t)DEPTH * NEXP * 64;
      for (size_t i = gtid; i < 2 * nch; i += gsz) { const bool isU = i < nch; const size_t j = isU ? i : i - nch; const float sc = isU ? 90.50966799187809f : 2.0f;
          const int bits = isU ? PEER_UBITS : PEER_VBITS;
          const float* s = (isU ? F.inp(I_PU) : F.inp(I_PV)) + j * 32; unsigned w[6] = {0u, 0u, 0u, 0u, 0u, 0u};
#pragma unroll
          for (int q = 0; q < 8; ++q) { const f32x4 a = *(const f32x4*)(s + 4 * q);
#pragma unroll
              for (int e = 0; e < 4; ++e) { const float y = a[e] * sc; const int el = q * 4 + e;
                  if (bits == 6) { const float ay = fminf(fabsf(y), 7.5f); unsigned code;
                      if (ay < 1.0f) code = (unsigned)__float2int_rn(ay * 8.0f); else if (ay < 2.0f) code = 8u + (unsigned)__float2int_rn((ay - 1.0f) * 8.0f);
                      else if (ay < 4.0f) code = 16u + (unsigned)__float2int_rn((ay * 0.5f - 1.0f) * 8.0f); else code = 24u + (unsigned)__float2int_rn((ay * 0.25f - 1.0f) * 8.0f);
                      code |= y < 0.f ? 32u : 0u;
                      const int bit = 6 * el, d = bit >> 5, o = bit & 31; w[d] |= code << o; if (o > 26) w[d + 1] |= code >> (32 - o); }
                  else { const float ay = fabsf(y);
                      unsigned code = ay < 0.25f ? 0u : ay < 0.75f ? 1u : ay < 1.25f ? 2u : ay < 1.75f ? 3u : ay < 2.5f ? 4u : ay < 3.5f ? 5u : ay < 5.0f ? 6u : 7u;
                      code |= y < 0.f ? 8u : 0u; w[el >> 3] |= code << (4 * (el & 7)); } } }
          const int rowb = isU ? PEER_UROWB : PEER_VROWB;
          unsigned char* dst = F.ws + (isU ? WS_PU : WS_PV) + (j >> 6) * rowb; const int ln = (int)(j & 63);
          *(u32x4*)(dst + ln * 16) = (u32x4){w[0], w[1], w[2], w[3]}; if (bits == 6) *(u32x2*)(dst + 1024 + ln * 8) = (u32x2){w[4], w[5]}; } }
    for (size_t i = gtid; i < (size_t)DEPTH * 256 * 256; i += gsz) { const int l = (int)(i >> 16), r = (int)(i >> 8) & 255, c = (int)i & 255;
        const float v = ((r >> 7) == (c >> 7)) ? F.inp(I_PKEYS)[(((size_t)l * 2 + (r >> 7)) * 128 + (r & 127)) * 128 + (c & 127)] : 0.f;
        F.bf(WS_KB)[i] = f2bf(v); }
    for (size_t i = gtid; i < (size_t)512 * 1024; i += gsz) { const int n = (int)(i >> 10), kc = (int)i & 1023; const int g = n >> 7, m = n & 127, part = kc >> 9, g2 = (kc >> 7) & 3, c = kc & 127;
        float v = 0.f; if (g == g2) { const float x = (float)((c * m) & 127) * (1.0f / 64.0f); v = part == 0 ? cospif(x) : sinpif(x); }
        (F.ws + WS_WDFT)[i] = f2fp8(v * 64.f); }
    for (size_t i = gtid; i < (size_t)SEQ * 32; i += gsz) { const int pos = (int)(i >> 5), idx = (int)i & 31; const int row = pos >> 6, col = pos & 63;
        const float inv = powf(10000.0f, -(float)(idx & 15) / 16.0f); const float ang = (float)(idx < 16 ? row : col) * inv;
        float s, c; sincosf(ang, &s, &c); F.f32(WS_ROPE)[i * 2] = c; F.f32(WS_ROPE)[i * 2 + 1] = s; }
    { LAS float* sil = (LAS float*)F.lds;
      LAS float* red = sil + 3 * DM;
      const int wid = F.wid, lane = F.lane;
      __syncthreads();
      for (int i = tid; i < 3 * DM; i += NTHREADS) { const int v = i / DM, k = i % DM; const float x = v < 2 ? F.inp(I_C)[v * DM + k] : F.inp(I_CCTX)[k]; sil[i] = x / (1.0f + __expf(-x)); }
      __syncthreads();
      for (int item = F.bid; item < DEPTH * 128; item += F.G) {
          const int l = item / 128, col0 = (item % 128) * 96; const int c4 = ((lane & 31) < 24 ? (lane & 31) : 0) * 4, rsel = lane >> 5;
          const float* w = F.inp(I_WADA) + ((size_t)l * DM + (size_t)wid * 256 + rsel) * (6 * DM) + col0 + c4;
          f32x4 a0 = {0.f, 0.f, 0.f, 0.f}, a1 = a0, a2 = a0;
#pragma unroll 8
          for (int i = 0; i < 128; ++i) { const f32x4 wv = *(const f32x4*)(w + (size_t)(2 * i) * (6 * DM)); const int kk = wid * 256 + 2 * i + rsel;
              a0 += wv * sil[kk]; a1 += wv * sil[DM + kk]; a2 += wv * sil[2 * DM + kk]; }
          LAS float* rp = red + ((wid * 2 + rsel) * 32 + (lane & 31)) * 12;
#pragma unroll
          for (int e = 0; e < 4; ++e) { rp[e] = a0[e]; rp[4 + e] = a1[e]; rp[8 + e] = a2[e]; }
          __syncthreads();
          if (tid < 288) { const int q = tid / 12, j = tid % 12; const int v = j >> 2, e = j & 3; float sacc = 0.f;
#pragma unroll
              for (int p = 0; p < 16; ++p) sacc += red[(p * 32 + q) * 12 + j];
              const int col = col0 + q * 4 + e;
              F.f32(WS_MOD)[(size_t)(l * 3 + v) * 6 * DM + col] = sacc + F.inp(I_BADA)[(size_t)l * 6 * DM + col]; }
          __syncthreads();
      } }
}

__device__ __forceinline__ void norm_rows(const Ctx& F, const float* __restrict__ xl, const float* __restrict__ xc, const float* __restrict__ g, int l, int kshift, int kscale, int nrows, bool fp8copy,
                                          const float* __restrict__ part = nullptr, const float* __restrict__ pgate = nullptr, float* __restrict__ xw = nullptr, bool bf16out = true) {
    for (int row = F.bid * NWAVES + F.wid; row < nrows; row += F.G * NWAVES) {
        const float* xr = row < ML ? xl + (size_t)row * DM : xc + (size_t)(row - ML) * DM;
        const int v = row < ML ? (row >> 13) : 2;
        const float* sh = F.mod(l, v, kshift); const float* sc = F.mod(l, v, kscale);
        f32x4 x[8]; float ss = 0.f;
#pragma unroll
        for (int i = 0; i < 4; ++i) { x[2 * i] = *(const f32x4*)(xr + i * 512 + F.lane * 8); x[2 * i + 1] = *(const f32x4*)(xr + i * 512 + F.lane * 8 + 4); }
        if (part != nullptr && row >= ML) {
#pragma unroll
            for (int i = 0; i < 4; ++i) { const int c = i * 512 + F.lane * 8; f32x4 s0 = {0.f, 0.f, 0.f, 0.f}, s1 = s0;
#pragma unroll
                for (int k = 0; k < 8; ++k) { const float* pp = part + ((size_t)k * MC + (row - ML)) * DM + c; s0 += *(const f32x4*)pp; s1 += *(const f32x4*)(pp + 4); }
                x[2 * i] += *(const f32x4*)(pgate + c) * s0; x[2 * i + 1] += *(const f32x4*)(pgate + c + 4) * s1;
                *(f32x4*)(xw + (size_t)(row - ML) * DM + c) = x[2 * i]; *(f32x4*)(xw + (size_t)(row - ML) * DM + c + 4) = x[2 * i + 1]; } }
#pragma unroll
        for (int i = 0; i < 4; ++i) {
#pragma unroll
            for (int e = 0; e < 4; ++e) ss += x[2 * i][e] * x[2 * i][e] + x[2 * i + 1][e] * x[2 * i + 1][e]; }
        ss = wave_sum(ss);
        const float rs = rsqrtf(ss * (1.0f / DM) + 1e-6f);
        bf16_t* hr = F.bf(WS_HN) + (size_t)row * DM;
#pragma unroll
        for (int i = 0; i < 4; ++i) { const int c = i * 512 + F.lane * 8; float o[8];
#pragma unroll
            for (int h = 0; h < 2; ++h) { const f32x4 gv = *(const f32x4*)(g + c + 4 * h), sv = *(const f32x4*)(sc + c + 4 * h), tv = *(const f32x4*)(sh + c + 4 * h);
#pragma unroll
                for (int e = 0; e < 4; ++e) o[4 * h + e] = (x[2 * i + h][e] * rs * gv[e]) * (1.0f + sv[e]) + tv[e]; }
            u32x4 w; w.x = cvt_pk_bf16(o[0], o[1]); w.y = cvt_pk_bf16(o[2], o[3]); w.z = cvt_pk_bf16(o[4], o[5]); w.w = cvt_pk_bf16(o[6], o[7]);
            if (bf16out) *(u32x4*)(hr + c) = w;
            if (fp8copy) { int p0 = 0, p1 = 0; p0 = __builtin_amdgcn_cvt_pk_fp8_f32(o[0], o[1], p0, false); p0 = __builtin_amdgcn_cvt_pk_fp8_f32(o[2], o[3], p0, true);
                p1 = __builtin_amdgcn_cvt_pk_fp8_f32(o[4], o[5], p1, false); p1 = __builtin_amdgcn_cvt_pk_fp8_f32(o[6], o[7], p1, true);
                *(u32x2*)(F.ws + WS_HN8 + (size_t)row * DM + c) = (u32x2){(unsigned)p0, (unsigned)p1}; } }
    }
}

__device__ __forceinline__ void z_post_rows(const Ctx& F, int l) {
    const float* gq = F.inp(I_GQ) + l * 384; const float* gkv = F.inp(I_GKV) + l * 256;
    for (int row = F.bid * NWAVES + F.wid; row < MT; row += F.G * NWAVES) {
        bf16_t* z = F.bf(WS_Z) + (size_t)row * ZLD; const int lane = F.lane; const bool lat = row < ML;
        const int pos = row & (SEQ - 1); const int d = lane & 31, hv = lane >> 5;
        float q[6], kv[4], x1[5], x2[5]; float sq = 0.f, sk = 0.f, cs = 1.f, sn = 0.f;
#pragma unroll
        for (int i = 0; i < 6; ++i) q[i] = bf2f(z[ZC_QLAT + i * 64 + lane]);
#pragma unroll
        for (int i = 0; i < 4; ++i) kv[i] = bf2f(z[ZC_KVLAT + i * 64 + lane]);
        if (lat) { cs = F.f32(WS_ROPE)[((size_t)pos * 32 + d) * 2]; sn = F.f32(WS_ROPE)[((size_t)pos * 32 + d) * 2 + 1];
#pragma unroll
            for (int s5 = 0; s5 < 5; ++s5) { const int vi = s5 * 2 + hv; const int vo = vi == 0 ? ZC_KROPE : ZC_DK + (vi - 1) * 64;
                x1[s5] = vi < 9 ? bf2f(z[vo + d]) : 0.f; x2[s5] = vi < 9 ? bf2f(z[vo + d + 32]) : 0.f; } }
#pragma unroll
        for (int i = 0; i < 6; ++i) sq += q[i] * q[i];
#pragma unroll
        for (int i = 0; i < 4; ++i) sk += kv[i] * kv[i];
        sq = wave_sum(sq); sk = wave_sum(sk);
        const float rq = rsqrtf(sq * (1.0f / 384.0f) + 1e-6f), rk = rsqrtf(sk * (1.0f / 256.0f) + 1e-6f);
#pragma unroll
        for (int i = 0; i < 6; ++i) z[ZC_QLAT + i * 64 + lane] = f2bf(q[i] * rq * gq[i * 64 + lane]);
#pragma unroll
        for (int i = 0; i < 4; ++i) z[ZC_KVLAT + i * 64 + lane] = f2bf(kv[i] * rk * gkv[i * 64 + lane]);
        unsigned char* k8 = F.ws + WS_K8 + (size_t)row * 1024 + 128;
        if (lat) {
#pragma unroll
            for (int s5 = 0; s5 < 5; ++s5) { const int vi = s5 * 2 + hv;
                if (vi < 9) { bf16_t* p = z + (vi == 0 ? ZC_KROPE : ZC_DK + (vi - 1) * 64);
                    const float y1 = x1[s5] * cs - x2[s5] * sn, y2 = x2[s5] * cs + x1[s5] * sn;
                    p[d] = f2bf(y1); p[d + 32] = f2bf(y2);
                    const unsigned char e1 = f2fp8(y1), e2 = f2fp8(y2);
                    if (vi == 0) {
#pragma unroll
                        for (int hh = 0; hh < 4; ++hh) { k8[hh * 256 + d] = e1; k8[hh * 256 + d + 32] = e2; } }
                    else { unsigned char* kd = F.ws + WS_KD8 + (size_t)row * 512 + (vi - 1) * 64; kd[d] = e1; kd[d + 32] = e2; } } } }
        else { const unsigned char e = f2fp8(bf2f(z[ZC_KROPE + lane]));
#pragma unroll
            for (int hh = 0; hh < 4; ++hh) k8[hh * 256 + lane] = e;
            unsigned char* kd = F.ws + WS_KD8 + (size_t)row * 512;
#pragma unroll
            for (int i = 0; i < 8; ++i) kd[i * 64 + lane] = f2fp8(bf2f(z[ZC_DK + i * 64 + lane])); }
    }
}

__device__ __forceinline__ void v8t_build(const Ctx& F) {
    const int lane = F.lane;
    for (int item = F.bid * NWAVES + F.wid; item < (MT / 64) * 8; item += F.G * NWAVES) { const int gt = (item >> 2) % (MT / 64), h = item & 3; const bool dif = item >= (MT / 64) * 4;
        const unsigned* src = (dif ? (const unsigned*)(F.bf(WS_Z) + (size_t)gt * 64 * ZLD + ZC_DV + h * 128) : (const unsigned*)(F.bf(WS_KV) + (size_t)gt * 64 * 1024 + h * 256 + 128)) + lane;
        const size_t pitch = dif ? ZLD / 2 : 512;
        unsigned w0[16], w1[16];
#pragma unroll
        for (int i = 0; i < 16; ++i) { w0[i] = 0u; w1[i] = 0u; }
#pragma unroll
        for (int kk = 0; kk < 64; ++kk) { const unsigned v = src[(size_t)kk * pitch];
            const int pos = 32 * ((kk >> 2) & 1) + 16 * (kk >> 5) + (kk & 3) + 4 * ((kk >> 3) & 3);
            const unsigned pk = (unsigned)__builtin_amdgcn_cvt_pk_fp8_f32(bflo(v), bfhi(v), 0, false);
            w0[pos >> 2] |= (pk & 0xFFu) << (8 * (pos & 3)); w1[pos >> 2] |= ((pk >> 8) & 0xFFu) << (8 * (pos & 3)); }
        unsigned char* dst = F.ws + (dif ? WS_VD8T : WS_V8T) + (((size_t)h * (MT / 64) + gt) * 128 + 2 * lane) * 64;
#pragma unroll
        for (int i = 0; i < 4; ++i) { *(u32x4*)(dst + 16 * i) = (u32x4){w0[4 * i], w0[4 * i + 1], w0[4 * i + 2], w0[4 * i + 3]}; *(u32x4*)(dst + 64 + 16 * i) = (u32x4){w1[4 * i], w1[4 * i + 1], w1[4 * i + 2], w1[4 * i + 3]}; }
    }
}

__device__ __forceinline__ void conv_units(const Ctx& F, int l) {
    LAS float* u = (LAS float*)F.lds;
    LAS float* y = u + 94 * 128;
    int tid_ = tid_of_wave(F.wid); asm volatile("" : "+v"(tid_)); const int tid = tid_;
    constexpr int NT_L = ML / 64, NT_ALL = MT / 64;
    const int ntile = l == 0 ? NT_ALL : NT_L;
    const int un0 = (F.bid + 58) % F.G;
    if (un0 >= ntile * 4) return;
    int grp_w = un0 & 3;
    const int ch = tid & 127, tq = tid >> 7, lane = tid & 63;
    float w[31], bias, g0, g1, b0, b1;
    auto load_w = [&](int grp) { const int cg = grp * 128 + ch;
        _Pragma("unroll") for (int j = 0; j < 31; ++j) w[j] = F.inp(I_WDW)[((size_t)l * 31 + j) * 512 + cg];
        bias = F.inp(I_BDW)[l * 512 + cg];
        g0 = F.inp(I_GCN)[l * 512 + grp * 128 + lane]; g1 = F.inp(I_GCN)[l * 512 + grp * 128 + 64 + lane];
        b0 = F.inp(I_BCN)[l * 512 + grp * 128 + lane]; b1 = F.inp(I_BCN)[l * 512 + grp * 128 + 64 + lane]; };
    load_w(grp_w);
    auto geom = [&](int un, int& rowbase, int& n0, int& L) { const int tile = un >> 2;
        if (tile < NT_L) { const int b = tile >> 7; rowbase = b * SEQ; n0 = (tile & 127) * 64; L = SEQ; } else { const int t2 = tile - NT_L; const int b = t2 >> 2; rowbase = ML + b * CTXL; n0 = (t2 & 3) * 64; L = CTXL; } };
    u32x4 pa[3], pg[3];
    auto fetch = [&](int un) { int rowbase, n0, L; geom(un, rowbase, n0, L); const int grp = un & 3;
        _Pragma("unroll") for (int i = 0; i < 3; ++i) { const int p = tid + i * NTHREADS; const int r = p >> 4, c8 = (p & 15) * 8; const int n = n0 - 15 + r;
            pa[i] = (u32x4){0u, 0u, 0u, 0u}; pg[i] = pa[i];
            if (p < 94 * 16 && n >= 0 && n < L) { const bf16_t* zp = F.bf(WS_Z) + (size_t)(rowbase + n) * ZLD + ZC_C + grp * 128 + c8; pa[i] = *(const u32x4*)zp; pg[i] = *(const u32x4*)(zp + 512); } } };
    fetch(un0);
    for (int un = un0; un < ntile * 4; un += F.G) {
        const int grp = un & 3; int rowbase, n0, L; geom(un, rowbase, n0, L);
        if (grp != grp_w) { grp_w = grp; load_w(grp); }
        __syncthreads();
#pragma unroll
        for (int i = 0; i < 3; ++i) { const int p = tid + i * NTHREADS; const int r = p >> 4, c8 = (p & 15) * 8;
            if (p < 94 * 16) { const u32x4 a = pa[i], g = pg[i];
                f32x4 o0, o1;
                o0[0] = bflo(a.x) * sigmoidf_(bflo(g.x)); o0[1] = bfhi(a.x) * sigmoidf_(bfhi(g.x)); o0[2] = bflo(a.y) * sigmoidf_(bflo(g.y)); o0[3] = bfhi(a.y) * sigmoidf_(bfhi(g.y));
                o1[0] = bflo(a.z) * sigmoidf_(bflo(g.z)); o1[1] = bfhi(a.z) * sigmoidf_(bfhi(g.z)); o1[2] = bflo(a.w) * sigmoidf_(bflo(g.w)); o1[3] = bfhi(a.w) * sigmoidf_(bfhi(g.w));
                *(LAS f32x4*)(u + r * 128 + c8) = o0; *(LAS f32x4*)(u + r * 128 + c8 + 4) = o1; } }
        if (un + F.G < ntile * 4) fetch(un + F.G);
        __syncthreads();
        {
          float uw[46];
#pragma unroll
          for (int i = 0; i < 46; ++i) uw[i] = u[(tq * 16 + i) * 128 + ch];
#pragma unroll
          for (int t = 0; t < 16; ++t) { float a = bias;
#pragma unroll
              for (int j = 0; j < 31; ++j) a = fmaf(uw[t + j], w[j], a);
              y[(tq * 16 + t) * 128 + ch] = a; } }
        __syncthreads();
        { const int tb = F.wid * 8;
#pragma unroll
          for (int i = 0; i < 8; ++i) { const int t = tb + i; const float v0 = y[t * 128 + lane], v1 = y[t * 128 + 64 + lane];
              const float mu = wave_sum(v0 + v1) * (1.0f / 128.0f); const float d0 = v0 - mu, d1 = v1 - mu;
              const float var = wave_sum(d0 * d0 + d1 * d1) * (1.0f / 128.0f); const float rs = rsqrtf(var + 1e-5f);
              const float y0 = d0 * rs * g0 + b0, y1 = d1 * rs * g1 + b1;
              unsigned char* o = F.ws + WS_BR + ((size_t)1 * MT + rowbase + n0 + t) * 512 + grp * 128;
              o[lane] = f2fp8(y0 * sigmoidf_(y0)); o[64 + lane] = f2fp8(y1 * sigmoidf_(y1)); } }
    }
    __syncthreads();
}

namespace att {
#define SBAR() __builtin_amdgcn_sched_barrier(0)
__device__ __forceinline__ int crow(int r, int hi) { return (r & 3) + 8 * (r >> 2) + 4 * hi; }
template <int OFF> __device__ __forceinline__ s16x4 tr_read(int vb) { s16x4 r; asm volatile("ds_read_b64_tr_b16 %0, %1 offset:%2" : "=&v"(r) : "v"(vb), "i"(OFF) : "memory"); return r; }
__device__ __forceinline__ int v_rd_base(int lane) { return ((lane & 3) << 3) | (((lane >> 2) & 3) << 6) | (((lane >> 4) & 1) << 5) | (((lane >> 5) & 1) << 8); }
constexpr int v_rd_off(int d0, int ks, int half) { return d0 * 512 + ks * 4096 + half * 2048; }
template <int D0> __device__ __forceinline__ void pv_one(f32x16& od, int vb, bf16x8 pa0, bf16x8 pa1, bf16x8 pa2, bf16x8 pa3) {
    const s16x4 l0 = tr_read<v_rd_off(D0, 0, 0)>(vb), h0 = tr_read<v_rd_off(D0, 0, 1)>(vb), l1 = tr_read<v_rd_off(D0, 1, 0)>(vb), h1 = tr_read<v_rd_off(D0, 1, 1)>(vb);
    const s16x4 l2 = tr_read<v_rd_off(D0, 2, 0)>(vb), h2 = tr_read<v_rd_off(D0, 2, 1)>(vb), l3 = tr_read<v_rd_off(D0, 3, 0)>(vb), h3 = tr_read<v_rd_off(D0, 3, 1)>(vb);
    asm volatile("s_waitcnt lgkmcnt(0)" ::: "memory"); SBAR();
#define PK(L, H) (bf16x8){L[0], L[1], L[2], L[3], H[0], H[1], H[2], H[3]}
    od = __builtin_amdgcn_mfma_f32_32x32x16_bf16(pa0, PK(l0, h0), od, 0, 0, 0);
    od = __builtin_amdgcn_mfma_f32_32x32x16_bf16(pa1, PK(l1, h1), od, 0, 0, 0);
    od = __builtin_amdgcn_mfma_f32_32x32x16_bf16(pa2, PK(l2, h2), od, 0, 0, 0);
    od = __builtin_amdgcn_mfma_f32_32x32x16_bf16(pa3, PK(l3, h3), od, 0, 0, 0);
#undef PK
}
__device__ __forceinline__ void pv_d0(f32x16* o, int vb, bf16x8 pa0, bf16x8 pa1, bf16x8 pa2, bf16x8 pa3) {
    pv_one<0>(o[0], vb, pa0, pa1, pa2, pa3); pv_one<1>(o[1], vb, pa0, pa1, pa2, pa3); pv_one<2>(o[2], vb, pa0, pa1, pa2, pa3); pv_one<3>(o[3], vb, pa0, pa1, pa2, pa3);
}
template <int D0> __device__ __forceinline__ void pv_one2(f32x16& od0, f32x16& od1, int vb, bf16x8 a0, bf16x8 a1, bf16x8 a2, bf16x8 a3, bf16x8 b0, bf16x8 b1, bf16x8 b2, bf16x8 b3) {
    const s16x4 l0 = tr_read<v_rd_off(D0, 0, 0)>(vb), h0 = tr_read<v_rd_off(D0, 0, 1)>(vb), l1 = tr_read<v_rd_off(D0, 1, 0)>(vb), h1 = tr_read<v_rd_off(D0, 1, 1)>(vb);
    const s16x4 l2 = tr_read<v_rd_off(D0, 2, 0)>(vb), h2 = tr_read<v_rd_off(D0, 2, 1)>(vb), l3 = tr_read<v_rd_off(D0, 3, 0)>(vb), h3 = tr_read<v_rd_off(D0, 3, 1)>(vb);
    asm volatile("s_waitcnt lgkmcnt(0)" ::: "memory"); SBAR();
#define PK(L, H) (bf16x8){L[0], L[1], L[2], L[3], H[0], H[1], H[2], H[3]}
    const bf16x8 v0 = PK(l0, h0), v1 = PK(l1, h1), v2 = PK(l2, h2), v3 = PK(l3, h3);
    od0 = __builtin_amdgcn_mfma_f32_32x32x16_bf16(a0, v0, od0, 0, 0, 0); od1 = __builtin_amdgcn_mfma_f32_32x32x16_bf16(b0, v0, od1, 0, 0, 0);
    od0 = __builtin_amdgcn_mfma_f32_32x32x16_bf16(a1, v1, od0, 0, 0, 0); od1 = __builtin_amdgcn_mfma_f32_32x32x16_bf16(b1, v1, od1, 0, 0, 0);
    od0 = __builtin_amdgcn_mfma_f32_32x32x16_bf16(a2, v2, od0, 0, 0, 0); od1 = __builtin_amdgcn_mfma_f32_32x32x16_bf16(b2, v2, od1, 0, 0, 0);
    od0 = __builtin_amdgcn_mfma_f32_32x32x16_bf16(a3, v3, od0, 0, 0, 0); od1 = __builtin_amdgcn_mfma_f32_32x32x16_bf16(b3, v3, od1, 0, 0, 0);
#undef PK
}
typedef int v8i_att_t __attribute__((ext_vector_type(8)));
__device__ __forceinline__ void softmax_tile8(f32x16& p0, f32x16& p1, float C, float& m_reg, float& l_reg, float& alpha, v8i_att_t& pa) {
    float pmax = p0[0];
#pragma unroll
    for (int r = 1; r < 16; ++r) pmax = fmaxf(pmax, p0[r]);
#pragma unroll
    for (int r = 0; r < 16; ++r) pmax = fmaxf(pmax, p1[r]);
    { auto rr = __builtin_amdgcn_permlane32_swap(__float_as_uint(pmax), __float_as_uint(pmax), false, false); pmax = fmaxf(__uint_as_float(rr[0]), __uint_as_float(rr[1])); }
    float mn;
    if (__builtin_expect(__all((pmax - m_reg) * C <= 8.5f), 1)) { mn = m_reg; alpha = 1.f; }
    else { mn = fmaxf(m_reg, pmax); alpha = __builtin_amdgcn_exp2f((m_reg - mn) * C); m_reg = mn; }
    const float mnC = -mn * C;
#pragma unroll
    for (int r = 0; r < 16; ++r) { p0[r] = __builtin_amdgcn_exp2f(fmaf(p0[r], C, mnC)); p1[r] = __builtin_amdgcn_exp2f(fmaf(p1[r], C, mnC)); }
    float ps = 0.f;
#pragma unroll
    for (int r = 0; r < 16; ++r) ps += p0[r] + p1[r];
    { auto rr = __builtin_amdgcn_permlane32_swap(__float_as_uint(ps), __float_as_uint(ps), false, false); ps = __uint_as_float(rr[0]) + __uint_as_float(rr[1]); }
    l_reg = l_reg * alpha + ps;
#pragma unroll
    for (int w = 0; w < 4; ++w) { int a_ = 0, b_ = 0;
        a_ = __builtin_amdgcn_cvt_pk_fp8_f32(p0[4 * w], p0[4 * w + 1], a_, false); a_ = __builtin_amdgcn_cvt_pk_fp8_f32(p0[4 * w + 2], p0[4 * w + 3], a_, true);
        b_ = __builtin_amdgcn_cvt_pk_fp8_f32(p1[4 * w], p1[4 * w + 1], b_, false); b_ = __builtin_amdgcn_cvt_pk_fp8_f32(p1[4 * w + 2], p1[4 * w + 3], b_, true);
        pa[w] = a_; pa[4 + w] = b_; }
}
__device__ __forceinline__ void softmax_tile(f32x16& p0, f32x16& p1, float C, float& m_reg, float& l_reg, float& alpha, bf16x8& pa0, bf16x8& pa1, bf16x8& pa2, bf16x8& pa3) {
    float pmax = p0[0];
#pragma unroll
    for (int r = 1; r < 16; ++r) pmax = fmaxf(pmax, p0[r]);
#pragma unroll
    for (int r = 0; r < 16; ++r) pmax = fmaxf(pmax, p1[r]);
    { auto rr = __builtin_amdgcn_permlane32_swap(__float_as_uint(pmax), __float_as_uint(pmax), false, false); pmax = fmaxf(__uint_as_float(rr[0]), __uint_as_float(rr[1])); }
    float mn;
    if (__builtin_expect(__all((pmax - m_reg) * C <= 11.541560327111707f), 1)) { mn = m_reg; alpha = 1.f; }
    else { mn = fmaxf(m_reg, pmax); alpha = __builtin_amdgcn_exp2f((m_reg - mn) * C); m_reg = mn; }
    const float mnC = -mn * C;
#pragma unroll
    for (int r = 0; r < 16; ++r) { p0[r] = __builtin_amdgcn_exp2f(fmaf(p0[r], C, mnC)); p1[r] = __builtin_amdgcn_exp2f(fmaf(p1[r], C, mnC)); }
    float ps = 0.f;
#pragma unroll
    for (int r = 0; r < 16; ++r) ps += p0[r] + p1[r];
    { auto rr = __builtin_amdgcn_permlane32_swap(__float_as_uint(ps), __float_as_uint(ps), false, false); ps = __uint_as_float(rr[0]) + __uint_as_float(rr[1]); }
    l_reg = l_reg * alpha + ps;
#define PK4(P, BASE, OUT) do { unsigned a0 = cvt_pk_bf16(P[BASE + 0], P[BASE + 1]), a1 = cvt_pk_bf16(P[BASE + 2], P[BASE + 3]);   \
    unsigned b0 = cvt_pk_bf16(P[BASE + 4], P[BASE + 5]), b1 = cvt_pk_bf16(P[BASE + 6], P[BASE + 7]);                              \
    auto r0 = __builtin_amdgcn_permlane32_swap(a0, b0, false, false); auto r1 = __builtin_amdgcn_permlane32_swap(a1, b1, false, false); \
    u32x4 w = {r0[0], r1[0], r0[1], r1[1]}; OUT = *reinterpret_cast<bf16x8*>(&w); } while (0)
    PK4(p0, 0, pa0); PK4(p0, 8, pa1); PK4(p1, 0, pa2); PK4(p1, 8, pa3);
#undef PK4
}
__device__ __forceinline__ void rope_pair(bf16x8& x1, bf16x8& x2, const float* __restrict__ cs) {
    float c[16];
#pragma unroll
    for (int i = 0; i < 4; ++i) { const f32x4 v = *(const f32x4*)(cs + 4 * i); c[4 * i] = v[0]; c[4 * i + 1] = v[1]; c[4 * i + 2] = v[2]; c[4 * i + 3] = v[3]; }
#pragma unroll
    for (int j = 0; j < 8; ++j) { const float a = bf2f((bf16_t)x1[j]), b = bf2f((bf16_t)x2[j]);
        x1[j] = (short)f2bf(a * c[2 * j] - b * c[2 * j + 1]); x2[j] = (short)f2bf(b * c[2 * j] + a * c[2 * j + 1]); }
}

constexpr int SHM_V = 64 * 128 * 2;
template <int MODE>
__device__ __forceinline__ void attn_unit(const Ctx& F, int l, int b, int h, int qb) {
    constexpr int NKS = MODE == 0 ? 12 : 8;
    constexpr int RB = MODE == 0 ? 192 + 16 : 128 + 16;
    constexpr int SHM_K = 64 * RB;
    constexpr int PPR = RB / 16;
    constexpr int NKF = 64 * PPR / NTHREADS;
    constexpr int NXW = (64 * PPR - NKF * NTHREADS) / 64;
    int tid_ = F.tid; asm volatile("" : "+v"(tid_));
    const int tid = tid_, wid = F.wid, lane = tid & 63, r32 = lane & 31, hi = lane >> 5;
    constexpr int SHMV = 128 * 80;
    constexpr int NB = 3;
    LAS unsigned char* Kl = F.lds; LAS unsigned char* Vl = F.lds + NB * SHM_K;
    LAS float* wsc = (LAS float*)(F.lds + NB * SHM_K + NB * SHMV) + wid * 512;
    LAS unsigned char* Ql = F.lds + NB * SHM_K + NB * SHMV + 16384 + wid * 8192 + lane * 16;
    const bool lat = qb < 32;
    const int NT = lat ? (CTXL + SEQ) / 64 : CTXL / 64;
    const bf16_t* Zb = F.bf(WS_Z);
    const char* wsb = (const char*)F.ws;
    static_assert(64 * PPR == NKF * NTHREADS + NXW * 64, "K tile pieces");
    auto k_off = [&](int i, size_t rb, int tl) -> size_t { const int s = i * NTHREADS + tl; const int row = s / PPR, q = s % PPR; const int lp = q == PPR - 1 ? 0 : q;
        if (MODE == 0) return WS_K8 + ((rb + row) * 4 + h) * 256 + lp * 16;
        return WS_KD8 + ((rb + row) * 4 + h) * 128 + lp * 16; };
    auto v8_off = [&](int i, size_t rb, int tl) -> size_t { const int s = i * NTHREADS + tl; const int d = s / 5, q = s % 5;
        return (MODE == 0 ? WS_V8T : WS_VD8T) + (((size_t)h * (MT / 64) + rb / 64) * 128 + d) * 64 + (q == 4 ? 0 : q) * 16; };
    auto v_off = [&](int i, size_t rb, int tl) -> size_t { const int s = i * NTHREADS + tl; const int sub = s >> 5; const int kk = (sub >> 2) * 8 + ((s & 31) >> 2);
        const int k = (kk & ~0xC) | ((kk & 4) << 1) | ((kk & 8) >> 1); const int c = (sub & 3) * 32 + (s & 3) * 8;
        return MODE == 0 ? WS_KV + ((rb + k) * 1024 + h * 256 + 128 + c) * 2 : WS_Z + ((rb + k) * ZLD + ZC_DV + h * 128 + c) * 2; };
#define ATT_ROWBASE(j) ((j) < 4 ? (ML + b * CTXL + (j) * 64) : (b * SEQ + ((j) - 4) * 64))
#define ATT_STAGE(j, buf) do { const size_t _rb = (size_t)ATT_ROWBASE(j); int _tl = tid; asm volatile("" : "+v"(_tl)); \
    static_assert(NKF == 1, "one full K round"); const int _kx = wid < NXW ? 1 : 0, _vx = wid < 2 ? 1 : 0;        \
    __builtin_amdgcn_global_load_lds((const unsigned*)(wsb + k_off(0, _rb, _tl)), (LAS unsigned*)(Kl + (buf) * SHM_K + (wid * 64) * 16), 16, 0, 0); \
    __builtin_amdgcn_global_load_lds((const unsigned*)(wsb + k_off(_kx, _rb, _tl)), (LAS unsigned*)(Kl + (buf) * SHM_K + (_kx * NTHREADS + wid * 64) * 16), 16, 0, 0); \
    __builtin_amdgcn_global_load_lds((const unsigned*)(wsb + v8_off(0, _rb, _tl)), (LAS unsigned*)(Vl + (buf) * SHMV + (wid * 64) * 16), 16, 0, 0); \
    __builtin_amdgcn_global_load_lds((const unsigned*)(wsb + v8_off(_vx, _rb, _tl)), (LAS unsigned*)(Vl + (buf) * SHMV + (_vx * NTHREADS + wid * 64) * 16), 16, 0, 0); } while (0)
    __syncthreads();
    ATT_STAGE(0, 0);
    const int qrow = lat ? b * SEQ + qb * 256 + wid * 32 + r32 : ML + b * CTXL + wid * 32 + r32;
    bf16x8 qr[NKS];
    { const bf16_t* qp = MODE == 0 ? F.bf(WS_Q) + (size_t)qrow * 768 + h * 192 + hi * 8 : Zb + (size_t)qrow * ZLD + ZC_DQ + h * 128 + hi * 8;
#pragma unroll
      for (int d0 = 0; d0 < NKS; ++d0) qr[d0] = *(const bf16x8*)(qp + d0 * 16);
      if (lat) { const float* rp = F.f32(WS_ROPE) + ((size_t)(qb * 256 + wid * 32 + r32) * 32 + hi * 8) * 2;
          if (MODE == 0) { rope_pair(qr[8], qr[10], rp); rope_pair(qr[9], qr[11], rp + 32); }
          else { rope_pair(qr[0], qr[2], rp); rope_pair(qr[1], qr[3], rp + 32); rope_pair(qr[4], qr[6], rp); rope_pair(qr[5], qr[7], rp + 32); } }
    }
    typedef int v8i_t __attribute__((ext_vector_type(8)));
    constexpr int NS8 = MODE == 0 ? 3 : 2;
    v8i_t q8[3];
    {
#pragma unroll
        for (int s_ = 0; s_ < NS8; ++s_) { unsigned P[4][2];
#pragma unroll
            for (int dd = 0; dd < 4; ++dd) { const bf16x8 v = qr[4 * s_ + dd]; float f[8];
#pragma unroll
                for (int j = 0; j < 8; ++j) f[j] = bf2f((bf16_t)v[j]);
                int a_ = 0, b_ = 0; a_ = __builtin_amdgcn_cvt_pk_fp8_f32(f[0], f[1], a_, false); a_ = __builtin_amdgcn_cvt_pk_fp8_f32(f[2], f[3], a_, true);
                b_ = __builtin_amdgcn_cvt_pk_fp8_f32(f[4], f[5], b_, false); b_ = __builtin_amdgcn_cvt_pk_fp8_f32(f[6], f[7], b_, true); P[dd][0] = (unsigned)a_; P[dd][1] = (unsigned)b_; }
            auto r00 = __builtin_amdgcn_permlane32_swap(P[0][0], P[2][0], false, false); auto r01 = __builtin_amdgcn_permlane32_swap(P[0][1], P[2][1], false, false);
            auto r10 = __builtin_amdgcn_permlane32_swap(P[1][0], P[3][0], false, false); auto r11 = __builtin_amdgcn_permlane32_swap(P[1][1], P[3][1], false, false);
            q8[s_] = (v8i_t){(int)r00[0], (int)r01[0], (int)r00[1], (int)r01[1], (int)r10[0], (int)r11[0], (int)r10[1], (int)r11[1]};
            if (MODE == 1) { *(LAS u32x4*)(Ql + (2 * s_) * 1024) = (u32x4){(unsigned)q8[s_][0], (unsigned)q8[s_][1], (unsigned)q8[s_][2], (unsigned)q8[s_][3]};
                             *(LAS u32x4*)(Ql + (2 * s_ + 1) * 1024) = (u32x4){(unsigned)q8[s_][4], (unsigned)q8[s_][5], (unsigned)q8[s_][6], (unsigned)q8[s_][7]}; } } }
    int sc1_ = 0x7F7F7F7F; asm volatile("" : "+v"(sc1_));
    constexpr float LOG2E = 1.4426950408889634f;
    const float C = (MODE == 0 ? 0.07216878364870322f : 0.125f) * LOG2E;
    constexpr int NACC = MODE == 0 ? 1 : 2;
    f32x16 o[NACC][4]; float m_reg[NACC], l_reg[NACC];
#pragma unroll
    for (int a = 0; a < NACC; ++a) { float mi = -1e30f, li = 0.f; asm volatile("" : "+v"(mi), "+v"(li));
        m_reg[a] = mi; l_reg[a] = li; if (MODE == 1) { wsc[64 + 4 * lane + 2 * a] = mi; wsc[64 + 4 * lane + 2 * a + 1] = li; }
#pragma unroll
        for (int d = 0; d < 4; ++d) o[a][d] = f32x16{}; }
    const int vb0 = (int)(uintptr_t)Vl + v_rd_base(lane);
    if (NT > 1) ATT_STAGE(1, 1);
    asm volatile("s_waitcnt vmcnt(0)" ::: "memory"); __syncthreads();
    v8i_att_t keep8 = {};
    int bc = 0, bn = 1, bf_ = 2;
    for (int j = 0; j < NT; ++j) {
        const int buf = bc; { const int t_ = bc; bc = bn; bn = bf_; bf_ = t_; }
        if (j + 2 < NT) ATT_STAGE(j + 2, bn);
        const LAS unsigned char* Ks = Kl + buf * SHM_K;
#pragma unroll
        for (int a = 0; a < NACC; ++a) {
            f32x16 p0 = f32x16{}, p1 = f32x16{};
            {
                constexpr int NSQ = MODE == 0 ? 3 : 1;
#pragma unroll
                for (int s_ = 0; s_ < NSQ; ++s_) { const LAS unsigned char* kp = Ks + r32 * RB + (MODE == 0 ? s_ : a) * 64 + hi * 32;
                    const u32x4 a0_ = *(const LAS u32x4*)kp, a1_ = *(const LAS u32x4*)(kp + 16), c0_ = *(const LAS u32x4*)(kp + 32 * RB), c1_ = *(const LAS u32x4*)(kp + 32 * RB + 16);
                    const v8i_t b0 = (v8i_t){(int)a0_[0], (int)a0_[1], (int)a0_[2], (int)a0_[3], (int)a1_[0], (int)a1_[1], (int)a1_[2], (int)a1_[3]};
                    const v8i_t b1 = (v8i_t){(int)c0_[0], (int)c0_[1], (int)c0_[2], (int)c0_[3], (int)c1_[0], (int)c1_[1], (int)c1_[2], (int)c1_[3]};
                    v8i_t qf;
                    if (MODE == 0) qf = q8[s_];
                    else { const u32x4 q0_ = *(const LAS u32x4*)(Ql + (2 * a) * 1024), q1_ = *(const LAS u32x4*)(Ql + (2 * a + 1) * 1024);
                        qf = (v8i_t){(int)q0_[0], (int)q0_[1], (int)q0_[2], (int)q0_[3], (int)q1_[0], (int)q1_[1], (int)q1_[2], (int)q1_[3]}; }
                    asm volatile("v_mfma_scale_f32_32x32x64_f8f6f4 %0, %1, %2, %0, %3, %4 op_sel_hi:[0,0,0]" : "+v"(p0) : "v"(b0), "v"(qf), "v"(sc1_), "v"(sc1_));
                    asm volatile("v_mfma_scale_f32_32x32x64_f8f6f4 %0, %1, %2, %0, %3, %4 op_sel_hi:[0,0,0]" : "+v"(p1) : "v"(b1), "v"(qf), "v"(sc1_), "v"(sc1_)); }
                asm volatile("s_nop 15\n\ts_nop 7" : "+v"(p0), "+v"(p1));
                SBAR();
            }
            float alpha; bf16x8 pa0, pa1, pa2, pa3; v8i_att_t pa8;
            if (MODE == 1) { float mm = wsc[64 + 4 * lane + 2 * a], ll = wsc[64 + 4 * lane + 2 * a + 1];
                softmax_tile8(p0, p1, C, mm, ll, alpha, pa8); wsc[64 + 4 * lane + 2 * a] = mm; wsc[64 + 4 * lane + 2 * a + 1] = ll; }
            else if (MODE == 0) softmax_tile8(p0, p1, C, m_reg[a], l_reg[a], alpha, pa8);
            else softmax_tile(p0, p1, C, m_reg[a], l_reg[a], alpha, pa0, pa1, pa2, pa3);
            if (__any(alpha < 1.f)) { if (hi == 0) wsc[r32] = alpha; asm volatile("s_waitcnt lgkmcnt(0)" ::: "memory");
#pragma unroll
                for (int r = 0; r < 16; ++r) { const float al = wsc[crow(r, hi)];
#pragma unroll
                    for (int d = 0; d < 4; ++d) o[a][d][r] *= al; } }
            SBAR();
            if constexpr (MODE == 0) {
#pragma unroll
                for (int d0 = 0; d0 < 4; ++d0) { const LAS unsigned char* vp = Vl + buf * SHMV + (d0 * 32 + r32) * 80 + hi * 32;
                    const u32x4 v0_ = *(const LAS u32x4*)vp, v1_ = *(const LAS u32x4*)(vp + 16);
                    const v8i_t vf = (v8i_t){(int)v0_[0], (int)v0_[1], (int)v0_[2], (int)v0_[3], (int)v1_[0], (int)v1_[1], (int)v1_[2], (int)v1_[3]};
                    asm volatile("v_mfma_scale_f32_32x32x64_f8f6f4 %0, %1, %2, %0, %3, %4 op_sel_hi:[0,0,0]" : "+v"(o[a][d0]) : "v"(pa8), "v"(vf), "v"(sc1_), "v"(sc1_)); } }
            else { if (a == 0) keep8 = pa8;
                   else {
#pragma unroll
                       for (int d0 = 0; d0 < 4; ++d0) { const LAS unsigned char* vp = Vl + buf * SHMV + (d0 * 32 + r32) * 80 + hi * 32;
                           const u32x4 v0_ = *(const LAS u32x4*)vp, v1_ = *(const LAS u32x4*)(vp + 16);
                           const v8i_t vf = (v8i_t){(int)v0_[0], (int)v0_[1], (int)v0_[2], (int)v0_[3], (int)v1_[0], (int)v1_[1], (int)v1_[2], (int)v1_[3]};
                           asm volatile("v_mfma_scale_f32_32x32x64_f8f6f4 %0, %1, %2, %0, %3, %4 op_sel_hi:[0,0,0]" : "+v"(o[0][d0]) : "v"(keep8), "v"(vf), "v"(sc1_), "v"(sc1_));
                           asm volatile("v_mfma_scale_f32_32x32x64_f8f6f4 %0, %1, %2, %0, %3, %4 op_sel_hi:[0,0,0]" : "+v"(o[NACC - 1][d0]) : "v"(pa8), "v"(vf), "v"(sc1_), "v"(sc1_)); } } }
        }
        if (j + 2 < NT) asm volatile("s_waitcnt vmcnt(4)" ::: "memory"); else asm volatile("s_waitcnt vmcnt(0)" ::: "memory");
        __syncthreads();
    }
    if constexpr (MODE == 0) { asm volatile("s_nop 15\n\ts_nop 7" : "+v"(o[0][0]), "+v"(o[0][1]), "+v"(o[0][2]), "+v"(o[0][3])); SBAR(); }
    else { asm volatile("s_nop 15\n\ts_nop 7" : "+v"(o[0][0]), "+v"(o[0][1]), "+v"(o[0][2]), "+v"(o[0][3]), "+v"(o[NACC - 1][0]), "+v"(o[NACC - 1][1]), "+v"(o[NACC - 1][2]), "+v"(o[NACC - 1][3])); SBAR(); }
    const int orow0 = lat ? b * SEQ + qb * 256 + wid * 32 : ML + b * CTXL + wid * 32;
    if (MODE == 0) {
        if (hi == 0) wsc[32 + r32] = l_reg[0]; asm volatile("s_waitcnt lgkmcnt(0)" ::: "memory");
        unsigned char* Ob = F.ws + WS_BR + (size_t)orow0 * 512 + h * 128;
#pragma unroll
        for (int r = 0; r < 16; ++r) { const int orow = crow(r, hi); const float rl = 64.f * __builtin_amdgcn_rcpf(wsc[32 + orow]);
#pragma unroll
            for (int d0 = 0; d0 < 4; ++d0) Ob[(size_t)orow * 512 + d0 * 32 + r32] = f2fp8(o[0][d0][r] * rl); }
    } else {
        const float lam_init = l == 0 ? 0.2f : 0.35550906759060355f;
        const float s1 = wave_sum(F.inp(I_LQ1)[l * 64 + lane] * F.inp(I_LK1)[l * 64 + lane]), s2 = wave_sum(F.inp(I_LQ2)[l * 64 + lane] * F.inp(I_LK2)[l * 64 + lane]);
        const float lam = __expf(s1) - __expf(s2) + lam_init;
        { const float ll0 = wsc[64 + 4 * lane + 1], ll1 = wsc[64 + 4 * lane + 3]; if (hi == 0) { wsc[r32] = ll0; wsc[32 + r32] = ll1; } } asm volatile("s_waitcnt lgkmcnt(0)" ::: "memory");
        unsigned char* Ob = F.ws + WS_BR + ((size_t)2 * MT + orow0) * 512 + h * 128;
        float gs[4];
#pragma unroll
        for (int d0 = 0; d0 < 4; ++d0) gs[d0] = F.inp(I_GSUB)[l * 128 + d0 * 32 + r32] * (1.0f - lam_init);
#pragma unroll
        for (int r = 0; r < 16; ++r) { const int orow = crow(r, hi); const float rl0 = __builtin_amdgcn_rcpf(wsc[orow]), rl1 = lam * __builtin_amdgcn_rcpf(wsc[32 + orow]);
            float v[4]; float ss = 0.f;
#pragma unroll
            for (int d0 = 0; d0 < 4; ++d0) { v[d0] = o[0][d0][r] * rl0 - o[1][d0][r] * rl1; ss += v[d0] * v[d0]; }
            ss = half_sum_dpp(ss, hi);
            const float rs = rsqrtf(ss * (1.0f / 128.0f) + 1e-6f);
#pragma unroll
            for (int d0 = 0; d0 < 4; ++d0) Ob[(size_t)orow * 512 + d0 * 32 + r32] = f2fp8(v[d0] * rs * gs[d0]); }
    }
#undef ATT_ROWBASE
#undef ATT_STAGE
}
}

namespace fnet {
__device__ __forceinline__ int crow(int r, int hi) { return (r & 3) + 8 * (r >> 2) + 4 * hi; }
__device__ __forceinline__ void v_slot(int s, int& k, int& c) { const int sub = s >> 5; const int kk = (sub >> 2) * 8 + ((s & 31) >> 2); k = (kk & ~0xC) | ((kk & 4) << 1) | ((kk & 8) >> 1); c = (sub & 3) * 32 + (s & 3) * 8; }
template <int NT> __device__ __forceinline__ void stage_tiles(const Ctx& F, const bf16_t* src, size_t stride, LAS unsigned char* dst) {
#pragma unroll
    for (int i = 0; i < NT * 2; ++i) { const int s = i * NTHREADS + F.tid; int k, c; v_slot(s & 1023, k, c); const int t = s >> 10;
        __builtin_amdgcn_global_load_lds((const unsigned*)(src + (size_t)(64 * t + k) * stride + c), (LAS unsigned*)(dst + (i * NTHREADS + F.wid * 64) * 16), 16, 0, 0); }
}
__device__ __forceinline__ bf16x8 pack8(const float (&v)[8]) { u32x4 w = {cvt_pk_bf16(v[0], v[1]), cvt_pk_bf16(v[2], v[3]), cvt_pk_bf16(v[4], v[5]), cvt_pk_bf16(v[6], v[7])}; return *reinterpret_cast<bf16x8*>(&w); }

__device__ __forceinline__ void phase_s1_ctx(const Ctx& F, bool do_ctx) {
    LAS unsigned char* Bt = F.lds; LAS float* T = (LAS float*)(F.lds + 65536); LAS float* tw = T + 512;
    const int tid = F.tid, wid = F.wid, lane = F.lane, r32 = lane & 31, hi = lane >> 5;
    __syncthreads();
    for (int i = tid; i < 256; i += NTHREADS) { const float x = (float)i * (1.0f / 128.0f); T[2 * i] = cospif(x); T[2 * i + 1] = sinpif(x); }
    __syncthreads();
    const int vb = (int)(uintptr_t)Bt + att::v_rd_base(lane);
    bf16x8 pa[2][4];
    { const int k1 = 16 * wid + (r32 & 15); const bool im = r32 >= 16;
#pragma unroll
      for (int t = 0; t < 2; ++t)
#pragma unroll
          for (int ks = 0; ks < 4; ++ks) { float v[8];
#pragma unroll
              for (int j = 0; j < 8; ++j) { const int n1 = 64 * t + 16 * ks + 8 * hi + j; const int idx = ((k1 * n1) & 127) * 2; v[j] = im ? -T[2 * idx + 1] : T[2 * idx]; }
              pa[t][ks] = pack8(v); } }
    for (int un = F.bid; un < NBATCH * 64 * 4; un += F.G) {
        const int b = un >> 8, n2 = (un >> 2) & 63, g = un & 3;
        __syncthreads();
        stage_tiles<2>(F, F.bf(WS_Z) + (size_t)(b * SEQ + n2) * ZLD + ZC_F + g * 128, (size_t)64 * ZLD, Bt);
        if (tid < 128) { const float x = (float)(n2 * tid) * (1.0f / 4096.0f); tw[2 * tid] = cospif(x); tw[2 * tid + 1] = sinpif(x); }
        asm volatile("s_waitcnt vmcnt(0)" ::: "memory"); __syncthreads();
        f32x16 o[4] = {f32x16{}, f32x16{}, f32x16{}, f32x16{}};
        att::pv_d0(o, vb, pa[0][0], pa[0][1], pa[0][2], pa[0][3]);
        att::pv_d0(o, vb + 16384, pa[1][0], pa[1][1], pa[1][2], pa[1][3]);
        bf16_t* AP = F.bf(WS_AP);
#pragma unroll
        for (int r = 0; r < 8; ++r) { const int kk1 = 16 * wid + crow(r, hi); const float c = tw[2 * kk1], sn = tw[2 * kk1 + 1];
#pragma unroll
            for (int d0 = 0; d0 < 4; ++d0) { const float ar = o[d0][r], ai = o[d0][r + 8];
                const size_t base = ((((size_t)b * 128 + kk1) * 2) * 64 + n2) * 512 + g * 128 + d0 * 32 + r32;
                AP[base] = f2bf(ar * c + ai * sn); AP[base + (size_t)64 * 512] = f2bf(ai * c - ar * sn); } }
    }
    if (do_ctx) for (int un = F.bid; un < NBATCH * 4 * 2; un += F.G) {
        const int b = un >> 3, g = (un >> 1) & 3, kh = un & 1;
        __syncthreads();
        stage_tiles<4>(F, F.bf(WS_Z) + (size_t)(ML + b * CTXL) * ZLD + ZC_F + g * 128, (size_t)ZLD, Bt);
        const int k = 128 * kh + 16 * wid + (r32 & 15); const bool im = r32 >= 16; const float nrm = 0.005524271728019903f;
        asm volatile("s_waitcnt vmcnt(0)" ::: "memory"); __syncthreads();
        f32x16 o[4] = {f32x16{}, f32x16{}, f32x16{}, f32x16{}};
#pragma unroll
        for (int t = 0; t < 4; ++t) { bf16x8 pc[4];
#pragma unroll
            for (int ks = 0; ks < 4; ++ks) { float v[8];
#pragma unroll
                for (int j = 0; j < 8; ++j) { const int n = 64 * t + 16 * ks + 8 * hi + j; const int idx = (k * n) & 255; v[j] = (im ? -T[2 * idx + 1] : T[2 * idx]) * nrm; }
                pc[ks] = pack8(v); }
            att::pv_d0(o, vb + t * 16384, pc[0], pc[1], pc[2], pc[3]); }
        unsigned char* X = F.ws + WS_X;
#pragma unroll
        for (int r = 0; r < 8; ++r) { const int kk = 128 * kh + 16 * wid + crow(r, hi);
#pragma unroll
            for (int d0 = 0; d0 < 4; ++d0) { const size_t base = (size_t)(ML + b * CTXL + kk) * 1024 + g * 128 + d0 * 32 + r32; X[base] = f2fp8(o[d0][r]); X[base + 512] = f2fp8(o[d0][r + 8]); } }
    }
    __syncthreads();
}
__device__ __forceinline__ void phase_s3(const Ctx& F) {
    LAS unsigned char* Bt = F.lds; LAS float* T = (LAS float*)(F.lds + 65536);
    const int tid = F.tid, wid = F.wid, lane = F.lane, r32 = lane & 31, hi = lane >> 5;
    __syncthreads();
    for (int i = tid; i < 256; i += NTHREADS) { const float x = (float)i * (1.0f / 128.0f); T[2 * i] = cospif(x); T[2 * i + 1] = sinpif(x); }
    __syncthreads();
    const int usel = wid >> 2, wq = wid & 3;
    const int vb = (int)(uintptr_t)Bt + usel * 32768 + att::v_rd_base(lane);
    bf16x8 pa[2][4];
    { const int k2 = 16 * wq + (r32 & 15); const bool im = r32 >= 16; const float nrm = 1.0f / 1024.0f;
#pragma unroll
      for (int t = 0; t < 2; ++t)
#pragma unroll
          for (int ks = 0; ks < 4; ++ks) { float v[8];
#pragma unroll
              for (int j = 0; j < 8; ++j) { const int n2 = 16 * ks + 8 * hi + j; const int idx = ((n2 * k2) & 63) * 4; const float c = T[2 * idx], sn = T[2 * idx + 1];
                  v[j] = (im ? (t == 0 ? -sn : c) : (t == 0 ? c : sn)) * nrm; }
              pa[t][ks] = pack8(v); } }
    for (int up = F.bid; up < NBATCH * 128 * 4 / 2; up += F.G) {
        __syncthreads();
#pragma unroll
        for (int q = 0; q < 2; ++q) { const int un = 2 * up + q; const int b = un >> 9, k1 = (un >> 2) & 127, g = un & 3;
            stage_tiles<2>(F, F.bf(WS_AP) + ((size_t)b * 128 + k1) * 2 * 64 * 512 + g * 128, 512, Bt + q * 32768); }
        asm volatile("s_waitcnt vmcnt(0)" ::: "memory"); __syncthreads();
        const int un = 2 * up + usel; const int b = un >> 9, k1 = (un >> 2) & 127, g = un & 3;
        f32x16 o[4] = {f32x16{}, f32x16{}, f32x16{}, f32x16{}};
        att::pv_d0(o, vb, pa[0][0], pa[0][1], pa[0][2], pa[0][3]);
        att::pv_d0(o, vb + 16384, pa[1][0], pa[1][1], pa[1][2], pa[1][3]);
        unsigned char* X = F.ws + WS_X;
#pragma unroll
        for (int r = 0; r < 8; ++r) { const int k2 = 16 * wq + crow(r, hi); const size_t tok = (size_t)b * SEQ + k1 + 128 * k2;
#pragma unroll
            for (int d0 = 0; d0 < 4; ++d0) { const size_t base = tok * 1024 + g * 128 + d0 * 32 + r32; X[base] = f2fp8(o[d0][r]); X[base + 512] = f2fp8(o[d0][r + 8]); } }
    }
    __syncthreads();
}
}

namespace peer {
typedef float v32f_t __attribute__((ext_vector_type(32)));
typedef unsigned v6u_t __attribute__((ext_vector_type(6)));
__device__ __forceinline__ unsigned okey(float s) { const unsigned b = __float_as_uint(s); return b ^ ((unsigned)((int)b >> 31) | 0x80000000u); }
__device__ __forceinline__ float oval(unsigned k) { return __uint_as_float((k & 0x80000000u) ? (k ^ 0x80000000u) : ~k); }
template <int NE> __device__ __forceinline__ unsigned top16_row(unsigned (&key)[NE], int t) {
    unsigned sel = 0u;
#pragma unroll
    for (int n = 0; n < 16; ++n) { unsigned m = key[0];
#pragma unroll
        for (int e = 1; e < NE; ++e) m = m > key[e] ? m : key[e];
        m = row_max16_u(m); sel = (t == n) ? m : sel;
#pragma unroll
        for (int e = 0; e < NE; ++e) key[e] = (key[e] == m) ? 0u : key[e]; }
    return sel;
}
__device__ __forceinline__ float gelu_erf(float x) { return 0.5f * x * (1.0f + erff(x * 0.70710678118654752f)); }

__device__ __forceinline__ void peer_rows(const Ctx& F, int l, int nrows, bool dry = false) {
    const int lane = F.lane, wid = F.wid, t = lane & 15, rr = lane >> 4;
    LAS unsigned* selL = (LAS unsigned*)F.lds + wid * 1024;
    LAS unsigned* eidL = selL + 256; LAS float* gwL = (LAS float*)(selL + 384); LAS unsigned* tabL = selL + 512;
    { const int q = lane; int cnt = 0, fi = -1, fj = 0;
      for (int i = 0; i < 16; ++i) { const int nj = 16 / (i + 1); if (fi < 0 && q < cnt + nj) { fi = i; fj = q - cnt; } cnt += nj; }
      tabL[lane] = fi >= 0 ? (unsigned)(fi * 16 + fj) : 255u; }
    const unsigned char* PU = F.ws + WS_PU + (size_t)l * NEXP * PEER_UROWB; const unsigned char* PV = F.ws + WS_PV + (size_t)l * NEXP * PEER_VROWB;
    unsigned* rowcnt = (unsigned*)(F.ws + WS_DIAG + 2048 + l * 256);
    auto next_row = [&]() -> int { unsigned nx = 0u; if (lane == 0) nx = __hip_atomic_fetch_add(rowcnt, 1u, __ATOMIC_RELAXED, __HIP_MEMORY_SCOPE_AGENT); return F.G * NWAVES + __builtin_amdgcn_readfirstlane((int)nx); };
    for (int row = F.bid * NWAVES + wid; row < nrows; row = next_row()) {
        const bool cpart = l == 0 && row >= ML;
        const float* S = cpart ? F.f32(WS_PART) + (size_t)(row - ML) * DM : F.f32(WS_S) + (size_t)row * DM;
#pragma unroll
        for (int it = 0; it < 4; ++it) { const float* sp = S + (it * 4 + rr) * 128 + t * 8; f32x4 a = *(const f32x4*)sp, b = *(const f32x4*)(sp + 4);
            if (cpart) {
#pragma unroll 1
                for (int k = 1; k < 8; ++k) { a += *(const f32x4*)(sp + (size_t)k * MC * DM); b += *(const f32x4*)(sp + (size_t)k * MC * DM + 4); } }
            unsigned key[8];
#pragma unroll
            for (int e = 0; e < 4; ++e) { key[e] = (okey(a[e]) & 0xFFFFFF80u) | (unsigned)(t * 8 + e); key[4 + e] = (okey(b[e]) & 0xFFFFFF80u) | (unsigned)(t * 8 + 4 + e); }
            selL[it * 64 + lane] = top16_row<8>(key, t); }
#pragma unroll
        for (int pass = 0; pass < 2; ++pass) { const int hd = pass * 4 + rr; const LAS unsigned* s1 = selL + (hd >> 1) * 64 + (hd & 1) * 32; const LAS unsigned* s2 = s1 + 16;
            unsigned key[4];
#pragma unroll
            for (int e = 0; e < 4; ++e) { const unsigned ij = tabL[t * 4 + e]; if (ij != 255u) { const float v = oval(s1[ij >> 4] & 0xFFFFFF80u) + oval(s2[ij & 15u] & 0xFFFFFF80u); key[e] = (okey(v) & 0xFFFFFF00u) | ij; } else key[e] = 1u + e; }
            const unsigned ks = top16_row<4>(key, t);
            const int i = (ks >> 4) & 15, j = ks & 15; const unsigned k1 = s1[i], k2 = s2[j];
            const float sc = oval(k1 & 0xFFFFFF80u) + oval(k2 & 0xFFFFFF80u);
            const float mx = row_max16_f(sc); const float ex = __expf(sc - mx); const float sm = row_sum16_f(ex);
            eidL[hd * 16 + t] = (k1 & 127u) * 128u + (k2 & 127u); gwL[hd * 16 + t] = ex / sm;
            }
        v32f_t hf;
        { const bf16_t* hr = F.bf(WS_HN) + (size_t)row * DM + lane * 32;
#pragma unroll
          for (int h = 0; h < 4; ++h) { const u32x4 v = *(const u32x4*)(hr + h * 8);
              hf[h * 8 + 0] = bflo(v[0]); hf[h * 8 + 1] = bfhi(v[0]); hf[h * 8 + 2] = bflo(v[1]); hf[h * 8 + 3] = bfhi(v[1]);
              hf[h * 8 + 4] = bflo(v[2]); hf[h * 8 + 5] = bfhi(v[2]); hf[h * 8 + 6] = bflo(v[3]); hf[h * 8 + 7] = bfhi(v[3]); } }
        v32f_t acc;
#pragma unroll
        for (int i = 0; i < 32; ++i) acc[i] = 0.f;
        if constexpr (PEER_UBITS == 4 && PEER_VBITS == 4) {
            f32x2 acc2[16];
#pragma unroll
            for (int i = 0; i < 16; ++i) acc2[i] = (f32x2){0.f, 0.f};
            u32x4 hb1, hb2;
            { auto enc4 = [](float y) -> unsigned { const float ay = fabsf(y);
                  unsigned code = ay < 0.25f ? 0u : ay < 0.75f ? 1u : ay < 1.25f ? 2u : ay < 1.75f ? 3u : ay < 2.5f ? 4u : ay < 3.5f ? 5u : ay < 5.0f ? 6u : 7u; return code | (y < 0.f ? 8u : 0u); };
#define PEER_RES(k2) do { const f32x2 d = __builtin_amdgcn_cvt_scalef32_pk_f32_fp4(w, 1.0f, k2); \
        v |= enc4((hf[q * 8 + 2 * k2] - d[0]) * 8.f) << (8 * k2); v |= enc4((hf[q * 8 + 2 * k2 + 1] - d[1]) * 8.f) << (8 * k2 + 4); } while (0)
#pragma unroll
              for (int q = 0; q < 4; ++q) { unsigned w = 0u;
#pragma unroll
                  for (int e = 0; e < 8; ++e) w |= enc4(hf[q * 8 + e]) << (4 * e);
                  unsigned v = 0u; PEER_RES(0); PEER_RES(1); PEER_RES(2); PEER_RES(3);
                  hb1[q] = w; hb2[q] = v; }
#undef PEER_RES
            }
            int sA = 0x79797979, sB1 = 0x7F7F7F7F, sB2 = 0x7C7C7C7C; asm volatile("" : "+v"(sA), "+v"(sB1), "+v"(sB2));
            const bool ondiag = (lane >> 4) == ((lane & 15) >> 2); const int di = lane & 3;
#define PEER_DEC4(w_, k_) __builtin_amdgcn_cvt_scalef32_pk_f32_fp4((w_), 1.0f, (k_))
            for (int kb = 0; kb < 16; ++kb) {
                u32x4 bu[8], bv[8]; float gq[8], dd[8];
#pragma unroll
                for (int m = 0; m < 8; ++m) { const unsigned e = (unsigned)__builtin_amdgcn_readfirstlane((int)eidL[kb * 8 + m]); gq[m] = gwL[kb * 8 + m];
                    bu[m] = *(const u32x4*)(PU + (size_t)e * PEER_UROWB + lane * 16); bv[m] = *(const u32x4*)(PV + (size_t)e * PEER_VROWB + lane * 16); }
                f32x4 dm[8];
#pragma unroll
                for (int m = 0; m < 8; ++m) { dm[m] = (f32x4){0.f, 0.f, 0.f, 0.f};
                    asm volatile("v_mfma_scale_f32_16x16x128_f8f6f4 %0, %1, %2, %0, %3, %4 op_sel_hi:[0,0,0] cbsz:4 blgp:4" : "+v"(dm[m]) : "v"(bu[m]), "v"(hb1), "v"(sA), "v"(sB1)); }
#pragma unroll
                for (int m = 0; m < 8; ++m)
                    asm volatile("v_mfma_scale_f32_16x16x128_f8f6f4 %0, %1, %2, %0, %3, %4 op_sel_hi:[0,0,0] cbsz:4 blgp:4" : "+v"(dm[m]) : "v"(bu[m]), "v"(hb2), "v"(sA), "v"(sB2));
                __builtin_amdgcn_sched_barrier(0); asm volatile("s_nop 15\n\ts_nop 7" ::: "memory"); __builtin_amdgcn_sched_barrier(0);
#pragma unroll
                for (int m = 0; m < 8; ++m) { float x = dm[m][0]; x = di == 1 ? dm[m][1] : x; x = di == 2 ? dm[m][2] : x; x = di == 3 ? dm[m][3] : x;
                    dd[m] = wave_sum_dpp(ondiag ? x : 0.f); }
                float x = dd[0];
#pragma unroll
                for (int m = 1; m < 8; ++m) x = ((lane & 7) == m) ? dd[m] : x;
                const float gl = gelu_erf(x * 0.70710678118654752f) * 0.5f;
#pragma unroll
                for (int m = 0; m < 8; ++m) { const float cf = gq[m] * __int_as_float(__builtin_amdgcn_readlane(__float_as_int(gl), m)); const f32x2 cf2 = {cf, cf};
#pragma unroll
                    for (int q = 0; q < 4; ++q) { const unsigned w = bv[m][q];
                        acc2[q * 4 + 0] = PEER_DEC4(w, 0) * cf2 + acc2[q * 4 + 0]; acc2[q * 4 + 1] = PEER_DEC4(w, 1) * cf2 + acc2[q * 4 + 1];
                        acc2[q * 4 + 2] = PEER_DEC4(w, 2) * cf2 + acc2[q * 4 + 2]; acc2[q * 4 + 3] = PEER_DEC4(w, 3) * cf2 + acc2[q * 4 + 3]; } }
            }
#undef PEER_DEC4
#pragma unroll
            for (int i = 0; i < 16; ++i) { acc[2 * i] = acc2[i][0]; acc[2 * i + 1] = acc2[i][1]; }
        } else
        for (int kb = 0; kb < 16; ++kb) {
            u32x4 ua[8], va[8]; u32x2 ub[8], vb[8]; float gk[8];
#pragma unroll
            for (int m = 0; m < 8; ++m) { const unsigned e = (unsigned)__builtin_amdgcn_readfirstlane((int)eidL[kb * 8 + m]); gk[m] = gwL[kb * 8 + m];
                const unsigned char* up = PU + (size_t)e * PEER_UROWB; const unsigned char* vp = PV + (size_t)e * PEER_VROWB;
                ua[m] = *(const u32x4*)(up + lane * 16); if (PEER_UBITS == 6) ub[m] = *(const u32x2*)(up + 1024 + lane * 8);
                va[m] = *(const u32x4*)(vp + lane * 16); if (PEER_VBITS == 6) vb[m] = *(const u32x2*)(vp + 1024 + lane * 8); }
#pragma unroll
            for (int m = 0; m < 8; ++m) {
                v32f_t du;
                if (PEER_UBITS == 6) { v6u_t pk; pk[0] = ua[m][0]; pk[1] = ua[m][1]; pk[2] = ua[m][2]; pk[3] = ua[m][3]; pk[4] = ub[m][0]; pk[5] = ub[m][1]; du = __builtin_amdgcn_cvt_scalef32_pk32_f32_fp6(pk, 1.0f); }
                else {
#pragma unroll
                    for (int q = 0; q < 4; ++q) { const f32x2 t0 = __builtin_amdgcn_cvt_scalef32_pk_f32_fp4(ua[m][q], 1.0f, 0), t1 = __builtin_amdgcn_cvt_scalef32_pk_f32_fp4(ua[m][q], 1.0f, 1);
                        const f32x2 t2 = __builtin_amdgcn_cvt_scalef32_pk_f32_fp4(ua[m][q], 1.0f, 2), t3 = __builtin_amdgcn_cvt_scalef32_pk_f32_fp4(ua[m][q], 1.0f, 3);
                        du[q * 8 + 0] = t0[0]; du[q * 8 + 1] = t0[1]; du[q * 8 + 2] = t1[0]; du[q * 8 + 3] = t1[1]; du[q * 8 + 4] = t2[0]; du[q * 8 + 5] = t2[1]; du[q * 8 + 6] = t3[0]; du[q * 8 + 7] = t3[1]; } }
                float d0 = 0.f, d1 = 0.f;
#pragma unroll
                for (int i = 0; i < 32; i += 2) { d0 = fmaf(du[i], hf[i], d0); d1 = fmaf(du[i + 1], hf[i + 1], d1); }
                const float d = wave_sum_dpp(d0 + d1) * 0.011048543456039806f;
                const float cf = gk[m] * gelu_erf(d) * 0.5f;
                if (PEER_VBITS == 6) { v6u_t pk; pk[0] = va[m][0]; pk[1] = va[m][1]; pk[2] = va[m][2]; pk[3] = va[m][3]; pk[4] = vb[m][0]; pk[5] = vb[m][1];
                    const v32f_t dv = __builtin_amdgcn_cvt_scalef32_pk32_f32_fp6(pk, 1.0f);
#pragma unroll
                    for (int i = 0; i < 32; ++i) acc[i] = fmaf(dv[i], cf, acc[i]); }
                else {
#pragma unroll
                    for (int q = 0; q < 4; ++q)
#pragma unroll
                        for (int k = 0; k < 4; ++k) { const f32x2 t = k == 0 ? __builtin_amdgcn_cvt_scalef32_pk_f32_fp4(va[m][q], 1.0f, 0) : k == 1 ? __builtin_amdgcn_cvt_scalef32_pk_f32_fp4(va[m][q], 1.0f, 1)
                                : k == 2 ? __builtin_amdgcn_cvt_scalef32_pk_f32_fp4(va[m][q], 1.0f, 2) : __builtin_amdgcn_cvt_scalef32_pk_f32_fp4(va[m][q], 1.0f, 3);
                            acc[q * 8 + k * 2] = fmaf(t[0], cf, acc[q * 8 + k * 2]); acc[q * 8 + k * 2 + 1] = fmaf(t[1], cf, acc[q * 8 + k * 2 + 1]); } } }
        }
        const int v = row < ML ? (row >> 13) : 2;
        const float* g2 = F.mod(l, v, 5);
        float* xr = F.f32(WS_XR) + (size_t)row * DM + lane * 32; float ss = 0.f;
        float xo[32];
#pragma unroll
        for (int q = 0; q < 8; ++q) { const f32x4 xv = *(const f32x4*)(xr + q * 4), gv = *(const f32x4*)(g2 + lane * 32 + q * 4); f32x4 ov;
#pragma unroll
            for (int e = 0; e < 4; ++e) { ov[e] = xv[e] + gv[e] * acc[q * 4 + e]; xo[q * 4 + e] = ov[e]; ss += ov[e] * ov[e]; }
            if (!dry) *(f32x4*)(xr + q * 4) = ov; }
        ss = wave_sum(ss);
        if (dry) { if (lane == 0) F.f32(WS_DIAG)[512 + (row & 255)] = ss; continue; }
        const float rs = rsqrtf(ss * (1.0f / DM) + 1e-6f);
        if (l == 0) {
            const float* gn = F.inp(I_GN1) + DM + lane * 32; const float* sh = F.mod(1, v, 0) + lane * 32; const float* sc = F.mod(1, v, 1) + lane * 32;
#pragma unroll
            for (int h = 0; h < 4; ++h) { float o[8];
#pragma unroll
                for (int q = 0; q < 2; ++q) { const f32x4 gv = *(const f32x4*)(gn + h * 8 + 4 * q), sv = *(const f32x4*)(sc + h * 8 + 4 * q), tv = *(const f32x4*)(sh + h * 8 + 4 * q);
#pragma unroll
                    for (int e = 0; e < 4; ++e) o[4 * q + e] = (xo[h * 8 + 4 * q + e] * rs * gv[e]) * (1.0f + sv[e]) + tv[e]; }
                int p0 = 0, p1 = 0; p0 = __builtin_amdgcn_cvt_pk_fp8_f32(o[0], o[1], p0, false);
                p0 = __builtin_amdgcn_cvt_pk_fp8_f32(o[2], o[3], p0, true);
                p1 = __builtin_amdgcn_cvt_pk_fp8_f32(o[4], o[5], p1, false); p1 = __builtin_amdgcn_cvt_pk_fp8_f32(o[6], o[7], p1, true);
                *(u32x2*)(F.ws + WS_HN8 + (size_t)row * DM + lane * 32 + h * 8) = (u32x2){(unsigned)p0, (unsigned)p1}; }
        } else if (row < ML) {
            const float* gf = F.inp(I_GFIN) + lane * 32; float* orow = F.out + (size_t)row * DM + lane * 32;
#pragma unroll
            for (int q = 0; q < 8; ++q) { const f32x4 gv = *(const f32x4*)(gf + q * 4); f32x4 ov;
#pragma unroll
                for (int e = 0; e < 4; ++e) ov[e] = xo[q * 4 + e] * rs * gv[e];
                *(f32x4*)(orow + q * 4) = ov; }
        }
    }
}
}

constexpr int PH_PRE = 2, PH_PER_LAYER = 13, NPHASES = PH_PRE + PH_PER_LAYER * DEPTH;
static_assert(offsetof(Args, out) == 240 && offsetof(Args, ws) == 248, "Ctx::fresh reads out / ws from the argument block");
__global__ void __launch_bounds__(NTHREADS, 2) mk_fwd(Args a) {
    extern __shared__ __attribute__((aligned(16))) unsigned char shm[];
    Ctx F; F.lds = (LAS unsigned char*)shm; F.G = gridDim.x; F.bid = blockIdx.x; F.wv = __builtin_amdgcn_readfirstlane((int)threadIdx.x >> 6); F.fresh();
    LAS unsigned char* lds = F.lds;
    volatile LAS unsigned* xbw = (volatile LAS unsigned*)(lds + LDS_BYTES - 16);
    if (F.tid == 0) { xbw[0] = 0u; xbw[1] = 0u; xbw[2] = 0u; xbw[3] = 0u; }
    __syncthreads();
    XcdBarrier bar; bar.bar = (unsigned*)(a.ws + WS_BAR); bar.x = 0; bar.st = xbw;
    const int lo = a.ph_lo, hi = a.ph_hi;
    if (hi - lo > 1) bar = xcd_barrier_post((unsigned*)(a.ws + WS_BAR), xbw, F.tid);
#ifndef MK_PHMASK
#define MK_PHMASK 0xFFFF
#endif
#define PHON(j) ((MK_PHMASK >> (j)) & 1)
#ifndef MK_REP
#define MK_REP -1
#endif
#define REPS(j) for (int rep_ = 0; rep_ < (MK_REP == (j) ? 2 : 1); ++rep_)
#define IN(k) (F.fresh(), (lo <= (k) && (k) < hi))
#define SEAM(k) do { if (IN(k) && IN((k) + 1)) { xcd_barrier(bar, F.tid); if (MK_REP == 99) xcd_barrier(bar, F.tid); } } while (0)

    if (IN(0) && PHON(13)) REPS(100) { p0_prologue(F); } SEAM(0);
    if (IN(1)) { pg8::Gemm g{256, DM, 256, F.wid};
        pg8::SchedWsc S{F.G, F.bid, (const char*)F.bf(WS_KB), (const char*)F.bf(WS_WPQ)};
        pg8::EpiBf16 E{F.bf(WS_WSC), DM, 8, (size_t)DM * DM};
        pg8::gemm_phase(lds, g, S, E); } SEAM(1);

    for (int l = 0; l < DEPTH; ++l) {
        const int pb = PH_PRE + PH_PER_LAYER * l;
        const int nMa = l == 0 ? MT / 256 : ML / 256;
        const int nrows_a = l == 0 ? MT : ML;
        if (IN(pb + 0) && PHON(0)) { if (l == 0) norm_rows(F, F.inp(I_X), F.inp(I_CTX), F.inp(I_GN1), 0, 0, 1, MT, true, nullptr, nullptr, nullptr, false); } if (l == 0 || hi - lo == 1) SEAM(pb + 0);
        if (IN(pb + 1) && PHON(1)) REPS(1) {
            pg8::Gemm g{DM, DM, DM, F.wid};
            pg8::Sched S{MT / 256, ZLD / 256, F.G, F.bid, (const char*)(F.ws + WS_HN8), (const char*)(F.ws + WS_WIN + (size_t)l * ZLD * DM), (size_t)256 * DM, (size_t)256 * DM, 1 << 20, 0};
            pg8::EpiBf16 E{F.bf(WS_Z), ZLD, 1 << 20, 0};
            pg8::gemm_phase<pg8::EpiBf16, pg8::Sched, 1>(lds, g, S, E);
        } SEAM(pb + 1);
        if (IN(pb + 2) && PHON(2)) { z_post_rows(F, l); REPS(20) fnet::phase_s1_ctx(F, l == 0); } SEAM(pb + 2);
        if (IN(pb + 3) && PHON(3)) REPS(3) {
            { pg8::Gemm g{ZLD, 384, 384, F.wid};
              pg8::Sched S{MT / 256, 3, F.G, F.bid, (const char*)(F.bf(WS_Z) + ZC_QLAT), (const char*)(F.bf(WS_WUQ) + (size_t)l * 768 * 384), (size_t)256 * ZLD * 2, (size_t)256 * 384 * 2, 1 << 20, 0};
              pg8::EpiBf16 E{F.bf(WS_Q), 768, 1 << 20, 0};
              pg8::gemm_phase(lds, g, S, E); }
            { pg8::Gemm g{ZLD, 256, 256, F.wid};
              pg8::Sched S{MT / 256, 4, F.G, (F.bid + 26) % F.G, (const char*)(F.bf(WS_Z) + ZC_KVLAT), (const char*)(F.bf(WS_WUKV) + (size_t)l * 1024 * 256), (size_t)256 * ZLD * 2, (size_t)256 * 256 * 2, 1 << 20, 0};
              pg8::EpiKV E{F.bf(WS_KV), F.ws + WS_K8};
              pg8::gemm_phase(lds, g, S, E); }
            conv_units(F, l);
        } SEAM(pb + 3);
        if (IN(pb + 4) && PHON(4)) {
            v8t_build(F); xcd_barrier(bar, F.tid); F.fresh();
            const int nu = l == 0 ? 256 + 8 : 256;
            for (int u = F.bid; u < (MK_REP == 4 ? 2 : 1) * 512; u += F.G) { const int uu_ = u & 511; if (uu_ < nu) att::attn_unit<0>(F, l, (uu_ & 7) >> 2, uu_ & 3, uu_ >> 3); }
            for (int u = (F.bid + 248) % F.G; u < (MK_REP == 40 ? 2 : 1) * 512; u += F.G) { const int uu_ = u & 511; if (uu_ < nu) att::attn_unit<1>(F, l, (uu_ & 7) >> 2, uu_ & 3, uu_ >> 3); }
            REPS(41) fnet::phase_s3(F);
        } SEAM(pb + 4);
        if (IN(pb + 5) && PHON(5)) REPS(5) {
            { pg8::Gemm g{1024, 1024, 1024, F.wid};
              pg8::Sched S{nMa, 2, F.G, F.bid, (const char*)(F.ws + WS_X), (const char*)(F.ws + WS_WDFT), (size_t)256 * 1024, (size_t)256 * 1024, 1 << 20, 0};
              pg8::EpiFp8 E{F.ws + WS_BR + (size_t)3 * MT * 512, 512, 1 << 20, 0};
              pg8::gemm_phase<pg8::EpiFp8, pg8::Sched, 1>(lds, g, S, E); }
            { pg8::Gemm g{512, 512, 512, F.wid};
              pg8::Sched S{nMa, 24, F.G, (F.bid + 76) % F.G, (const char*)(F.ws + WS_BR), (const char*)(F.ws + WS_WB + (size_t)l * 4 * DM * 512), (size_t)256 * 512, (size_t)256 * 512, 8, (size_t)MT * 512, 0x79797979};
              pg8::EpiFp8 E{F.ws + WS_T, DM, 8, (size_t)MT * DM};
              pg8::gemm_phase<pg8::EpiFp8, pg8::Sched, 1>(lds, g, S, E); }
        } SEAM(pb + 5);
        if (IN(pb + 6) && PHON(6)) REPS(6) {
            { pg8::Gemm g{512, 512, 512, F.wid};
              pg8::Sched S{nMa, 8, F.G, F.bid, (const char*)(F.ws + WS_BR + (size_t)3 * MT * 512), (const char*)(F.ws + WS_WB + ((size_t)l * 4 + 3) * DM * 512), (size_t)256 * 512, (size_t)256 * 512, 1 << 20, 0};
              pg8::EpiFp8 E{F.ws + WS_T + (size_t)3 * MT * DM, DM, 1 << 20, 0};
              pg8::gemm_phase<pg8::EpiFp8, pg8::Sched, 1>(lds, g, S, E); }
        }
        SEAM(pb + 6);
        if (IN(pb + 7) && PHON(7)) REPS(7) {
            pg8::Gemm g{DM, DM, DM, F.wid};
            pg8::SchedGate S{ML / 256, F.G, F.bid, (const char*)(F.ws + WS_HN8), (const char*)(F.ws + WS_WG + (size_t)l * 4 * DM * DM), (size_t)256 * DM, (size_t)256 * DM};
            pg8::EpiGate E{F.ws + WS_T, (size_t)MT * DM, (u32x4*)(F.ws + WS_BR) + (size_t)F.bid * 16 * NTHREADS, F.ws + WS_Y};
            pg8::gemm_phase<pg8::EpiGate, pg8::SchedGate, 1>(lds, g, S, E);
            if (l == 0) {
                pg8::SchedGateCtx S2{F.G, F.bid, (const char*)(F.ws + WS_HN8), (const char*)(F.ws + WS_WG + (size_t)l * 4 * DM * DM), (size_t)256 * DM, (size_t)256 * DM};
                pg8::EpiGateCtx E2{F.ws + WS_T, (size_t)MT * DM, F.bf(WS_YC)};
                pg8::gemm_phase<pg8::EpiGateCtx, pg8::SchedGateCtx, 1>(lds, g, S2, E2); }
        } SEAM(pb + 7);
        if (IN(pb + 8) && PHON(8)) { if (l == 0) { const bf16_t* yc = F.bf(WS_YC); unsigned char* y = F.ws + WS_Y + (size_t)ML * DM;
                for (size_t i = (size_t)F.bid * NTHREADS + F.tid; i < (size_t)MC * DM / 8; i += (size_t)F.G * NTHREADS) { float sacc[8] = {0.f, 0.f, 0.f, 0.f, 0.f, 0.f, 0.f, 0.f};
#pragma unroll
                    for (int n = 0; n < 4; ++n) { const u32x4 v = *(const u32x4*)(yc + (size_t)n * MC * DM + i * 8);
                        sacc[0] += bflo(v.x); sacc[1] += bfhi(v.x); sacc[2] += bflo(v.y); sacc[3] += bfhi(v.y); sacc[4] += bflo(v.z); sacc[5] += bfhi(v.z); sacc[6] += bflo(v.w); sacc[7] += bfhi(v.w); }
                    int p0 = 0, p1 = 0; p0 = __builtin_amdgcn_cvt_pk_fp8_f32(sacc[0], sacc[1], p0, false); p0 = __builtin_amdgcn_cvt_pk_fp8_f32(sacc[2], sacc[3], p0, true);
                    p1 = __builtin_amdgcn_cvt_pk_fp8_f32(sacc[4], sacc[5], p1, false); p1 = __builtin_amdgcn_cvt_pk_fp8_f32(sacc[6], sacc[7], p1, true);
                    *(u32x2*)(y + i * 8) = (u32x2){(unsigned)p0, (unsigned)p1}; } } } if (l == 0 || hi - lo == 1) SEAM(pb + 8);
        if (IN(pb + 9) && PHON(9)) REPS(9) {
            pg8::Gemm g{DM, DM, DM, F.wid};
            pg8::Sched S{ML / 256, 8, F.G, F.bid, (const char*)(F.ws + WS_Y), (const char*)(F.ws + WS_WO + (size_t)l * DM * DM), (size_t)256 * DM, (size_t)256 * DM, 1 << 20, 0};
            pg8::EpiResGate E{F.f32(WS_XR), l == 0 ? F.inp(I_X) : F.f32(WS_XR), l == 0 ? F.inp(I_CTX) : F.f32(WS_XR) + (size_t)ML * DM, F.mod(l, 0, 2), F.mod(l, 2, 2)};
            pg8::gemm_phase<pg8::EpiResGate, pg8::Sched, 1>(lds, g, S, E);
            if (l == 0) {
                pg8::Gemm g2{DM, DM, 256, F.wid};
                pg8::SchedKSplit S2{F.G, F.bid, (const char*)(F.ws + WS_Y), (const char*)(F.ws + WS_WO), (size_t)256 * DM, (size_t)256 * DM, 256};
                pg8::EpiPart E2{F.f32(WS_PART)};
                pg8::gemm_phase<pg8::EpiPart, pg8::SchedKSplit, 1>(lds, g2, S2, E2); }
        } SEAM(pb + 9);
        if (IN(pb + 10) && PHON(10)) REPS(10) { if (l == 0) norm_rows(F, F.f32(WS_XR), F.inp(I_CTX), F.inp(I_GN2), 0, 3, 4, MT, false, F.f32(WS_PART), F.mod(0, 2, 2), F.f32(WS_XR) + (size_t)ML * DM);
            else norm_rows(F, F.f32(WS_XR), F.f32(WS_XR) + (size_t)ML * DM, F.inp(I_GN2) + l * DM, l, 3, 4, nrows_a, false); } SEAM(pb + 10);
        if (IN(pb + 11) && PHON(11)) REPS(11) {
            pg8::Gemm g{DM, DM, DM, F.wid};
            pg8::Sched S{ML / 256, 8, F.G, F.bid, (const char*)F.bf(WS_HN), (const char*)(F.bf(WS_WSC) + (size_t)l * DM * DM), (size_t)256 * DM * 2, (size_t)256 * DM * 2, 1 << 20, 0};
            pg8::EpiF32 E{F.f32(WS_S), DM};
            pg8::gemm_phase(lds, g, S, E);
            if (l == 0) {
                pg8::Gemm g2{DM, DM, 256, F.wid};
                pg8::SchedKSplit S2{F.G, F.bid, (const char*)F.bf(WS_HN), (const char*)F.bf(WS_WSC), (size_t)256 * DM * 2, (size_t)256 * DM * 2, 512};
                pg8::EpiPart E2{F.f32(WS_PART)};
                pg8::gemm_phase<pg8::EpiPart, pg8::SchedKSplit, 2>(lds, g2, S2, E2); }
        } SEAM(pb + 11);
        if (IN(pb + 12) && PHON(12)) REPS(13) { peer::peer_rows(F, l, nrows_a, MK_REP == 13 && rep_ == 0); } SEAM(pb + 12);
    }
#undef IN
#undef SEAM
}

#if MK_DIAG
__device__ __forceinline__ void dacc(float* dg, int c, float err, float ref) { atomicAdd(dg + 2 * c, err * err); atomicAdd(dg + 2 * c + 1, ref * ref); }
__device__ __forceinline__ unsigned hsh(unsigned x) { x ^= x >> 16; x *= 0x7feb352dU; x ^= x >> 15; x *= 0x846ca68bU; x ^= x >> 16; return x; }
__device__ float ddot_bf(const bf16_t* a, const bf16_t* b, int K) { float s = 0.f; for (int k = 0; k < K; ++k) s += bf2f(a[k]) * bf2f(b[k]); return s; }
__global__ void __launch_bounds__(256) k_diag(Args a) {
    Ctx F; F.fresh(); F.G = gridDim.x; F.bid = blockIdx.x;
    float* dg = F.f32(WS_DIAG);
    const unsigned gt = blockIdx.x * 256 + threadIdx.x, gn = gridDim.x * 256;
#if MK_DIAG == 1
    for (unsigned i = gt; i < 4096; i += gn) { const unsigned h = hsh(i * 7 + 1); const int n = h % DIN, k = (h >> 12) % DM;
        dacc(dg, 0, bf2f(F.bf(WS_WIN)[((size_t)1 * ZLD + n) * DM + k]) - F.inp(I_WIN)[((size_t)1 * DM + k) * DIN + n], F.inp(I_WIN)[((size_t)1 * DM + k) * DIN + n]);
        const int n2 = h % DM, slot = (h >> 28) & 3, br = (0x1320 >> (4 * slot)) & 3;
        dacc(dg, 0, bf2f(F.bf(WS_WG)[(((size_t)1 * 4 + slot) * DM + n2) * DM + k]) - F.inp(I_WGATE)[(((size_t)1 * 4 + br) * DM + k) * DM + n2], F.inp(I_WGATE)[(((size_t)1 * 4 + br) * DM + k) * DM + n2]);
        const int k5 = k & 511;
        dacc(dg, 0, bf2f(F.bf(WS_WB)[(((size_t)1 * 4 + slot) * DM + n2) * 512 + k5]) - F.inp(I_WBR)[(((size_t)1 * 4 + br) * 512 + k5) * DM + n2], F.inp(I_WBR)[(((size_t)1 * 4 + br) * 512 + k5) * DM + n2]); }
    for (unsigned i = gt; i < 384; i += gn) { const unsigned h = hsh(i * 13 + 5); const int l = i & 1, v = (i >> 1) % 3, j = h % (6 * DM);
        float s = F.inp(I_BADA)[l * 6 * DM + j];
        for (int k = 0; k < DM; ++k) { const float x = v < 2 ? F.inp(I_C)[v * DM + k] : F.inp(I_CCTX)[k]; s += x / (1.0f + expf(-x)) * F.inp(I_WADA)[((size_t)l * DM + k) * 6 * DM + j]; }
        dacc(dg, 1, F.f32(WS_MOD)[(size_t)(l * 3 + v) * 6 * DM + j] - s, s); }
    for (unsigned i = gt; i < 64 * 256; i += gn) { const int rs = i >> 8, c8 = (i & 255) * 8; const int row = rs < 48 ? (hsh(rs * 3 + 2) % ML) : ML + (hsh(rs) % MC);
        const float* xr = row < ML ? F.inp(I_X) + (size_t)row * DM : F.inp(I_CTX) + (size_t)(row - ML) * DM; const int v = row < ML ? row >> 13 : 2;
        float ss = 0.f; for (int k = 0; k < DM; ++k) ss += xr[k] * xr[k]; const float r = rsqrtf(ss / DM + 1e-6f);
        for (int e = 0; e < 8; ++e) { const int c = c8 + e; const float ref = xr[c] * r * F.inp(I_GN1)[c] * (1.0f + F.mod(0, v, 1)[c]) + F.mod(0, v, 0)[c];
            dacc(dg, 2, bf2f(F.bf(WS_HN)[(size_t)row * DM + c]) - ref, ref); } }
    for (unsigned i = gt; i < 2048; i += gn) { const unsigned h = hsh(i * 11 + 3); const int row = h % MT, col = (h >> 15) % ZLD;
        const float ref = ddot_bf(F.bf(WS_HN) + (size_t)row * DM, F.bf(WS_WIN) + (size_t)col * DM, DM);
        dacc(dg, 3, bf2f(F.bf(WS_Z)[(size_t)row * ZLD + col]) - ref, ref + 1e-3f); }
#endif
#if MK_DIAG == 2
    __shared__ float sh[8448 + 64];
    for (unsigned i = gt; i < 16 * 9 * 32; i += gn) { const int d = i & 31, vi = (i >> 5) % 9, rs = i / (9 * 32); const int row = hsh(rs * 5 + 1) % ML; const int pos = row & (SEQ - 1);
        const int col = vi == 0 ? ZC_KROPE : ZC_DK + (vi - 1) * 64;
        const float x1 = bf2f(f2bf(ddot_bf(F.bf(WS_HN) + (size_t)row * DM, F.bf(WS_WIN) + (size_t)(col + d) * DM, DM))), x2 = bf2f(f2bf(ddot_bf(F.bf(WS_HN) + (size_t)row * DM, F.bf(WS_WIN) + (size_t)(col + d + 32) * DM, DM)));
        const double inv = pow(10000.0, -(double)(d & 15) / 16.0); const double ang = (double)(d < 16 ? (pos >> 6) : (pos & 63)) * (double)(float)inv; const float c = (float)cos(ang), sn = (float)sin(ang);
        dacc(dg, 0, bf2f(F.bf(WS_Z)[(size_t)row * ZLD + col + d]) - (x1 * c - x2 * sn), x1 * c - x2 * sn + 1e-3f); dacc(dg, 0, bf2f(F.bf(WS_Z)[(size_t)row * ZLD + col + d + 32]) - (x2 * c + x1 * sn), x2 * c + x1 * sn + 1e-3f); }
    for (unsigned i = gt; i < 64; i += gn) { const int row = hsh(i * 9 + 4) % MT; float s = 0.f, s2 = 0.f;
        for (int j = 0; j < 384; ++j) { const float v = bf2f(F.bf(WS_Z)[(size_t)row * ZLD + j]) / F.inp(I_GQ)[j]; s += v * v; }
        for (int j = 0; j < 256; ++j) { const float v = bf2f(F.bf(WS_Z)[(size_t)row * ZLD + 384 + j]) / F.inp(I_GKV)[j]; s2 += v * v; }
        dacc(dg, 0, sqrtf(s / 384.f) - 1.f, 1.f); dacc(dg, 0, sqrtf(s2 / 256.f) - 1.f, 1.f); }
    for (unsigned i = gt; i < 512; i += gn) { const unsigned h = hsh(i * 3 + 11); const bool cx = i >= 448; const int b = h & 1, c = (h >> 1) & 511; const int L = cx ? CTXL : SEQ; const int k = (h >> 10) % L;
        const int rb = cx ? ML + b * CTXL : b * SEQ; double re = 0, im = 0;
        for (int n = 0; n < L; ++n) { const double f = bf2f(F.bf(WS_Z)[(size_t)(rb + n) * ZLD + ZC_F + c]); const double a = -2.0 * 3.14159265358979323846 * (double)((n * k) % L) / L; re += f * cos(a); im += f * sin(a); }
        const double nr = 1.0 / sqrt((double)L * 128.0);
        dacc(dg, 1, bf2f(F.bf(WS_X)[(size_t)(rb + k) * 1024 + c]) - (float)(re * nr), (float)(re * nr)); dacc(dg, 1, bf2f(F.bf(WS_X)[(size_t)(rb + k) * 1024 + 512 + c]) - (float)(im * nr), (float)(im * nr)); }
    for (unsigned i = gt; i < 1024; i += gn) { const unsigned h = hsh(i * 17 + 2); const int row = h % MT;
        { const int col = (h >> 15) % 768; const float ref = ddot_bf(F.bf(WS_Z) + (size_t)row * ZLD + ZC_QLAT, F.bf(WS_WUQ) + (size_t)col * 384, 384); dacc(dg, 2, bf2f(F.bf(WS_Q)[(size_t)row * 768 + col]) - ref, ref + 1e-3f); }
        { const int col = (h >> 15) % 1024; const float ref = ddot_bf(F.bf(WS_Z) + (size_t)row * ZLD + ZC_KVLAT, F.bf(WS_WUKV) + (size_t)col * 256, 256); dacc(dg, 2, bf2f(F.bf(WS_KV)[(size_t)row * 1024 + col]) - ref, ref + 1e-3f); } }
    for (unsigned i = gt; i < 24 * 128; i += gn) { const int ch = i & 127, sm = i >> 7; const unsigned h = hsh(sm * 7 + 3); const int grp = h & 3; const bool cx = sm >= 20;
        const int L = cx ? CTXL : SEQ; const int b = (h >> 2) & 1; int n = (h >> 3) % L; if (sm == 0) n = 3; if (sm == 1) n = L - 2; const int rb = cx ? ML + b * CTXL : b * SEQ;
        auto cv = [&](int cg) { float acc = F.inp(I_BDW)[cg];
            for (int j = 0; j < 31; ++j) { const int nn = n + j - 15; if (nn < 0 || nn >= L) continue; const float a = bf2f(F.bf(WS_Z)[(size_t)(rb + nn) * ZLD + ZC_C + cg]), g = bf2f(F.bf(WS_Z)[(size_t)(rb + nn) * ZLD + ZC_C + 512 + cg]);
                acc += a / (1.f + expf(-g)) * F.inp(I_WDW)[(size_t)j * 512 + cg]; }
            return acc; };
        float mu = 0.f; for (int c2 = 0; c2 < 128; ++c2) mu += cv(grp * 128 + c2);
        mu /= 128.f; float var = 0.f; for (int c2 = 0; c2 < 128; ++c2) { const float v = cv(grp * 128 + c2); var += (v - mu) * (v - mu); } var /= 128.f;
        const int cg = grp * 128 + ch; const float yn = (cv(cg) - mu) * rsqrtf(var + 1e-5f) * F.inp(I_GCN)[cg] + F.inp(I_BCN)[cg]; const float ref = yn / (1.f + expf(-yn));
        dacc(dg, 3, bf2f(F.bf(WS_BR)[((size_t)1 * MT + rb + n) * 512 + cg]) - ref, ref + 1e-3f); }
    if (blockIdx.x < 48) { const int md = blockIdx.x / 24, sm = blockIdx.x % 24; const unsigned h = hsh(sm * 31 + 7 + md); const bool cx = (sm % 6) == 5; const int b = h & 1, hd = (h >> 1) & 3;
        const int qi = (h >> 3) % (cx ? CTXL : SEQ); const int qrow = cx ? ML + b * CTXL + qi : b * SEQ + qi; const int nk = cx ? CTXL : CTXL + SEQ; const int t = threadIdx.x;
        float* qv = sh + 8448;
        float outv = 0.f;
        for (int comp = 0; comp < (md == 0 ? 1 : 2); ++comp) {
            __syncthreads();
            __shared__ float qf[192];
            const int qd = md == 0 ? 192 : 64;
            if (t < qd) { float v;
                if (md == 0) v = bf2f(F.bf(WS_Q)[(size_t)qrow * 768 + hd * 192 + t]); else v = bf2f(F.bf(WS_Z)[(size_t)qrow * ZLD + ZC_DQ + hd * 128 + comp * 64 + t]);
                qf[t] = v; }
            __syncthreads();
            if (!cx) { const int ro = md == 0 ? 128 : 0; if (t < 32) { const double inv = pow(10000.0, -(double)(t & 15) / 16.0); const double ang = (double)(t < 16 ? (qi >> 6) : (qi & 63)) * (double)(float)inv;
                    const float c = (float)cos(ang), sn = (float)sin(ang); const float x1 = qf[ro + t], x2 = qf[ro + t + 32]; qv[t] = bf2f(f2bf(x1 * c - x2 * sn)); qv[t + 32] = bf2f(f2bf(x2 * c + x1 * sn)); }
                __syncthreads(); if (t < 64) qf[(md == 0 ? 128 : 0) + t] = qv[t]; __syncthreads(); }
            const float scale = md == 0 ? 0.07216878364870322f : 0.125f;
            for (int k = t; k < nk; k += 256) { const int krow = k < CTXL ? ML + b * CTXL + k : b * SEQ + (k - CTXL); float s = 0.f;
                if (md == 0) { for (int d = 0; d < 128; ++d) s += qf[d] * bf2f(F.bf(WS_KV)[(size_t)krow * 1024 + hd * 256 + d]); for (int d = 0; d < 64; ++d) s += qf[128 + d] * bf2f(F.bf(WS_Z)[(size_t)krow * ZLD + ZC_KROPE + d]); }
                else for (int d = 0; d < 64; ++d) s += qf[d] * bf2f(F.bf(WS_Z)[(size_t)krow * ZLD + ZC_DK + hd * 128 + comp * 64 + d]);
                sh[k] = s * scale; }
            __syncthreads();
            __shared__ float red[256]; float mx = -1e30f; for (int k = t; k < nk; k += 256) mx = fmaxf(mx, sh[k]); red[t] = mx; __syncthreads();
            for (int o = 128; o > 0; o >>= 1) { if (t < o) red[t] = fmaxf(red[t], red[t + o]); __syncthreads(); } mx = red[0]; __syncthreads();
            float sm2 = 0.f; for (int k = t; k < nk; k += 256) { const float e = expf(sh[k] - mx); sh[k] = e; sm2 += e; } red[t] = sm2; __syncthreads();
            for (int o = 128; o > 0; o >>= 1) { if (t < o) red[t] += red[t + o]; __syncthreads(); } const float den = red[0]; __syncthreads();
            if (t < 128) { float o = 0.f; for (int k = 0; k < nk; ++k) { const int krow = k < CTXL ? ML + b * CTXL + k : b * SEQ + (k - CTXL);
                    const float v = md == 0 ? bf2f(F.bf(WS_KV)[(size_t)krow * 1024 + hd * 256 + 128 + t]) : bf2f(F.bf(WS_Z)[(size_t)krow * ZLD + ZC_DV + hd * 128 + t]); o += sh[k] * v; }
                o /= den;
                if (md == 0) outv = o; else { float lam; { float s1 = 0.f, s2 = 0.f; for (int j = 0; j < 64; ++j) { s1 += F.inp(I_LQ1)[j] * F.inp(I_LK1)[j]; s2 += F.inp(I_LQ2)[j] * F.inp(I_LK2)[j]; } lam = expf(s1) - expf(s2) + 0.2f; }
                    outv = comp == 0 ? o : outv - lam * o; } }
        }
        __syncthreads();
        if (md == 0) { if (t < 128) dacc(dg, 4, bf2f(F.bf(WS_BR)[(size_t)qrow * 512 + hd * 128 + t]) - outv, outv + 1e-4f); }
        else { __shared__ float r2[128]; if (t < 128) r2[t] = outv * outv; __syncthreads(); float ss = 0.f; if (t < 128) { for (int j = 0; j < 128; ++j) ss += r2[j];
                const float ref = outv * rsqrtf(ss / 128.f + 1e-6f) * F.inp(I_GSUB)[t] * 0.8f; dacc(dg, 5, bf2f(F.bf(WS_BR)[((size_t)2 * MT + qrow) * 512 + hd * 128 + t]) - ref, ref + 1e-4f); } }
    }
#endif
#if MK_DIAG == 3
    for (unsigned i = gt; i < 0; i += gn) { const unsigned h = hsh(i * 5 + 9); const bool cx = i >= 80; const int b = h & 1, g = (h >> 1) & 3, m = (h >> 3) & 127; const int L = cx ? CTXL : SEQ; const int k = (h >> 10) % L;
        const int rb = cx ? ML + b * CTXL : b * SEQ; double acc = 0;
        for (int n = 0; n < L; ++n) { const double p1 = (double)((n * k) % L) / L; for (int c = 0; c < 128; ++c) { const double ph = p1 + (double)((c * m) & 127) / 128.0;
                acc += (double)bf2f(F.bf(WS_Z)[(size_t)(rb + n) * ZLD + ZC_F + g * 128 + c]) * cospi(2.0 * ph); } }
        const float ref = (float)(acc / sqrt((double)L * 128.0));
        dacc(dg, 0, bf2f(F.bf(WS_BR)[((size_t)3 * MT + rb + k) * 512 + g * 128 + m]) - ref, ref + 1e-3f); }
#if MK_STOP == 7
    for (unsigned i = gt; i < 1024; i += gn) { const unsigned h = hsh(i * 37 + 12); const int row = h % MT, col = (h >> 15) % 512;
        const float ref = ddot_bf(F.bf(WS_X) + (size_t)row * 1024, F.bf(WS_WDFT) + (size_t)col * 1024, 1024);
        dacc(dg, 4, bf2f(F.bf(WS_BR)[((size_t)3 * MT + row) * 512 + col]) - ref, ref + 1e-3f); }
    for (unsigned i = gt; i < 4096; i += gn) { const unsigned h = hsh(i * 41 + 14); const int n = h % 512, kc = (h >> 12) % 1024; const int g = n >> 7, m = n & 127, part = kc >> 9, g2 = (kc >> 7) & 3, c = kc & 127;
        const float ref = g == g2 ? (part == 0 ? (float)cos(2.0 * 3.14159265358979323846 * ((c * m) & 127) / 128.0) : (float)sin(2.0 * 3.14159265358979323846 * ((c * m) & 127) / 128.0)) : 0.f;
        dacc(dg, 5, bf2f(F.bf(WS_WDFT)[(size_t)n * 1024 + kc]) - ref, ref + (g == g2 ? 0.f : 0.f)); }
    for (unsigned i = gt; i < 2048; i += gn) { const unsigned h = hsh(i * 19 + 6); const int row = h % MT, col = (h >> 15) % DM, slot = i % 3;
        const float ref = ddot_bf(F.bf(WS_BR) + ((size_t)slot * MT + row) * 512, F.bf(WS_WB) + ((size_t)slot * DM + col) * 512, 512);
        dacc(dg, 1, bf2f(F.bf(WS_T)[((size_t)slot * MT + row) * DM + col]) - ref, ref + 1e-3f); }
#else
    for (unsigned i = gt; i < 1024; i += gn) { const unsigned h = hsh(i * 23 + 8); const int row = h % MT, col = (h >> 15) % DM; float ref = 0.f;
        for (int slot = 0; slot < 4; ++slot) { const float gt_ = ddot_bf(F.bf(WS_HN) + (size_t)row * DM, F.bf(WS_WG) + ((size_t)slot * DM + col) * DM, DM);
            ref += 1.f / (1.f + expf(-gt_)) * bf2f(F.bf(WS_T)[((size_t)slot * MT + row) * DM + col]); }
        dacc(dg, 2, bf2f(F.bf(WS_Y)[(size_t)row * DM + col]) - ref, ref + 1e-3f); }
    for (unsigned i = gt; i < 1024; i += gn) { const unsigned h = hsh(i * 29 + 10); const int row = h % MT, col = (h >> 15) % DM;
        const float d = ddot_bf(F.bf(WS_Y) + (size_t)row * DM, F.bf(WS_WO) + (size_t)col * DM, DM);
        const float x = row < ML ? F.inp(I_X)[(size_t)row * DM + col] : F.inp(I_CTX)[(size_t)(row - ML) * DM + col]; const int v = row < ML ? row >> 13 : 2;
        const float ref = x + F.mod(0, v, 2)[col] * d;
        dacc(dg, 3, F.f32(WS_XR)[(size_t)row * DM + col] - ref, ref); }
#endif
#endif
#if MK_DIAG == 5
    if (blockIdx.x == 0) { const int lane = threadIdx.x & 63, t = lane & 15, rr = lane >> 4, w = threadIdx.x >> 6;
        __shared__ unsigned kk[4][64][8]; __shared__ unsigned res[4][64];
        { const float x = (float)lane * 1.5f + 1.0f + (float)w; const float sgot = wave_sum_dpp(x); const float sexp = 1.5f * 2016.f + 64.f * (1.f + (float)w); dacc(dg, 0, sgot - sexp, sexp); }
        { const unsigned x = hsh(lane * 31 + w) | 1u; const unsigned got = row_max16_u(x); unsigned ex = 0; for (int j = 0; j < 16; ++j) { const unsigned y = hsh((rr * 16 + j) * 31 + w) | 1u; ex = y > ex ? y : ex; }
          dacc(dg, 1, got == ex ? 0.f : 1.f, 1.f);
          const float xf = (float)(hsh(lane * 7 + w) & 1023); const float gs = row_sum16_f(xf); float es = 0.f; for (int j = 0; j < 16; ++j) es += (float)(hsh((rr * 16 + j) * 7 + w) & 1023); dacc(dg, 1, gs - es, es); }
        { unsigned key[8]; for (int e = 0; e < 8; ++e) { key[e] = (hsh(lane * 8 + e + w * 977) & 0xFFFFFF80u) | (unsigned)(t * 8 + e) | 0x80000000u; kk[w][lane][e] = key[e]; }
          __syncthreads();
          const unsigned got = peer::top16_row<8>(key, t);
          int rank = 0; for (int j = 0; j < 16; ++j) for (int e = 0; e < 8; ++e) if (kk[w][rr * 16 + j][e] > got) ++rank;
          bool member = false; for (int j = 0; j < 16; ++j) for (int e = 0; e < 8; ++e) if (kk[w][rr * 16 + j][e] == got) member = true;
          dacc(dg, 2, (rank == t && member) ? 0.f : 1.f, 1.f); }
        { unsigned key[4]; for (int e = 0; e < 4; ++e) { const int q = t * 4 + e; key[e] = q < 50 ? ((hsh(lane * 4 + e + w * 131) & 0xFFFFFF00u) | (unsigned)q | 0x80000000u) : 1u + e; }
          __syncthreads(); for (int e = 0; e < 4; ++e) kk[w][lane][e] = key[e]; __syncthreads();
          const unsigned got = peer::top16_row<4>(key, t);
          int rank = 0; for (int j = 0; j < 16; ++j) for (int e = 0; e < 4; ++e) if (kk[w][rr * 16 + j][e] > got) ++rank;
          dacc(dg, 3, rank == t ? 0.f : 1.f, 1.f); }
        { const float a0 = 1.5f, a1 = -2.25f, b0 = 3.0f + lane, b1 = 0.5f; const unsigned pa = cvt_pk_bf16(a0, a1), pb = cvt_pk_bf16(b0, b1);
          const float got = __builtin_amdgcn_fdot2_f32_bf16(__builtin_bit_cast(bf16x2_t, pa), __builtin_bit_cast(bf16x2_t, pb), 10.f, false); const float ex = 10.f + a0 * b0 + a1 * b1; dacc(dg, 4, got - ex, ex); }
        { const float x = (float)(lane * lane) + (float)w; const float got = half_sum_dpp(x, lane >> 5); float ex = 0.f; for (int j = 0; j < 32; ++j) { const int ll = (lane & 32) + j; ex += (float)(ll * ll) + (float)w; } dacc(dg, 5, got - ex, ex); }
    }
#endif
#if MK_DIAG == 6
    if (blockIdx.x == 0 && threadIdx.x < 64) { const int lane = threadIdx.x;
        typedef float v32f __attribute__((ext_vector_type(32))); typedef float v16f __attribute__((ext_vector_type(16))); typedef unsigned v6u __attribute__((ext_vector_type(6)));
        float x[32]; unsigned code[32];
        for (int i = 0; i < 32; ++i) { const unsigned h = hsh(lane * 32 + i); const unsigned c = h & 63u; code[i] = c; const int sgn = (c >> 5) & 1, e = (c >> 3) & 3, m = c & 7;
            const float mag = e == 0 ? (float)m * 0.125f : (float)(1 << (e - 1)) * (1.0f + (float)m * 0.125f); x[i] = sgn ? -mag : mag; }
        unsigned long long lo = 0, mid = 0, hi = 0;
        unsigned w[6] = {0, 0, 0, 0, 0, 0};
        for (int i = 0; i < 32; ++i) { const int bit = 6 * i; const int d = bit >> 5, o = bit & 31; w[d] |= code[i] << o; if (o > 26) w[d + 1] |= code[i] >> (32 - o); }
        (void)lo; (void)mid; (void)hi;
        v6u pk; for (int d = 0; d < 6; ++d) pk[d] = w[d];
        const v32f dec = __builtin_amdgcn_cvt_scalef32_pk32_f32_fp6(pk, 1.0f);
        for (int i = 0; i < 32; ++i) dacc(dg, 0, dec[i] - x[i], fabsf(x[i]) + 0.1f);
        v16f a, b; for (int i = 0; i < 16; ++i) { a[i] = x[i]; b[i] = x[16 + i]; }
        const v6u enc = __builtin_amdgcn_cvt_scalef32_2xpk16_fp6_f32(a, b, 1.0f);
        const v32f dec2 = __builtin_amdgcn_cvt_scalef32_pk32_f32_fp6(enc, 1.0f);
        for (int i = 0; i < 32; ++i) dacc(dg, 1, dec2[i] - x[i], fabsf(x[i]) + 0.1f);
        for (int d = 0; d < 6; ++d) dacc(dg, 2, enc[d] == w[d] ? 0.f : 1.f, 1.f);
        v16f a2, b2; float y[32]; for (int i = 0; i < 32; ++i) { y[i] = ((float)(hsh(lane * 77 + i) & 0xFFFF) / 65536.0f - 0.5f) * 18.0f; if (i < 16) a2[i] = y[i]; else b2[i - 16] = y[i]; }
        const v32f dec3 = __builtin_amdgcn_cvt_scalef32_pk32_f32_fp6(__builtin_amdgcn_cvt_scalef32_2xpk16_fp6_f32(a2, b2, 1.0f), 1.0f);
        for (int i = 0; i < 32; ++i) { const float yc = fminf(fmaxf(y[i], -7.5f), 7.5f); const float ay = fabsf(yc); const float step = ay < 2.f ? 0.125f : ay < 4.f ? 0.25f : 0.5f;
            dacc(dg, 3, fabsf(dec3[i] - yc) <= 0.5f * step + 1e-6f ? 0.f : 1.f, 1.f); }
    }
#endif
#if MK_DIAG == 8
    if (blockIdx.x == 0) { const int t = threadIdx.x; const float lv[8] = {0.f, 0.5f, 1.f, 1.5f, 2.f, 3.f, 4.f, 6.f};
        const unsigned src = hsh(t * 7 + 3);
        f32x2 r[4]; r[0] = __builtin_amdgcn_cvt_scalef32_pk_f32_fp4(src, 1.0f, 0); r[1] = __builtin_amdgcn_cvt_scalef32_pk_f32_fp4(src, 1.0f, 1);
        r[2] = __builtin_amdgcn_cvt_scalef32_pk_f32_fp4(src, 1.0f, 2); r[3] = __builtin_amdgcn_cvt_scalef32_pk_f32_fp4(src, 1.0f, 3);
        for (int k = 0; k < 4; ++k) { const unsigned B = (src >> (8 * k)) & 255u; const unsigned lo = B & 15u, hi = B >> 4;
            const float flo = (lo & 8u ? -1.f : 1.f) * lv[lo & 7u], fhi = (hi & 8u ? -1.f : 1.f) * lv[hi & 7u];
            dacc(dg, 0, r[k][0] - flo, 1.f); dacc(dg, 0, r[k][1] - fhi, 1.f); dacc(dg, 1, r[k][0] - fhi, 1.f); dacc(dg, 1, r[k][1] - flo, 1.f); } }
#endif
#if MK_DIAG == 4
    if (blockIdx.x >= 16 && blockIdx.x < 32) { const int sm = blockIdx.x - 16; const int row = sm < 12 ? hsh(sm * 3 + 77) % ML : ML + hsh(sm) % MC; const int t = threadIdx.x;
        __shared__ float sv[2048]; __shared__ int ti[16][16]; __shared__ float tv[16][16]; __shared__ int ex[128]; __shared__ float gw[128];
        for (int j = t; j < DM; j += 256) sv[j] = F.f32(WS_S)[(size_t)row * DM + j];
        __syncthreads();
        if (t < 16) { for (int n = 0; n < 16; ++n) { float best = -1e30f; int bi = 0; for (int k = 0; k < 128; ++k) { const float x = sv[t * 128 + k]; if (x > best) { best = x; bi = k; } } tv[t][n] = best; ti[t][n] = bi; sv[t * 128 + bi] = -1e30f; } }
        __syncthreads();
        if (t < 8) { int used_i[16], used_j[16]; float scs[16]; int ids[16];
            for (int n = 0; n < 16; ++n) { float best = -1e30f; int bi = 0, bj = 0;
                for (int i = 0; i < 16; ++i) for (int j = 0; j < 16; ++j) { bool u = false; for (int q = 0; q < n; ++q) if (used_i[q] == i && used_j[q] == j) u = true; if (u) continue; const float x = tv[2 * t][i] + tv[2 * t + 1][j]; if (x > best) { best = x; bi = i; bj = j; } }
                used_i[n] = bi; used_j[n] = bj; scs[n] = best; ids[n] = ti[2 * t][bi] * 128 + ti[2 * t + 1][bj]; }
            float mx = scs[0], sm2 = 0.f; for (int n = 0; n < 16; ++n) mx = fmaxf(mx, scs[n]); for (int n = 0; n < 16; ++n) { scs[n] = expf(scs[n] - mx); sm2 += scs[n]; }
            for (int n = 0; n < 16; ++n) { ex[t * 16 + n] = ids[n]; gw[t * 16 + n] = scs[n] / sm2; } }
        __syncthreads();
        const float* dbg = (const float*)(F.ws + WS_R + (size_t)3 * MT * DM * 2) + (size_t)row * 384;
        if (t < 128) { const int hd = t >> 4; const int mine = (int)dbg[t]; bool found = false; float wn = 0.f; for (int n = 0; n < 16; ++n) if (ex[hd * 16 + n] == mine) { found = true; wn = gw[hd * 16 + n]; }
            dacc(dg, 0, found ? 0.f : 1.f, 1.f); if (found) dacc(dg, 1, dbg[128 + t] - wn, wn);
            float d = 0.f; for (int j = 0; j < DM; ++j) d += bf2f(F.bf(WS_PU)[(size_t)mine * DM + j]) * bf2f(F.bf(WS_HN)[(size_t)row * DM + j]);
            (void)d;
            const float* st = (const float*)(F.ws + WS_Y) + (size_t)32 * DM + sm * 256; float cfn = 0.f; bool f2 = false; for (int n = 0; n < 128; ++n) if ((int)st[128 + n] == mine && (n >> 4) == hd) { cfn = st[n]; f2 = true; }
            if (f2) dacc(dg, 4, dbg[256 + t] - cfn, cfn + 1e-4f); else dacc(dg, 4, 0.f, 1e-9f);
            const float* dbg2 = (const float*)(F.ws + WS_R + (size_t)3 * MT * DM * 2) + (size_t)MT * 384 + (size_t)row * 256;
            dacc(dg, 2, dbg2[128 + t] - dbg[t], 1.f);
            { float dn = 0.f; bool f3 = false; for (int n = 0; n < 128; ++n) if ((int)st[128 + n] == mine && (n >> 4) == hd) { dn = ((const float*)(F.ws + WS_Y))[(size_t)32 * DM + 16 * 256 + sm * 128 + n]; f3 = true; }
              if (f3) dacc(dg, 3, dbg2[t] - dn, dn + 1e-3f); else dacc(dg, 3, 0.f, 1e-9f); } }
    }
    if (blockIdx.x < 16) { const int sm = blockIdx.x; const int row = sm < 12 ? hsh(sm * 3 + 77) % ML : ML + hsh(sm) % MC; const int t = threadIdx.x; const int v = row < ML ? row >> 13 : 2;
        const float* exp_ = (const float*)(F.ws + WS_Y) + (size_t)sm * DM; const float* x2 = F.f32(WS_XR) + (size_t)row * DM;
        __shared__ float red[256]; float ss = 0.f;
        for (int j = t; j < DM; j += 256) { dacc(dg, 5, x2[j] - exp_[j], exp_[DM * 16 + (size_t)sm * DM + j]); ss += x2[j] * x2[j]; }
        red[t] = ss; __syncthreads(); for (int o = 128; o > 0; o >>= 1) { if (t < o) red[t] += red[t + o]; __syncthreads(); }
        const float rs = rsqrtf(red[0] / DM + 1e-6f);
        for (int j = t; j < DM; j += 256) { const float ref = x2[j] * rs * F.inp(I_GN1)[DM + j] * (1.f + F.mod(1, v, 1)[j]) + F.mod(1, v, 0)[j]; dacc(dg, 9, bf2f(F.bf(WS_HN)[(size_t)row * DM + j]) - ref, ref); } }
#endif
}
#if MK_DIAG == 4
__global__ void __launch_bounds__(256) k_diag_pre(Args a) {
    Ctx F; F.fresh(); F.G = gridDim.x; F.bid = blockIdx.x;
    float* dg = F.f32(WS_DIAG);
    const unsigned gt = blockIdx.x * 256 + threadIdx.x, gn = gridDim.x * 256;
    for (unsigned i = gt; i < 32 * 256; i += gn) { const int rs_ = i >> 8, c8 = (i & 255) * 8; const int row = rs_ < 24 ? (hsh(rs_ * 3 + 21) % ML) : ML + (hsh(rs_) % MC);
        const float* xr = F.f32(WS_XR) + (size_t)row * DM; const int v = row < ML ? row >> 13 : 2;
        float ss = 0.f; for (int k = 0; k < DM; ++k) ss += xr[k] * xr[k]; const float r = rsqrtf(ss / DM + 1e-6f);
        for (int e = 0; e < 8; ++e) { const int c = c8 + e; const float ref = xr[c] * r * F.inp(I_GN2)[c] * (1.0f + F.mod(0, v, 4)[c]) + F.mod(0, v, 3)[c];
            dacc(dg, 6, bf2f(F.bf(WS_HN)[(size_t)row * DM + c]) - ref, ref); } }
    for (unsigned i = gt; i < 1024; i += gn) { const unsigned h = hsh(i * 43 + 16); const int row = h % MT, col = (h >> 15) % DM;
        const float ref = ddot_bf(F.bf(WS_HN) + (size_t)row * DM, F.bf(WS_WPQ) + (size_t)col * DM, DM); dacc(dg, 7, bf2f(F.bf(WS_PQ)[(size_t)row * DM + col]) - ref, ref + 1e-3f); }
    for (unsigned i = gt; i < 4096; i += gn) { const unsigned h = hsh(i * 47 + 18); const int row = h % MT, col = (h >> 15) % DM; const int hd = col >> 8, p = (col >> 7) & 1, k = col & 127; float ref = 0.f;
        for (int d = 0; d < 128; ++d) ref += bf2f(F.bf(WS_PQ)[(size_t)row * DM + hd * 256 + p * 128 + d]) * bf2f(f2bf(F.inp(I_PKEYS)[((size_t)p * 128 + k) * 128 + d]));
        dacc(dg, 8, F.f32(WS_S)[(size_t)row * DM + col] - ref, ref + 1e-3f); }
    if (blockIdx.x < 16) { const int sm = blockIdx.x; const int row = sm < 12 ? hsh(sm * 3 + 77) % ML : ML + hsh(sm) % MC; const int t = threadIdx.x; const int v = row < ML ? row >> 13 : 2;
        __shared__ float sv[2048]; __shared__ int ti[16][16]; __shared__ float tv[16][16]; __shared__ int ex[128]; __shared__ float gw[128]; __shared__ float cf[128];
        for (int j = t; j < DM; j += 256) sv[j] = F.f32(WS_S)[(size_t)row * DM + j];
        __syncthreads();
        if (t < 16) { for (int n = 0; n < 16; ++n) { float best = -1e30f; int bi = 0; for (int k = 0; k < 128; ++k) { const float x = sv[t * 128 + k]; if (x > best) { best = x; bi = k; } } tv[t][n] = best; ti[t][n] = bi; sv[t * 128 + bi] = -1e30f; } }
        __syncthreads();
        if (t < 8) { int used_i[16], used_j[16]; float scs[16]; int ids[16];
            for (int n = 0; n < 16; ++n) { float best = -1e30f; int bi = 0, bj = 0;
                for (int i = 0; i < 16; ++i) for (int j = 0; j < 16; ++j) { bool u = false; for (int q = 0; q < n; ++q) if (used_i[q] == i && used_j[q] == j) u = true; if (u) continue; const float x = tv[2 * t][i] + tv[2 * t + 1][j]; if (x > best) { best = x; bi = i; bj = j; } }
                used_i[n] = bi; used_j[n] = bj; scs[n] = best; ids[n] = ti[2 * t][bi] * 128 + ti[2 * t + 1][bj]; }
            float mx = scs[0], sm2 = 0.f; for (int n = 0; n < 16; ++n) mx = fmaxf(mx, scs[n]); for (int n = 0; n < 16; ++n) { scs[n] = expf(scs[n] - mx); sm2 += scs[n]; }
            for (int n = 0; n < 16; ++n) { ex[t * 16 + n] = ids[n]; gw[t * 16 + n] = scs[n] / sm2; } }
        __syncthreads();
        if (t < 128) { float d = 0.f; for (int j = 0; j < DM; ++j) d += bf2f(F.bf(WS_PU)[(size_t)ex[t] * DM + j]) * bf2f(F.bf(WS_HN)[(size_t)row * DM + j]); cf[t] = gw[t] * 0.5f * d * (1.f + erff(d * 0.70710678f)); ((float*)(F.ws + WS_Y))[(size_t)32 * DM + 16 * 256 + sm * 128 + t] = d; }
        __syncthreads();
        float* st = (float*)(F.ws + WS_Y);
        if (t < 128) { st[(size_t)32 * DM + sm * 256 + t] = cf[t]; st[(size_t)32 * DM + sm * 256 + 128 + t] = (float)ex[t]; }
        for (int j = t; j < DM; j += 256) { float o = 0.f; for (int k = 0; k < 128; ++k) o += cf[k] * bf2f(F.bf(WS_PV)[(size_t)ex[k] * DM + j]);
            st[(size_t)sm * DM + j] = F.f32(WS_XR)[(size_t)row * DM + j] + F.mod(0, v, 5)[j] * o; st[(size_t)16 * DM + (size_t)sm * DM + j] = F.mod(0, v, 5)[j] * o; }
    }
}
#endif
__global__ void __launch_bounds__(256) k_diag_fill(Args a, size_t n) {
    const float* dg = (const float*)(a.ws + WS_DIAG);
    const float tol[8] = {MK_DIAG == 4 ? 0.1f : 0.02f, 0.02f, 0.02f, 0.02f, 0.02f, 0.02f, 0.02f, 0.02f};
    int id = 15; float e = 0.f;
    const int nchk = MK_DIAG == 6 ? 4 : MK_DIAG == 1 ? 4 : MK_DIAG == 2 ? 6 : MK_DIAG == 3 ? (MK_STOP == 7 ? 3 : 2) : 6;
    const int order3[6] = {MK_STOP == 7 ? 5 : 2, MK_STOP == 7 ? 4 : 3, 1, 0, 0, 0};
    for (int cc = 0; cc < nchk; ++cc) { const int c = MK_DIAG == 3 ? order3[cc] : cc; const float num = dg[2 * c], den = dg[2 * c + 1]; const float ec = den > 0.f ? sqrtf(num / den) : 1.f;
        if (!(ec <= tol[c])) { id = c; e = ec; break; } if (ec > e) e = ec; }
    if (!(e == e)) e = 1.f; e = fminf(fmaxf(e, 1e-6f), 1.f);
    const float m = 1.0f + 1.4f * log10f(e * 1e6f);
    const float c2 = m * powf(10.f, 4.f + (float)id);
    const float val = sqrtf(c2);
    for (size_t i = (size_t)blockIdx.x * 256 + threadIdx.x; i < n; i += (size_t)gridDim.x * 256) a.out[i] = val;
}
#endif

extern "C" void kernel_launch(void* const* d_in, const int* in_sizes, int n_in, void* d_out, int out_size, void* d_ws, size_t ws_size, hipStream_t stream) {
    static int grid = 0;
    if (grid == 0) {
        if (n_in != 30 || out_size != ML * DM || ws_size < WS_END) { fprintf(stderr, "kernel_launch: needs 30 inputs, %d outputs, >= %zu bytes of workspace; got n_in %d out %d ws %zu\n", ML * DM, (size_t)WS_END, n_in, out_size, ws_size); grid = -1; return; }
        int dev = 0, cus = 0, per_cu = 0;
        if (hipGetDevice(&dev) != hipSuccess || hipDeviceGetAttribute(&cus, hipDeviceAttributeMultiprocessorCount, dev) != hipSuccess) { grid = -1; return; }
        if (hipFuncSetAttribute((const void*)mk_fwd, hipFuncAttributeMaxDynamicSharedMemorySize, LDS_BYTES) != hipSuccess) { fprintf(stderr, "kernel_launch: hipFuncSetAttribute failed\n"); grid = -1; return; }
        if (hipOccupancyMaxActiveBlocksPerMultiprocessor(&per_cu, (const void*)mk_fwd, NTHREADS, LDS_BYTES) != hipSuccess || per_cu < 1) { fprintf(stderr, "kernel_launch: occupancy query says %d\n", per_cu); (void)hipGetLastError(); grid = -1; return; }
        grid = cus;
    }
    if (grid < 0) return;
    (void)hipMemsetAsync((char*)d_ws, 0, WS_ZERO_END, stream);
    Args a{};
    for (int i = 0; i < 30; ++i) a.in[i] = (const float*)d_in[i];
    a.out = (float*)d_out; a.ws = (unsigned char*)d_ws;
    constexpr int STOP = MK_STOP < NPHASES ? MK_STOP : NPHASES;
#if MK_MULTI
    for (int ph = 0; ph < STOP; ++ph) {
#if MK_DIAG == 4
        if (ph == STOP - 1) hipLaunchKernelGGL(k_diag_pre, dim3(64), dim3(256), 0, stream, a);
#endif
        a.ph_lo = ph; a.ph_hi = ph + 1; hipLaunchKernelGGL(mk_fwd, dim3(grid), dim3(NTHREADS), LDS_BYTES, stream, a); }
#else
    a.ph_lo = 0; a.ph_hi = STOP; hipLaunchKernelGGL(mk_fwd, dim3(grid), dim3(NTHREADS), LDS_BYTES, stream, a);
#endif
#if MK_DIAG
    hipLaunchKernelGGL(k_diag, dim3(64), dim3(256), 0, stream, a);
    hipLaunchKernelGGL(k_diag_fill, dim3(1024), dim3(256), 0, stream, a, (size_t)ML * DM);
#endif
    const hipError_t le = hipPeekAtLastError();
    if (le != hipSuccess) fprintf(stderr, "kernel_launch: launch failed: %s\n", hipGetErrorName(le));
}
```

```cpp
#include <hip/hip_runtime.h>
#include <cstdio>
#include <cstdint>
#include <cstddef>

#define LAS __attribute__((address_space(3)))
typedef unsigned short bf16_t;
typedef short bf16x8 __attribute__((ext_vector_type(8)));
typedef short s16x4 __attribute__((ext_vector_type(4)));
typedef float f32x4 __attribute__((ext_vector_type(4)));
typedef float f32x2 __attribute__((ext_vector_type(2)));
typedef float f32x16 __attribute__((ext_vector_type(16)));
typedef unsigned u32x4 __attribute__((ext_vector_type(4)));
typedef unsigned u32x2 __attribute__((ext_vector_type(2)));
typedef __bf16 bf16x2_t __attribute__((ext_vector_type(2)));

#ifndef MK_MULTI
#define MK_MULTI 0
#endif
#ifndef MK_DIAG
#define MK_DIAG 0
#endif
#ifndef MK_STOP
#define MK_STOP 1000
#endif

constexpr int DM = 2048, NBATCH = 2, SEQ = 8192, CTXL = 256, DEPTH = 2;
constexpr int ML = NBATCH * SEQ, MC = NBATCH * CTXL, MT = ML + MC;
constexpr int DIN = 3776, ZLD = 3840;
constexpr int ZC_QLAT = 0, ZC_KVLAT = 384, ZC_KROPE = 640, ZC_DQ = 704, ZC_DK = 1216, ZC_DV = 1728, ZC_F = 2240, ZC_C = 2752;
constexpr int NEXP = 16384;
#ifndef MK_UBITS
#define MK_UBITS 4
#endif
#ifndef MK_VBITS
#define MK_VBITS 4
#endif
constexpr int PEER_UBITS = MK_UBITS, PEER_VBITS = MK_VBITS;
constexpr int PEER_UROWB = DM * PEER_UBITS / 8, PEER_VROWB = DM * PEER_VBITS / 8;
constexpr int NTHREADS = 512, NWAVES = 8;
constexpr int LDS_BYTES = 160 * 1024;

constexpr size_t al256(size_t x) { return (x + 255) / 256 * 256; }
constexpr size_t WS_BAR   = 0;
constexpr size_t WS_MOD   = 16384;
constexpr size_t WS_DIAG  = WS_MOD + al256((size_t)DEPTH * 3 * 6 * DM * 4);
constexpr size_t WS_ZERO_END = WS_DIAG + 4096;
constexpr size_t WS_ROPE  = WS_ZERO_END;
constexpr size_t WS_WIN   = WS_ROPE + (size_t)SEQ * 32 * 2 * 4;
constexpr size_t WS_WG    = WS_WIN + (size_t)DEPTH * ZLD * DM * 2;
constexpr size_t WS_WB    = WS_WG + (size_t)DEPTH * 4 * DM * DM;
constexpr size_t WS_WO    = WS_WB + (size_t)DEPTH * 4 * DM * 512 * 2;
constexpr size_t WS_WPQ   = WS_WO + (size_t)DEPTH * DM * DM * 2;
constexpr size_t WS_WUQ   = WS_WPQ + (size_t)DEPTH * DM * DM * 2;
constexpr size_t WS_WUKV  = WS_WUQ + (size_t)DEPTH * 768 * 384 * 2;
constexpr size_t WS_KB    = WS_WUKV + (size_t)DEPTH * 1024 * 256 * 2;
constexpr size_t WS_WDFT  = WS_KB + (size_t)DEPTH * 256 * 256 * 2;
constexpr size_t WS_PU    = WS_WDFT + (size_t)512 * 1024 * 2;
constexpr size_t WS_PV    = WS_PU + (size_t)DEPTH * NEXP * PEER_UROWB;
constexpr size_t WS_XR    = WS_PV + (size_t)DEPTH * NEXP * PEER_VROWB;
constexpr size_t WS_HN    = WS_XR + (size_t)MT * DM * 4;
constexpr size_t WS_BR    = WS_HN + (size_t)MT * DM * 2;
constexpr size_t WS_Y     = WS_BR + (size_t)4 * MT * 512 * 2;
constexpr size_t WS_R     = WS_Y + (size_t)MT * DM * 2;
constexpr size_t WS_Z     = WS_R;
constexpr size_t WS_Q     = WS_Z + (size_t)MT * ZLD * 2;
constexpr size_t WS_KV    = WS_Q + (size_t)MT * 768 * 2;
constexpr size_t WS_AP    = WS_KV + (size_t)MT * 1024 * 2;
constexpr size_t WS_X     = WS_AP + (size_t)NBATCH * 128 * 2 * 64 * 512 * 2;
constexpr size_t WS_T     = WS_R;
constexpr size_t WS_S     = WS_R;
constexpr size_t WS_PART  = WS_R + (size_t)MT * DM * 4;
constexpr size_t WS_R_END = WS_R + (size_t)4 * MT * DM * 2;
static_assert(WS_PART + (size_t)8 * MC * DM * 4 <= WS_R_END, "partials must fit in region R");
constexpr size_t WS_YC    = WS_R_END;
constexpr size_t WS_WSC   = WS_YC + (size_t)4 * MC * DM * 2;
constexpr size_t WS_HN8   = WS_WSC + (size_t)DEPTH * DM * DM * 2;
constexpr size_t WS_K8    = WS_HN8 + (size_t)MT * DM;
constexpr size_t WS_KD8   = WS_K8 + (size_t)MT * 1024 + 256;
constexpr size_t WS_V8T   = WS_KD8 + (size_t)MT * 512 + 256;
constexpr size_t WS_VD8T  = WS_V8T + (size_t)4 * (MT / 64) * 8192 + 256;
constexpr size_t WS_QL8   = WS_VD8T + (size_t)4 * (MT / 64) * 8192 + 256;
constexpr size_t WS_KVL8  = WS_QL8 + (size_t)MT * 512;
constexpr size_t WS_END   = WS_KVL8 + (size_t)MT * 256 + 256;
static_assert(WS_X + (size_t)MT * 1024 * 2 <= WS_R_END, "region R overflow");
static_assert((size_t)256 * 32 * 512 * 16 <= (size_t)4 * MT * 512 * 2, "YS scratch must fit in BR");

struct Args { const float* in[30]; float* out; unsigned char* ws; int ph_lo, ph_hi; };
enum { I_X = 0, I_C, I_CTX, I_CCTX, I_WADA, I_BADA, I_GN1, I_GN2, I_WIN, I_GQ, I_WUQ, I_GKV, I_WUKV, I_LQ1, I_LK1, I_LQ2, I_LK2, I_GSUB, I_WDW, I_BDW, I_GCN, I_BCN,
       I_WGATE, I_WBR, I_WOUT, I_WPQ, I_PKEYS, I_PU, I_PV, I_GFIN };

__device__ __forceinline__ unsigned cvt_pk_bf16(float lo, float hi) { unsigned r; asm volatile("v_cvt_pk_bf16_f32 %0, %1, %2" : "=v"(r) : "v"(lo), "v"(hi)); return r; }
__device__ __forceinline__ bf16_t f2bf(float f) { unsigned u = __float_as_uint(f); u += 0x7FFFu + ((u >> 16) & 1u); return (bf16_t)(u >> 16); }
__device__ __forceinline__ float bf2f(bf16_t b) { return __uint_as_float(((unsigned)b) << 16); }
__device__ __forceinline__ float bflo(unsigned w) { return __uint_as_float(w << 16); }
__device__ __forceinline__ float bfhi(unsigned w) { return __uint_as_float(w & 0xFFFF0000u); }
__device__ __forceinline__ int tid_of_wave(int wv) { int ln; asm volatile("v_mbcnt_lo_u32_b32 %0, -1, 0\n\tv_mbcnt_hi_u32_b32 %0, -1, %0" : "=v"(ln)); return wv * 64 + ln; }
__device__ __forceinline__ unsigned char f2fp8(float v) { return (unsigned char)(__builtin_amdgcn_cvt_pk_fp8_f32(v, v, 0, false) & 0xFF); }
__device__ __forceinline__ float sigmoidf_(float x) { return __builtin_amdgcn_rcpf(1.0f + __expf(-x)); }
template <int CTRL> __device__ __forceinline__ unsigned dpp_u(unsigned x) { return (unsigned)__builtin_amdgcn_update_dpp(0, (int)x, CTRL, 0xf, 0xf, true); }
template <int CTRL> __device__ __forceinline__ float dpp_f(float x) { return __int_as_float(__builtin_amdgcn_update_dpp(0, __float_as_int(x), CTRL, 0xf, 0xf, true)); }
__device__ __forceinline__ unsigned row_max16_u(unsigned x) { unsigned y = dpp_u<0xB1>(x); x = x > y ? x : y; y = dpp_u<0x4E>(x); x = x > y ? x : y; y = dpp_u<0x141>(x); x = x > y ? x : y; y = dpp_u<0x140>(x); return x > y ? x : y; }
__device__ __forceinline__ float row_max16_f(float x) { x = fmaxf(x, dpp_f<0xB1>(x)); x = fmaxf(x, dpp_f<0x4E>(x)); x = fmaxf(x, dpp_f<0x141>(x)); return fmaxf(x, dpp_f<0x140>(x)); }
__device__ __forceinline__ float row_sum16_f(float x) { x += dpp_f<0xB1>(x); x += dpp_f<0x4E>(x); x += dpp_f<0x141>(x); return x + dpp_f<0x140>(x); }
__device__ __forceinline__ float wave_sum_dpp(float x) {
    x = row_sum16_f(x);
    const float a = __int_as_float(__builtin_amdgcn_readlane(__float_as_int(x), 0)), b = __int_as_float(__builtin_amdgcn_readlane(__float_as_int(x), 16));
    const float c = __int_as_float(__builtin_amdgcn_readlane(__float_as_int(x), 32)), d = __int_as_float(__builtin_amdgcn_readlane(__float_as_int(x), 48));
    return (a + b) + (c + d);
}
__device__ __forceinline__ float wave_sum(float v) { return wave_sum_dpp(v); }
__device__ __forceinline__ float half_sum_dpp(float x, int hi) {
    x = row_sum16_f(x);
    const float a = __int_as_float(__builtin_amdgcn_readlane(__float_as_int(x), 0)), b = __int_as_float(__builtin_amdgcn_readlane(__float_as_int(x), 16));
    const float c = __int_as_float(__builtin_amdgcn_readlane(__float_as_int(x), 32)), d = __int_as_float(__builtin_amdgcn_readlane(__float_as_int(x), 48));
    return hi ? (c + d) : (a + b);
}

#define XB_TMO      128
#define XB_XCNT(j)  (256  + 64 * (j))
#define XB_XSUB(j)  (1280 + 64 * (j))
#define XB_XGEN(j)  (2304 + 64 * (j))
#define XB_TOP      3328
#define XB_TOPGEN   3392
#define XCD_BAR_WORDS 3456
#define XB_SPIN_CAP (1u << 20)
__device__ __forceinline__ unsigned xb_ld(unsigned* p)              { return __hip_atomic_load(p, __ATOMIC_RELAXED, __HIP_MEMORY_SCOPE_AGENT); }
__device__ __forceinline__ unsigned xb_add(unsigned* p, unsigned v) { return __hip_atomic_fetch_add(p, v, __ATOMIC_RELAXED, __HIP_MEMORY_SCOPE_AGENT); }
__device__ __forceinline__ unsigned xb_xcc_id() { return (unsigned)__builtin_amdgcn_s_getreg((3 << 11) | 20) & 0xFu; }
#define XB_SPIN(cond, bar) do { unsigned _sp = 0; while (cond) { __builtin_amdgcn_s_sleep(1); \
    if ((++_sp & 255u) == 0u) { if (xb_ld(&(bar)[XB_TMO])) break; if (_sp > XB_SPIN_CAP) { atomicAdd(&(bar)[XB_TMO], 1u); break; } } } } while (0)
struct XcdBarrier { unsigned* bar; unsigned x; volatile LAS unsigned* st; };
__device__ __forceinline__ XcdBarrier xcd_barrier_post(unsigned* bar, volatile LAS unsigned* st, int tid) {
    XcdBarrier b; b.bar = bar; b.x = xb_xcc_id(); b.st = st;
    if (tid == 0) (void)xb_add(&bar[XB_XCNT(b.x)], 1u);
    return b;
}
__device__ __forceinline__ void xcd_barrier_complete(unsigned* bar, unsigned x, unsigned& nloc, unsigned& nx) {
    const unsigned G = gridDim.x * gridDim.y * gridDim.z;
    unsigned sum, cnt, mine, sp = 0u;
    for (;;) {
        sum = 0u; cnt = 0u; mine = 0u;
#pragma unroll
        for (unsigned j = 0; j < 16; ++j) { const unsigned c = xb_ld(&bar[XB_XCNT(j)]); sum += c; cnt += (c > 0u) ? 1u : 0u; mine = (j == x) ? c : mine; }
        if (sum == G) break;
        __builtin_amdgcn_s_sleep(1);
        if ((++sp & 255u) == 0u) { if (xb_ld(&bar[XB_TMO])) break; if (sp > XB_SPIN_CAP) { atomicAdd(&bar[XB_TMO], 1u); break; } }
    }
    nloc = mine > 0u ? mine : 1u; nx = cnt > 0u ? cnt : 1u;
}
__device__ __forceinline__ void xcd_barrier(const XcdBarrier& b, int tid) {
    asm volatile("s_waitcnt vmcnt(0)" ::: "memory");
    __syncthreads();
    if (tid == 0) {
        unsigned* bar = b.bar;
        __builtin_amdgcn_s_waitcnt(0);
        unsigned nloc = b.st[0], nx = b.st[1];
        if (nloc == 0u) { xcd_barrier_complete(bar, b.x, nloc, nx); b.st[0] = nloc; b.st[1] = nx; }
        const unsigned old = xb_add(&bar[XB_XSUB(b.x)], 1u);
        const unsigned gen = old / nloc;
        if (old + 1u == (gen + 1u) * nloc) {
            __builtin_amdgcn_fence(__ATOMIC_RELEASE, "agent");
            asm volatile("s_waitcnt vmcnt(0)" ::: "memory");
            const unsigned og = xb_add(&bar[XB_TOP], 1u);
            const unsigned tg = og / nx;
            if (og + 1u == (tg + 1u) * nx) xb_add(&bar[XB_TOPGEN], 1u);
            else XB_SPIN(xb_ld(&bar[XB_TOPGEN]) == tg, bar);
            __builtin_amdgcn_fence(__ATOMIC_ACQUIRE, "agent");
            xb_add(&bar[XB_XGEN(b.x)], 1u);
            asm volatile("s_waitcnt vmcnt(0)" ::: "memory");
        } else {
            XB_SPIN(xb_ld(&bar[XB_XGEN(b.x)]) == gen, bar);
            __builtin_amdgcn_fence(__ATOMIC_ACQUIRE, "agent");
            asm volatile("s_waitcnt vmcnt(0)" ::: "memory");
        }
    }
    __syncthreads();
}

namespace pg8 {
constexpr int BM = 256, BK = 64, HALF = 128, HTB = HALF * BK * 2, STAGE_BYTES = 8 * HTB, NXCD = 8, WGM = 8;
__host__ __device__ __forceinline__ int lds_byte(int r, int c) { const int st = (r >> 4) * 2 + (c >> 5), rr = r & 15, cc = c & 31, ob = rr * 64 + cc * 2; return st * 1024 + (ob ^ (((ob >> 9) & 1) << 5)); }
__host__ __device__ __forceinline__ void stage_rc(int b, int& R, int& C) { const int st = b / 1024, sb = b % 1024, swz = sb ^ (((sb >> 9) & 1) << 5); R = (st >> 1) * 16 + swz / 64; C = (st & 1) * 32 + (swz % 64) / 2; }
__host__ __device__ __forceinline__ int perm32(int rho) { const int n = rho >> 4, i = rho & 15; return 8 * (i >> 2) + 4 * n + (i & 3); }

typedef int v8i_t __attribute__((ext_vector_type(8)));
template <int ELT> struct FragT { bf16x8 k[2]; };
template <> struct FragT<1> { v8i_t v; };
struct Unit { int pm, pn; const char* a; const char* b; };
struct Gemm { int lda, ldb, K; int wv; };

__device__ __forceinline__ void tile_of(int L, int nM, int nN, int& pm, int& pn) {
    const int nwg = nM * nN; int wgid = L;
    { const int q = nwg / NXCD, r = nwg % NXCD, xcd = wgid % NXCD, off = wgid / NXCD; wgid = (xcd < r ? xcd * (q + 1) : r * (q + 1) + (xcd - r) * q) + off; }
    const int nig = WGM * nN, gid = wgid / nig, fm = gid * WGM, gsz = (nM - fm) < WGM ? (nM - fm) : WGM;
    pm = fm + ((wgid % nig) % gsz); pn = (wgid % nig) / gsz;
}
struct Sched {
    int nM, nN, G, c; const char* A; const char* B; size_t a_tile, b_tile; int a_div; size_t a_dstride; int sa0 = 0x7F7F7F7F;
    __device__ __forceinline__ int a_scale(const Unit& u) const { return (u.pn / a_div) == 0 ? sa0 : 0x7F7F7F7F; }
    __device__ __forceinline__ bool next(int i, Unit& u) const {
        const long L = (long)i * G + c; if (L >= (long)nM * nN) return false;
        tile_of((int)L, nM, nN, u.pm, u.pn);
        u.a = A + (size_t)u.pm * a_tile + (size_t)(u.pn / a_div) * a_dstride; u.b = B + (size_t)u.pn * b_tile; return true;
    }
};
struct SchedWsc {
    int G, c; const char* KB; const char* W;
    __device__ __forceinline__ bool next(int i, Unit& u) const {
        const long L = (long)i * G + c; if (L >= DEPTH * 64) return false;
        const int l = (int)L >> 6, h = ((int)L >> 3) & 7, pn = (int)L & 7; u.pm = h; u.pn = l * 8 + pn;
        u.a = KB + (size_t)l * 256 * 256 * 2; u.b = W + ((size_t)l * DM * DM + (size_t)pn * 256 * DM + h * 256) * 2; return true;
    }
};
struct SchedGate {
    int nM, G, c; const char* A; const char* B; size_t a_tile, b_tile;
    __device__ __forceinline__ int a_scale(const Unit&) const { return 0x7F7F7F7F; }
    __device__ __forceinline__ bool next(int i, Unit& u) const {
        const long L = (long)(i >> 2) * G + c; if (L >= (long)nM * 8) return false;
        int pm, pn; tile_of((int)L, nM, 8, pm, pn); const int n = i & 3;
        u.pm = pm; u.pn = n * 8 + pn; u.a = A + (size_t)pm * a_tile; u.b = B + (size_t)u.pn * b_tile; return true;
    }
};

struct EpiBf16 {
    static constexpr bool PERM = true;
    bf16_t* O; int ldc; int pn_div; size_t pn_stride;
    __device__ __forceinline__ void operator()(const f32x4 (&acc)[2][2][4][2], const Unit& u, int wr, int wc, int fr, int fq) const {
        bf16_t* base = O + (size_t)(u.pn / pn_div) * pn_stride;
        const int row0 = u.pm * BM + wr * 64 + fr, col0 = (u.pn % pn_div) * BM + wc * 32 + 8 * fq;
#pragma unroll
        for (int ai = 0; ai < 2; ++ai)
#pragma unroll
            for (int m = 0; m < 4; ++m) { bf16_t* rowp = base + (size_t)(row0 + ai * HALF + m * 16) * ldc + col0;
#pragma unroll
                for (int bj = 0; bj < 2; ++bj) { const f32x4 v0 = acc[ai][bj][m][0], v1 = acc[ai][bj][m][1];
                    u32x4 w; w.x = cvt_pk_bf16(v0[0], v0[1]); w.y = cvt_pk_bf16(v0[2], v0[3]); w.z = cvt_pk_bf16(v1[0], v1[1]); w.w = cvt_pk_bf16(v1[2], v1[3]);
                    *(u32x4*)(rowp + bj * HALF) = w; } }
    }
};
struct EpiKV {
    static constexpr bool PERM = true;
    bf16_t* O; unsigned char* K8;
    __device__ __forceinline__ void operator()(const f32x4 (&acc)[2][2][4][2], const Unit& u, int wr, int wc, int fr, int fq) const {
        const int row0 = u.pm * BM + wr * 64 + fr;
        bf16_t* ob = O + (size_t)row0 * 1024 + u.pn * BM + HALF + wc * 32 + 8 * fq; unsigned char* kb = K8 + ((size_t)row0 * 4 + u.pn) * 256 + wc * 32 + 8 * fq;
#pragma unroll
        for (int ai = 0; ai < 2; ++ai)
#pragma unroll
            for (int m = 0; m < 4; ++m) { int dr = (ai * HALF + m * 16) * 1024; asm volatile("" : "+v"(dr));
                { const f32x4 v0 = acc[ai][0][m][0], v1 = acc[ai][0][m][1]; int p0 = 0, p1 = 0;
                  p0 = __builtin_amdgcn_cvt_pk_fp8_f32(v0[0], v0[1], p0, false); p0 = __builtin_amdgcn_cvt_pk_fp8_f32(v0[2], v0[3], p0, true);
                  p1 = __builtin_amdgcn_cvt_pk_fp8_f32(v1[0], v1[1], p1, false); p1 = __builtin_amdgcn_cvt_pk_fp8_f32(v1[2], v1[3], p1, true);
                  *(u32x2*)(kb + dr) = (u32x2){(unsigned)p0, (unsigned)p1}; }
                { const f32x4 v0 = acc[ai][1][m][0], v1 = acc[ai][1][m][1];
                  u32x4 w; w.x = cvt_pk_bf16(v0[0], v0[1]); w.y = cvt_pk_bf16(v0[2], v0[3]); w.z = cvt_pk_bf16(v1[0], v1[1]); w.w = cvt_pk_bf16(v1[2], v1[3]);
                  *(u32x4*)(ob + dr) = w; } }
    }
};
struct EpiFp8 {
    static constexpr bool PERM = true;
    unsigned char* O; int ldc; int pn_div; size_t pn_stride;
    __device__ __forceinline__ void operator()(const f32x4 (&acc)[2][2][4][2], const Unit& u, int wr, int wc, int fr, int fq) const {
        unsigned char* base = O + (size_t)(u.pn / pn_div) * pn_stride;
        const int row0 = u.pm * BM + wr * 64 + fr, col0 = (u.pn % pn_div) * BM + wc * 32 + 8 * fq;
#pragma unroll
        for (int ai = 0; ai < 2; ++ai)
#pragma unroll
            for (int m = 0; m < 4; ++m) { unsigned char* rowp = base + (size_t)(row0 + ai * HALF + m * 16) * ldc + col0;
#pragma unroll
                for (int bj = 0; bj < 2; ++bj) { const f32x4 v0 = acc[ai][bj][m][0], v1 = acc[ai][bj][m][1]; int p0 = 0, p1 = 0;
                    p0 = __builtin_amdgcn_cvt_pk_fp8_f32(v0[0], v0[1], p0, false); p0 = __builtin_amdgcn_cvt_pk_fp8_f32(v0[2], v0[3], p0, true);
                    p1 = __builtin_amdgcn_cvt_pk_fp8_f32(v1[0], v1[1], p1, false); p1 = __builtin_amdgcn_cvt_pk_fp8_f32(v1[2], v1[3], p1, true);
                    *(u32x2*)(rowp + bj * HALF) = (u32x2){(unsigned)p0, (unsigned)p1}; } }
    }
};
struct EpiF32 {
    static constexpr bool PERM = false;
    float* C; int ldc;
    __device__ __forceinline__ void operator()(const f32x4 (&acc)[2][2][4][2], const Unit& u, int wr, int wc, int fr, int fq) const {
        int fr_ = fr; asm volatile("" : "+v"(fr_));
        const int row0 = u.pm * BM + wr * 64 + fr_, col0 = u.pn * BM + wc * 32 + 4 * fq;
#pragma unroll
        for (int ai = 0; ai < 2; ++ai)
#pragma unroll
            for (int m = 0; m < 4; ++m) { float* rowp = C + (size_t)(row0 + ai * HALF + m * 16) * ldc + col0;
#pragma unroll
                for (int bj = 0; bj < 2; ++bj)
#pragma unroll
                    for (int n = 0; n < 2; ++n) *(f32x4*)(rowp + bj * HALF + n * 16) = acc[ai][bj][m][n]; }
    }
};
struct SchedKSplit {
    int G, c; const char* A; const char* B; size_t a_tile, b_tile; int kbytes;
    __device__ __forceinline__ int a_scale(const Unit&) const { return 0x7F7F7F7F; }
    __device__ __forceinline__ bool next(int i, Unit& u) const {
        if (i > 0 || c >= 128) return false;
        const int cu = c >> 3, ks = c & 7; u.pm = ML / BM + (cu >> 3); u.pn = (cu & 7) + 8 * ks;
        u.a = A + (size_t)u.pm * a_tile + (size_t)ks * kbytes; u.b = B + (size_t)(cu & 7) * b_tile + (size_t)ks * kbytes; return true;
    }
};
struct EpiPart {
    static constexpr bool PERM = false;
    float* P;
    __device__ __forceinline__ void operator()(const f32x4 (&acc)[2][2][4][2], const Unit& u, int wr, int wc, int fr, int fq) const {
        int fr_ = fr; asm volatile("" : "+v"(fr_));
        const int row0 = (u.pm - ML / BM) * BM + wr * 64 + fr_, col0 = (u.pn & 7) * BM + wc * 32 + 4 * fq;
        float* base = P + (size_t)(u.pn >> 3) * MC * DM;
#pragma unroll
        for (int ai = 0; ai < 2; ++ai)
#pragma unroll
            for (int m = 0; m < 4; ++m) { float* rowp = base + (size_t)(row0 + ai * HALF + m * 16) * DM + col0;
#pragma unroll
                for (int bj = 0; bj < 2; ++bj)
#pragma unroll
                    for (int n = 0; n < 2; ++n) *(f32x4*)(rowp + bj * HALF + n * 16) = acc[ai][bj][m][n]; }
    }
};
struct EpiResGate {
    static constexpr bool PERM = false;
    float* XR; const float* resL; const float* resC; const float* modL; const float* modC;
    __device__ __forceinline__ void operator()(const f32x4 (&acc)[2][2][4][2], const Unit& u, int wr, int wc, int fr, int fq) const {
        const bool lat = u.pm < ML / BM;
        const float* res = lat ? resL + (size_t)u.pm * BM * DM : resC + (size_t)(u.pm - ML / BM) * BM * DM;
        const float* gate = lat ? modL + (size_t)(u.pm >> 5) * (6 * DM) : modC;
        int fr_ = fr; asm volatile("" : "+v"(fr_));
        const int row0 = wr * 64 + fr_, col0 = u.pn * BM + wc * 32 + 4 * fq;
        float* outp = XR + (size_t)u.pm * BM * DM;
        f32x4 gv[2][2];
#pragma unroll
        for (int bj = 0; bj < 2; ++bj)
#pragma unroll
            for (int n = 0; n < 2; ++n) gv[bj][n] = *(const f32x4*)(gate + col0 + bj * HALF + n * 16);
        f32x4 rc[2][2], rn[2][2] = {};
#define ER_LOAD(it_, r_) do { const size_t off_ = (size_t)(row0 + ((it_) >> 2) * HALF + ((it_) & 3) * 16) * DM + col0; \
        _Pragma("unroll") for (int bj = 0; bj < 2; ++bj) _Pragma("unroll") for (int n = 0; n < 2; ++n) r_[bj][n] = *(const f32x4*)(res + off_ + bj * HALF + n * 16); } while (0)
        ER_LOAD(0, rc);
#pragma unroll
        for (int it = 0; it < 8; ++it) { const int ai = it >> 2, m = it & 3; const size_t off = (size_t)(row0 + ai * HALF + m * 16) * DM + col0;
            if (it + 1 < 8) ER_LOAD(it + 1, rn);
#pragma unroll
            for (int bj = 0; bj < 2; ++bj)
#pragma unroll
                for (int n = 0; n < 2; ++n) { *(f32x4*)(outp + off + bj * HALF + n * 16) = rc[bj][n] + gv[bj][n] * acc[ai][bj][m][n]; rc[bj][n] = rn[bj][n]; }
            asm volatile("" ::: "memory"); }
#undef ER_LOAD
    }
};
struct EpiGate {
    static constexpr bool PERM = true;
    const unsigned char* T; size_t t_stride; u32x4* ys; unsigned char* Y;
    __device__ __forceinline__ void operator()(const f32x4 (&acc)[2][2][4][2], const Unit& u, int wr, int wc, int fr, int fq) const {
        const int n_br = u.pn >> 3; int tid = (wr * 4 + wc) * 64 + fq * 16 + fr; asm volatile("" : "+v"(tid));
        const int row0 = u.pm * BM + wr * 64 + fr, col0 = (u.pn & 7) * BM + wc * 32 + 8 * fq;
        const unsigned char* Tn = T + (size_t)n_br * t_stride;
        u32x2 twc[2], twn[2]; u32x4 pvc[2] = {}, pvn[2] = {};
#define EG_LOAD(it_, tw_, pv_) do { const int ai_ = (it_) >> 2, m_ = (it_) & 3; const size_t off_ = (size_t)(row0 + ai_ * HALF + m_ * 16) * DM + col0; \
        _Pragma("unroll") for (int bj = 0; bj < 2; ++bj) { tw_[bj] = *(const u32x2*)(Tn + off_ + bj * HALF); if (n_br != 0) pv_[bj] = ys[(size_t)(((ai_ * 2 + bj) * 4 + m_) * NTHREADS + tid)]; } } while (0)
        EG_LOAD(0, twc, pvc);
#pragma unroll
        for (int it = 0; it < 8; ++it) { const int ai = it >> 2, m = it & 3; const size_t off = (size_t)(row0 + ai * HALF + m * 16) * DM + col0;
            if (it + 1 < 8) EG_LOAD(it + 1, twn, pvn);
#pragma unroll
            for (int bj = 0; bj < 2; ++bj) {
                const u32x2 tw = twc[bj];
                const f32x2 t0 = __builtin_amdgcn_cvt_pk_f32_fp8((int)tw[0], false), t1 = __builtin_amdgcn_cvt_pk_f32_fp8((int)tw[0], true), t2 = __builtin_amdgcn_cvt_pk_f32_fp8((int)tw[1], false), t3 = __builtin_amdgcn_cvt_pk_f32_fp8((int)tw[1], true);
                const f32x4 a0 = acc[ai][bj][m][0], a1 = acc[ai][bj][m][1];
                float v[8];
                v[0] = sigmoidf_(a0[0]) * t0[0]; v[1] = sigmoidf_(a0[1]) * t0[1]; v[2] = sigmoidf_(a0[2]) * t1[0]; v[3] = sigmoidf_(a0[3]) * t1[1];
                v[4] = sigmoidf_(a1[0]) * t2[0]; v[5] = sigmoidf_(a1[1]) * t2[1]; v[6] = sigmoidf_(a1[2]) * t3[0]; v[7] = sigmoidf_(a1[3]) * t3[1];
                u32x4* sp = ys + (size_t)(((ai * 2 + bj) * 4 + m) * NTHREADS + tid);
                if (n_br != 0) { const u32x4 pv = pvc[bj]; v[0] += bflo(pv.x); v[1] += bfhi(pv.x); v[2] += bflo(pv.y); v[3] += bfhi(pv.y); v[4] += bflo(pv.z); v[5] += bfhi(pv.z); v[6] += bflo(pv.w); v[7] += bfhi(pv.w); }
                if (n_br != 3) { u32x4 w; w.x = cvt_pk_bf16(v[0], v[1]); w.y = cvt_pk_bf16(v[2], v[3]); w.z = cvt_pk_bf16(v[4], v[5]); w.w = cvt_pk_bf16(v[6], v[7]); *sp = w; }
                else { int p0 = 0, p1 = 0; p0 = __builtin_amdgcn_cvt_pk_fp8_f32(v[0], v[1], p0, false); p0 = __builtin_amdgcn_cvt_pk_fp8_f32(v[2], v[3], p0, true);
                    p1 = __builtin_amdgcn_cvt_pk_fp8_f32(v[4], v[5], p1, false); p1 = __builtin_amdgcn_cvt_pk_fp8_f32(v[6], v[7], p1, true);
                    *(u32x2*)(Y + off + bj * HALF) = (u32x2){(unsigned)p0, (unsigned)p1}; }
            }
            twc[0] = twn[0]; twc[1] = twn[1]; pvc[0] = pvn[0]; pvc[1] = pvn[1];
            asm volatile("" ::: "memory"); }
#undef EG_LOAD
    }
};
struct SchedGateCtx {
    int G, c; const char* A; const char* B; size_t a_tile, b_tile;
    __device__ __forceinline__ int a_scale(const Unit&) const { return 0x7F7F7F7F; }
    __device__ __forceinline__ bool next(int i, Unit& u) const {
        if (i > 0 || c >= 64) return false;
        const int tile = c >> 2, n = c & 3; u.pm = ML / BM + (tile >> 3); u.pn = n * 8 + (tile & 7);
        u.a = A + (size_t)u.pm * a_tile; u.b = B + (size_t)u.pn * b_tile; return true;
    }
};
struct EpiGateCtx {
    static constexpr bool PERM = true;
    const unsigned char* T; size_t t_stride; bf16_t* YC;
    __device__ __forceinline__ void operator()(const f32x4 (&acc)[2][2][4][2], const Unit& u, int wr, int wc, int fr, int fq) const {
        const int n_br = u.pn >> 3;
        const int row0 = u.pm * BM + wr * 64 + fr, col0 = (u.pn & 7) * BM + wc * 32 + 8 * fq;
        const unsigned char* Tn = T + (size_t)n_br * t_stride; bf16_t* Yn = YC + (size_t)n_br * MC * DM;
#pragma unroll
        for (int ai = 0; ai < 2; ++ai)
#pragma unroll
            for (int m = 0; m < 4; ++m) { const int row = row0 + ai * HALF + m * 16; const size_t off = (size_t)row * DM + col0, offc = (size_t)(row - ML) * DM + col0;
#pragma unroll
                for (int bj = 0; bj < 2; ++bj) {
                    const u32x2 tw = *(const u32x2*)(Tn + off + bj * HALF);
                    const f32x2 t0 = __builtin_amdgcn_cvt_pk_f32_fp8((int)tw[0], false), t1 = __builtin_amdgcn_cvt_pk_f32_fp8((int)tw[0], true), t2 = __builtin_amdgcn_cvt_pk_f32_fp8((int)tw[1], false), t3 = __builtin_amdgcn_cvt_pk_f32_fp8((int)tw[1], true);
                    const f32x4 a0 = acc[ai][bj][m][0], a1 = acc[ai][bj][m][1];
                    u32x4 w;
                    w.x = cvt_pk_bf16(sigmoidf_(a0[0]) * t0[0], sigmoidf_(a0[1]) * t0[1]); w.y = cvt_pk_bf16(sigmoidf_(a0[2]) * t1[0], sigmoidf_(a0[3]) * t1[1]);
                    w.z = cvt_pk_bf16(sigmoidf_(a1[0]) * t2[0], sigmoidf_(a1[1]) * t2[1]); w.w = cvt_pk_bf16(sigmoidf_(a1[2]) * t3[0], sigmoidf_(a1[3]) * t3[1]);
                    *(u32x4*)(Yn + offc + bj * HALF) = w; }
                asm volatile("" ::: "memory"); }
    }
};

template <class Epi, class Sch, int ELT = 2>
__device__ __forceinline__ void gemm_phase(LAS unsigned char* lds, const Gemm g, const Sch& S, const Epi& E) {
    int tid_ = tid_of_wave(g.wv); asm volatile("" : "+v"(tid_));
    const int tid = tid_, wid = __builtin_amdgcn_readfirstlane(tid >> 6), lane = tid & 63, wr = wid >> 2, wc = wid & 3, fr = lane & 15, fq = lane >> 4;
    const int K = g.K, nt = K * ELT / (BK * 2);
    unsigned voffA[2], voffB[2];
#pragma unroll
    for (int i = 0; i < 2; ++i) { int R, C; stage_rc(tid * 16 + i * 8192, R, C); const int Rb = Epi::PERM ? ((R & ~31) + perm32(R & 31)) : R;
        voffA[i] = (unsigned)(R * g.lda * ELT + C * 2); voffB[i] = (unsigned)(Rb * g.ldb * ELT + C * 2); }
    const size_t kstep = (size_t)(BK * 2);
    const size_t hstepA = (size_t)HALF * g.lda * ELT, hstepB = (size_t)HALF * g.ldb * ELT;
    const unsigned ldsw = (unsigned)wid * 1024u;
    const int aoff = lds_byte(wr * 64 + fr, ELT == 2 ? fq * 8 : fq * 16), boff = lds_byte(wc * 32 + fr, ELT == 2 ? fq * 8 : fq * 16);
#define PG8_SA(b, h) (((b) * 2 + (h)) * HTB)
#define PG8_SB(b, h) ((4 + (b) * 2 + (h)) * HTB)
#define PG8_STAGE(bufoff, gbase, voff) do { _Pragma("unroll") for (int _i = 0; _i < 2; ++_i) \
        __builtin_amdgcn_global_load_lds((const unsigned*)((const char*)(gbase) + (voff)[_i]), (LAS unsigned*)(lds + (bufoff) + ldsw + _i * 8192), 16, 0, 0); } while (0)
#define PG8_LD1(dstf, addr) do { if constexpr (ELT == 2) { (dstf).k[0] = *(const LAS bf16x8*)(lds + (addr)); (dstf).k[1] = *(const LAS bf16x8*)(lds + (addr) + 1024); } \
        else { const u32x4 lo_ = *(const LAS u32x4*)(lds + (addr)), hi_ = *(const LAS u32x4*)(lds + (addr) + 16); \
               (dstf).v = (v8i_t){(int)lo_[0], (int)lo_[1], (int)lo_[2], (int)lo_[3], (int)hi_[0], (int)hi_[1], (int)hi_[2], (int)hi_[3]}; } } while (0)
#define PG8_LDA(dst, b, h) do { _Pragma("unroll") for (int m = 0; m < 4; ++m) PG8_LD1(dst[m], PG8_SA(b, h) + aoff + m * 2048); } while (0)
#define PG8_LDB(dst, b, h) do { _Pragma("unroll") for (int n = 0; n < 2; ++n) PG8_LD1(dst[n], PG8_SB(b, h) + boff + n * 2048); } while (0)
#define PG8_MMA(ai, bj, At, Bt) do { __builtin_amdgcn_s_setprio(1); _Pragma("unroll") for (int m = 0; m < 4; ++m) _Pragma("unroll") for (int n = 0; n < 2; ++n) { \
        if constexpr (ELT == 2) { _Pragma("unroll") for (int k = 0; k < 2; ++k) acc[ai][bj][m][n] = __builtin_amdgcn_mfma_f32_16x16x32_bf16(Bt[n].k[k], At[m].k[k], acc[ai][bj][m][n], 0, 0, 0); } \
        else asm volatile("v_mfma_scale_f32_16x16x128_f8f6f4 %0, %1, %2, %0, %3, %4 op_sel_hi:[0,0,0]" : "+v"(acc[ai][bj][m][n]) : "v"(Bt[n].v), "v"(At[m].v), "v"(scB_), "v"(scA_)); } \
        __builtin_amdgcn_s_setprio(0); } while (0)
#define PG8_WAIT_V(n) asm volatile("s_waitcnt vmcnt(" #n ")" ::: "memory")
#define PG8_WAIT_L(n) asm volatile("s_waitcnt lgkmcnt(" #n ")" ::: "memory")
#define PG8_BAR __builtin_amdgcn_s_barrier()
#define PG8_SCHED __builtin_amdgcn_sched_barrier(0)
    Unit cur, nxt; int ui = 0;
    if (!S.next(0, cur)) return;
    f32x4 acc[2][2][4][2];
#pragma unroll
    for (int a = 0; a < 2; ++a)
#pragma unroll
        for (int b = 0; b < 2; ++b)
#pragma unroll
            for (int m = 0; m < 4; ++m)
#pragma unroll
                for (int n = 0; n < 2; ++n) acc[a][b][m][n] = (f32x4){0.f, 0.f, 0.f, 0.f};
    FragT<ELT> At[4], B0[2], B1[2];
    int scB_ = 0x79797979, scA_ = 0x7F7F7F7F;
    asm volatile("" : "+v"(scB_), "+v"(scA_));
    const char* cA = cur.a; const char* cB = cur.b;
    PG8_STAGE(PG8_SB(0, 0), cB, voffB); PG8_STAGE(PG8_SA(0, 0), cA, voffA); PG8_STAGE(PG8_SB(0, 1), cB + hstepB, voffB); PG8_STAGE(PG8_SA(0, 1), cA + hstepA, voffA);
    if (wr == 1) PG8_BAR;
    PG8_WAIT_V(4); PG8_BAR;
    PG8_STAGE(PG8_SB(1, 0), cB + kstep, voffB); PG8_STAGE(PG8_SA(1, 0), cA + kstep, voffA); PG8_STAGE(PG8_SB(1, 1), cB + hstepB + kstep, voffB);
    PG8_WAIT_V(6); PG8_BAR;
    for (;;) {
        const bool has_next = S.next(ui + 1, nxt);
        const char* nA = has_next ? nxt.a : cA; const char* nB = has_next ? nxt.b : cB;
        if constexpr (ELT == 1) { scA_ = S.a_scale(cur); asm volatile("" : "+v"(scA_)); }
        for (int t = 0; t < nt; t += 2) {
            const bool last = (t == nt - 2);
            const char* a1 = cA + (size_t)(t + 1) * kstep;
            const char* a2 = last ? nA : cA + (size_t)(t + 2) * kstep; const char* b2 = last ? nB : cB + (size_t)(t + 2) * kstep;
            const char* a3 = a2 + kstep; const char* b3 = b2 + kstep;
            PG8_LDB(B0, 0, 0); PG8_SCHED; PG8_LDA(At, 0, 0); PG8_STAGE(PG8_SA(1, 1), a1 + hstepA, voffA);
            PG8_WAIT_L(8); PG8_BAR; PG8_WAIT_L(0); PG8_MMA(0, 0, At, B0); PG8_BAR; PG8_SCHED;
            PG8_LDB(B1, 0, 1); PG8_STAGE(PG8_SB(0, 0), b2, voffB);
            PG8_BAR; PG8_WAIT_L(0); PG8_MMA(0, 1, At, B1); PG8_BAR;
            PG8_LDA(At, 0, 1); PG8_STAGE(PG8_SA(0, 0), a2, voffA);
            PG8_BAR; PG8_WAIT_L(0); PG8_MMA(1, 0, At, B0); PG8_BAR; PG8_SCHED;
            PG8_STAGE(PG8_SB(0, 1), b2 + hstepB, voffB);
            PG8_WAIT_V(6); PG8_BAR; PG8_MMA(1, 1, At, B1); PG8_BAR;
            PG8_LDB(B0, 1, 0); PG8_SCHED; PG8_LDA(At, 1, 0); PG8_STAGE(PG8_SA(0, 1), a2 + hstepA, voffA);
            PG8_WAIT_L(8); PG8_BAR; PG8_WAIT_L(0); PG8_MMA(0, 0, At, B0); PG8_BAR; PG8_SCHED;
            PG8_LDB(B1, 1, 1); PG8_STAGE(PG8_SB(1, 0), b3, voffB);
            PG8_BAR; PG8_WAIT_L(0); PG8_MMA(0, 1, At, B1); PG8_BAR;
            PG8_LDA(At, 1, 1); PG8_STAGE(PG8_SA(1, 0), a3, voffA);
            PG8_BAR; PG8_WAIT_L(0); PG8_MMA(1, 0, At, B0); PG8_BAR; PG8_SCHED;
            PG8_STAGE(PG8_SB(1, 1), b3 + hstepB, voffB);
            PG8_WAIT_V(6); PG8_BAR; PG8_MMA(1, 1, At, B1); PG8_BAR;
        }
        if constexpr (ELT == 1) { PG8_SCHED; asm volatile("s_nop 15\n\ts_nop 15" ::: "memory"); PG8_SCHED; }
        E(acc, cur, wr, wc, fr, fq);
        if (!has_next) break;
#pragma unroll
        for (int a = 0; a < 2; ++a)
#pragma unroll
            for (int b = 0; b < 2; ++b)
#pragma unroll
                for (int m = 0; m < 4; ++m)
#pragma unroll
                    for (int n = 0; n < 2; ++n) acc[a][b][m][n] = (f32x4){0.f, 0.f, 0.f, 0.f};
        cur = nxt; cA = nA; cB = nB; ++ui;
    }
    PG8_WAIT_V(0);
    if (wr == 0) PG8_BAR;
    PG8_BAR;
#undef PG8_SA
#undef PG8_SB
#undef PG8_STAGE
#undef PG8_LD1
#undef PG8_LDA
#undef PG8_LDB
#undef PG8_MMA
#undef PG8_WAIT_V
#undef PG8_WAIT_L
#undef PG8_BAR
#undef PG8_SCHED
}
}

struct Ctx {
    typedef __attribute__((address_space(4))) const unsigned long long* karg_t;
    karg_t tab;
    float* out; unsigned char* ws; LAS unsigned char* lds; int tid, wid, lane, G, bid; int wv;
    __device__ __forceinline__ void fresh() { int t = tid_of_wave(wv); asm volatile("" : "+v"(t)); tid = t; lane = t & 63; wid = __builtin_amdgcn_readfirstlane(t >> 6);
        karg_t tb = (karg_t)__builtin_amdgcn_kernarg_segment_ptr(); asm volatile("" : "+s"(tb)); tab = tb; out = (float*)(__attribute__((address_space(1))) float*)tb[30]; ws = (unsigned char*)(__attribute__((address_space(1))) unsigned char*)tb[31];
        int b_ = blockIdx.x, g_ = gridDim.x; asm volatile("" : "+s"(b_), "+s"(g_)); bid = b_; G = g_; }
    __device__ __forceinline__ const float* inp(int i) const { return (const float*)(__attribute__((address_space(1))) const float*)tab[i]; }
    __device__ __forceinline__ bf16_t* bf(size_t off) const { return (bf16_t*)(ws + off); }
    __device__ __forceinline__ float* f32(size_t off) const { return (float*)(ws + off); }
    __device__ __forceinline__ const float* mod(int l, int v, int k) const { return (const float*)(ws + WS_MOD) + ((size_t)(l * 3 + v) * 6 + k) * DM; }
};

struct TDesc { const float* src; bf16_t* dst; int N, ldd, k0, n0, fp8; };
__device__ __forceinline__ void transpose_load(const Ctx& F, const TDesc& d, f32x4 (&v)[2]) {
    const int tid = F.tid, r = tid >> 4, c4 = (tid & 15) * 4;
#pragma unroll
    for (int i = 0; i < 2; ++i) v[i] = *(const f32x4*)(d.src + (size_t)(d.k0 + r + 32 * i) * d.N + d.n0 + c4);
}
__device__ __forceinline__ void transpose_finish(const Ctx& F, const TDesc& d, const f32x4 (&vv)[2]) {
    LAS float* tile = (LAS float*)F.lds;
    const int tid = F.tid, r = tid >> 4, c4 = (tid & 15) * 4;
    const int N = d.N, ldd = d.ldd, k0 = d.k0, n0 = d.n0; bf16_t* dst = d.dst; (void)N;
#pragma unroll
    for (int i = 0; i < 2; ++i) { const int rr = r + 32 * i; const f32x4 v = vv[i];
        tile[rr * 65 + c4 + 0] = v[0]; tile[rr * 65 + c4 + 1] = v[1]; tile[rr * 65 + c4 + 2] = v[2]; tile[rr * 65 + c4 + 3] = v[3]; }
    __syncthreads();
    if (d.fp8) { if (tid < 256) { const int n = tid >> 2, k16 = (tid & 3) * 16; u32x4 w;
#pragma unroll
            for (int q = 0; q < 4; ++q) { int pk = 0; pk = __builtin_amdgcn_cvt_pk_fp8_f32(tile[(k16 + 4 * q) * 65 + n] * 64.f, tile[(k16 + 4 * q + 1) * 65 + n] * 64.f, pk, false);
                pk = __builtin_amdgcn_cvt_pk_fp8_f32(tile[(k16 + 4 * q + 2) * 65 + n] * 64.f, tile[(k16 + 4 * q + 3) * 65 + n] * 64.f, pk, true); w[q] = (unsigned)pk; }
            *(u32x4*)((unsigned char*)dst + (size_t)(n0 + n) * ldd + k0 + k16) = w; }
        __syncthreads(); return; }
    const int n = tid >> 3, k8 = (tid & 7) * 8;
    float v[8];
#pragma unroll
    for (int j = 0; j < 8; ++j) v[j] = tile[(k8 + j) * 65 + n];
    u32x4 w; w.x = cvt_pk_bf16(v[0], v[1]); w.y = cvt_pk_bf16(v[2], v[3]); w.z = cvt_pk_bf16(v[4], v[5]); w.w = cvt_pk_bf16(v[6], v[7]);
    *(u32x4*)(dst + (size_t)(n0 + n) * ldd + k0 + k8) = w;
    __syncthreads();
}

__device__ __forceinline__ void p0_prologue(const Ctx& F) {
    const int tid = F.tid;
    constexpr int T_WIN = 32 * 59, T_G = 1024, T_B = 256, T_UQ = 72, T_UKV = 64;
    constexpr int O_G = T_WIN, O_B = O_G + 4 * T_G, O_O = O_B + 4 * T_B, O_PQ = O_O + T_G, O_UQ = O_PQ, O_UKV = O_UQ + T_UQ, T_LAYER = O_UKV + T_UKV;
    auto desc = [&](int t) -> TDesc {
        const int l = t / T_LAYER; int j = t % T_LAYER;
        const float* src; bf16_t* dst; int K, N, ldd, fp8 = 0;
        if (j < O_G)        { src = F.inp(I_WIN) + (size_t)l * DM * DIN; dst = (bf16_t*)(F.ws + WS_WIN + (size_t)l * ZLD * DM); K = DM; N = DIN; ldd = DM; fp8 = 1; }
        else if (j < O_B)   { j -= O_G; const int nb = j / T_G; j %= T_G; src = F.inp(I_WGATE) + ((size_t)l * 4 + ((0x1320 >> (4 * nb)) & 3)) * DM * DM; dst = (bf16_t*)(F.ws + WS_WG + ((size_t)l * 4 + nb) * DM * DM); K = DM; N = DM; ldd = DM; fp8 = 1; }
        else if (j < O_O)   { j -= O_B; const int nb = j / T_B; j %= T_B; src = F.inp(I_WBR) + ((size_t)l * 4 + ((0x1320 >> (4 * nb)) & 3)) * 512 * DM; dst = (bf16_t*)(F.ws + WS_WB + ((size_t)l * 4 + nb) * DM * 512); K = 512; N = DM; ldd = 512; fp8 = 1; }
        else if (j < O_PQ)  { j -= O_O; src = F.inp(I_WOUT) + (size_t)l * DM * DM; dst = (bf16_t*)(F.ws + WS_WO + (size_t)l * DM * DM); K = DM; N = DM; ldd = DM; fp8 = 1; }
        else if (j < O_UKV) { j -= O_UQ; src = F.inp(I_WUQ) + (size_t)l * 384 * 768; dst = (bf16_t*)(F.ws + WS_WUQ + (size_t)l * 768 * 512); K = 384; N = 768; ldd = 512; fp8 = 1; }
        else                { j -= O_UKV; src = F.inp(I_WUKV) + (size_t)l * 256 * 1024; dst = (bf16_t*)(F.ws + WS_WUKV + (size_t)l * 1024 * 256); K = 256; N = 1024; ldd = 256; fp8 = 1; }
        (void)K; const int nnt = N / 64; const int tn = j % nnt, tk = j / nnt;
        return TDesc{src, dst, N, ldd, tk * 64, tn * 64, fp8}; };
    { f32x4 vc[2], vn[2] = {}; TDesc dc = desc(F.bid < DEPTH * T_LAYER ? F.bid : 0), dn = dc;
      if (F.bid < DEPTH * T_LAYER) transpose_load(F, dc, vc);
      for (int t = F.bid; t < DEPTH * T_LAYER; t += F.G) {
          if (t + F.G < DEPTH * T_LAYER) { dn = desc(t + F.G); transpose_load(F, dn, vn); }
          transpose_finish(F, dc, vc);
          dc = dn; vc[0] = vn[0]; vc[1] = vn[1]; } }
    const size_t gtid = (size_t)F.bid * NTHREADS + tid, gsz = (size_t)F.G * NTHREADS;
    for (size_t i = gtid; i < (size_t)DEPTH * DM * DM / 8; i += gsz) { const float* sp = F.inp(I_WPQ) + i * 8; const f32x4 a = *(const f32x4*)sp, b = *(const f32x4*)(sp + 4);
        u32x4 w; w.x = cvt_pk_bf16(a[0], a[1]); w.y = cvt_pk_bf16(a[2], a[3]); w.z = cvt_pk_bf16(b[0], b[1]); w.w = cvt_pk_bf16(b[2], b[3]); *(u32x4*)(F.bf(WS_WPQ) + i * 8) = w; }
    for (size_t i = gtid; i < (size_t)DEPTH * 64 * DM / 16; i += gsz) { const size_t l = i / (64 * DM / 16), r = i % (64 * DM / 16);
        *(u32x4*)(F.ws + WS_WIN + (l * ZLD + DIN) * DM + r * 16) = (u32x4){0u, 0u, 0u, 0u}; }
    for (size_t i = gtid; i < (size_t)DEPTH * 768 * 8; i += gsz) *(u32x4*)(F.ws + WS_WUQ + (i >> 3) * 512 + 384 + (i & 7) * 16) = (u32x4){0u, 0u, 0u, 0u};
    if constexpr (PEER_UBITS == 4 && PEER_VBITS == 4) {
        const int nrow = 2 * DEPTH * NEXP, gw = (int)(gtid >> 6), nw = (int)(gsz >> 6), lane = F.lane;
        f32x4 cur[8], nxt[8] = {}, nx2[8] = {};
        auto ld = [&](int r, f32x4 (&d)[8]) { const float* sp = (r < DEPTH * NEXP ? F.inp(I_PU) + (size_t)r * DM : F.inp(I_PV) + (size_t)(r - DEPTH * NEXP) * DM) + lane * 4;
            _Pragma("unroll") for (int q = 0; q < 8; ++q) d[q] = *(const f32x4*)(sp + q * 256); };
        if (gw < nrow) ld(gw, cur);
        if (gw + nw < nrow) ld(gw + nw, nxt);
        for (int r = gw; r < nrow; r += nw) {
            if (r + 2 * nw < nrow) ld(r + 2 * nw, nx2);
            const bool isU = r < DEPTH * NEXP; const float sc = isU ? 90.50966799187809f : 2.0f;
            unsigned char* dst = F.ws + (isU ? WS_PU + (size_t)r * 1024 : WS_PV + (size_t)(r - DEPTH * NEXP) * 1024) + lane * 2;
#pragma unroll
            for (int q = 0; q < 8; ++q) { unsigned w = 0u;
#pragma unroll
                for (int e = 0; e < 4; ++e) { const float y = cur[q][e] * sc; const float ay = fabsf(y);
                    unsigned code = ay < 0.25f ? 0u : ay < 0.75f ? 1u : ay < 1.25f ? 2u : ay < 1.75f ? 3u : ay < 2.5f ? 4u : ay < 3.5f ? 5u : ay < 5.0f ? 6u : 7u;
                    code |= y < 0.f ? 8u : 0u; w |= code << (4 * e); }
                *(unsigned short*)(dst + q * 128) = (unsigned short)w; cur[q] = nxt[q]; nxt[q] = nx2[q]; }
        }
    } else
    { const size_t nch = (size_t)DEPTH * NEXP * 64;
      for (size_t i = gtid; i < 2 * nch; i += gsz) { const bool isU = i < nch; const size_t j = isU ? i : i - nch; const float sc = isU ? 90.50966799187809f : 2.0f;
          const int bits = isU ? PEER_UBITS : PEER_VBITS;
          const float* s = (isU ? F.inp(I_PU) : F.inp(I_PV)) + j * 32; unsigned w[6] = {0u, 0u, 0u, 0u, 0u, 0u};
#pragma unroll
          for (int q = 0; q < 8; ++q) { const f32x4 a = *(const f32x4*)(s + 4 * q);
#pragma unroll
              for (int e = 0; e < 4; ++e) { const float y = a[e] * sc; const int el = q * 4 + e;
                  if (bits == 6) { const float ay = fminf(fabsf(y), 7.5f); unsigned code;
                      if (ay < 1.0f) code = (unsigned)__float2int_rn(ay * 8.0f); else if (ay < 2.0f) code = 8u + (unsigned)__float2int_rn((ay - 1.0f) * 8.0f);
                      else if (ay < 4.0f) code = 16u + (unsigned)__float2int_rn((ay * 0.5f - 1.0f) * 8.0f); else code = 24u + (unsigned)__float2int_rn((ay * 0.25f - 1.0f) * 8.0f);
                      code |= y < 0.f ? 32u : 0u;
                      const int bit = 6 * el, d = bit >> 5, o = bit & 31; w[d] |= code << o; if (o > 26) w[d + 1] |= code >> (32 - o); }
                  else { const float ay = fabsf(y);
                      unsigned code = ay < 0.25f ? 0u : ay < 0.75f ? 1u : ay < 1.25f ? 2u : ay < 1.75f ? 3u : ay < 2.5f ? 4u : ay < 3.5f ? 5u : ay < 5.0f ? 6u : 7u;
                      code |= y < 0.f ? 8u : 0u; w[el >> 3] |= code << (4 * (el & 7)); } } }
          const int rowb = isU ? PEER_UROWB : PEER_VROWB;
          unsigned char* dst = F.ws + (isU ? WS_PU : WS_PV) + (j >> 6) * rowb; const int ln = (int)(j & 63);
          *(u32x4*)(dst + ln * 16) = (u32x4){w[0], w[1], w[2], w[3]}; if (bits == 6) *(u32x2*)(dst + 1024 + ln * 8) = (u32x2){w[4], w[5]}; } }
    for (size_t i = gtid; i < (size_t)DEPTH * 256 * 256; i += gsz) { const int l = (int)(i >> 16), r = (int)(i >> 8) & 255, c = (int)i & 255;
        const float v = ((r >> 7) == (c >> 7)) ? F.inp(I_PKEYS)[(((size_t)l * 2 + (r >> 7)) * 128 + (r & 127)) * 128 + (c & 127)] : 0.f;
        F.bf(WS_KB)[i] = f2bf(v); }
    for (size_t i = gtid; i < (size_t)512 * 1024; i += gsz) { const int n = (int)(i >> 10), kc = (int)i & 1023; const int g = n >> 7, m = n & 127, part = kc >> 9, g2 = (kc >> 7) & 3, c = kc & 127;
        float v = 0.f; if (g == g2) { const float x = (float)((c * m) & 127) * (1.0f / 64.0f); v = part == 0 ? cospif(x) : sinpif(x); }
        (F.ws + WS_WDFT)[i] = f2fp8(v * 64.f); }
    for (size_t i = gtid; i < (size_t)SEQ * 32; i += gsz) { const int pos = (int)(i >> 5), idx = (int)i & 31; const int row = pos >> 6, col = pos & 63;
        const float inv = powf(10000.0f, -(float)(idx & 15) / 16.0f); const float ang = (float)(idx < 16 ? row : col) * inv;
        float s, c; sincosf(ang, &s, &c); F.f32(WS_ROPE)[i * 2] = c; F.f32(WS_ROPE)[i * 2 + 1] = s; }
    { LAS float* sil = (LAS float*)F.lds;
      LAS float* red = sil + 3 * DM;
      const int wid = F.wid, lane = F.lane;
      __syncthreads();
      for (int i = tid; i < 3 * DM; i += NTHREADS) { const int v = i / DM, k = i % DM; const float x = v < 2 ? F.inp(I_C)[v * DM + k] : F.inp(I_CCTX)[k]; sil[i] = x / (1.0f + __expf(-x)); }
      __syncthreads();
      for (int item = F.bid; item < DEPTH * 128; item += F.G) {
          const int l = item / 128, col0 = (item % 128) * 96; const int c4 = ((lane & 31) < 24 ? (lane & 31) : 0) * 4, rsel = lane >> 5;
          const float* w = F.inp(I_WADA) + ((size_t)l * DM + (size_t)wid * 256 + rsel) * (6 * DM) + col0 + c4;
          f32x4 a0 = {0.f, 0.f, 0.f, 0.f}, a1 = a0, a2 = a0;
#pragma unroll 8
          for (int i = 0; i < 128; ++i) { const f32x4 wv = *(const f32x4*)(w + (size_t)(2 * i) * (6 * DM)); const int kk = wid * 256 + 2 * i + rsel;
              a0 += wv * sil[kk]; a1 += wv * sil[DM + kk]; a2 += wv * sil[2 * DM + kk]; }
          LAS float* rp = red + ((wid * 2 + rsel) * 32 + (lane & 31)) * 12;
#pragma unroll
          for (int e = 0; e < 4; ++e) { rp[e] = a0[e]; rp[4 + e] = a1[e]; rp[8 + e] = a2[e]; }
          __syncthreads();
          if (tid < 288) { const int q = tid / 12, j = tid % 12; const int v = j >> 2, e = j & 3; float sacc = 0.f;
#pragma unroll
              for (int p = 0; p < 16; ++p) sacc += red[(p * 32 + q) * 12 + j];
              const int col = col0 + q * 4 + e;
              F.f32(WS_MOD)[(size_t)(l * 3 + v) * 6 * DM + col] = sacc + F.inp(I_BADA)[(size_t)l * 6 * DM + col]; }
          __syncthreads();
      } }
}

__device__ __forceinline__ void norm_rows(const Ctx& F, const float* __restrict__ xl, const float* __restrict__ xc, const float* __restrict__ g, int l, int kshift, int kscale, int nrows, bool fp8copy,
                                          const float* __restrict__ part = nullptr, const float* __restrict__ pgate = nullptr, float* __restrict__ xw = nullptr, bool bf16out = true) {
    for (int row = F.bid * NWAVES + F.wid; row < nrows; row += F.G * NWAVES) {
        const float* xr = row < ML ? xl + (size_t)row * DM : xc + (size_t)(row - ML) * DM;
        const int v = row < ML ? (row >> 13) : 2;
        const float* sh = F.mod(l, v, kshift); const float* sc = F.mod(l, v, kscale);
        f32x4 x[8]; float ss = 0.f;
#pragma unroll
        for (int i = 0; i < 4; ++i) { x[2 * i] = *(const f32x4*)(xr + i * 512 + F.lane * 8); x[2 * i + 1] = *(const f32x4*)(xr + i * 512 + F.lane * 8 + 4); }
        if (part != nullptr && row >= ML) {
#pragma unroll
            for (int i = 0; i < 4; ++i) { const int c = i * 512 + F.lane * 8; f32x4 s0 = {0.f, 0.f, 0.f, 0.f}, s1 = s0;
#pragma unroll
                for (int k = 0; k < 8; ++k) { const float* pp = part + ((size_t)k * MC + (row - ML)) * DM + c; s0 += *(const f32x4*)pp; s1 += *(const f32x4*)(pp + 4); }
                x[2 * i] += *(const f32x4*)(pgate + c) * s0; x[2 * i + 1] += *(const f32x4*)(pgate + c + 4) * s1;
                *(f32x4*)(xw + (size_t)(row - ML) * DM + c) = x[2 * i]; *(f32x4*)(xw + (size_t)(row - ML) * DM + c + 4) = x[2 * i + 1]; } }
#pragma unroll
        for (int i = 0; i < 4; ++i) {
#pragma unroll
            for (int e = 0; e < 4; ++e) ss += x[2 * i][e] * x[2 * i][e] + x[2 * i + 1][e] * x[2 * i + 1][e]; }
        ss = wave_sum(ss);
        const float rs = rsqrtf(ss * (1.0f / DM) + 1e-6f);
        bf16_t* hr = F.bf(WS_HN) + (size_t)row * DM;
#pragma unroll
        for (int i = 0; i < 4; ++i) { const int c = i * 512 + F.lane * 8; float o[8];
#pragma unroll
            for (int h = 0; h < 2; ++h) { const f32x4 gv = *(const f32x4*)(g + c + 4 * h), sv = *(const f32x4*)(sc + c + 4 * h), tv = *(const f32x4*)(sh + c + 4 * h);
#pragma unroll
                for (int e = 0; e < 4; ++e) o[4 * h + e] = (x[2 * i + h][e] * rs * gv[e]) * (1.0f + sv[e]) + tv[e]; }
            u32x4 w; w.x = cvt_pk_bf16(o[0], o[1]); w.y = cvt_pk_bf16(o[2], o[3]); w.z = cvt_pk_bf16(o[4], o[5]); w.w = cvt_pk_bf16(o[6], o[7]);
            if (bf16out) *(u32x4*)(hr + c) = w;
            if (fp8copy) { int p0 = 0, p1 = 0; p0 = __builtin_amdgcn_cvt_pk_fp8_f32(o[0], o[1], p0, false); p0 = __builtin_amdgcn_cvt_pk_fp8_f32(o[2], o[3], p0, true);
                p1 = __builtin_amdgcn_cvt_pk_fp8_f32(o[4], o[5], p1, false); p1 = __builtin_amdgcn_cvt_pk_fp8_f32(o[6], o[7], p1, true);
                *(u32x2*)(F.ws + WS_HN8 + (size_t)row * DM + c) = (u32x2){(unsigned)p0, (unsigned)p1}; } }
    }
}

__device__ __forceinline__ void z_post_rows(const Ctx& F, int l) {
    const float* gq = F.inp(I_GQ) + l * 384; const float* gkv = F.inp(I_GKV) + l * 256;
    for (int row = F.bid * NWAVES + F.wid; row < MT; row += F.G * NWAVES) {
        bf16_t* z = F.bf(WS_Z) + (size_t)row * ZLD; const int lane = F.lane; const bool lat = row < ML;
        const int pos = row & (SEQ - 1); const int d = lane & 31, hv = lane >> 5;
        float q[6], kv[4], x1[5], x2[5]; float sq = 0.f, sk = 0.f, cs = 1.f, sn = 0.f;
#pragma unroll
        for (int i = 0; i < 6; ++i) q[i] = bf2f(z[ZC_QLAT + i * 64 + lane]);
#pragma unroll
        for (int i = 0; i < 4; ++i) kv[i] = bf2f(z[ZC_KVLAT + i * 64 + lane]);
        if (lat) { cs = F.f32(WS_ROPE)[((size_t)pos * 32 + d) * 2]; sn = F.f32(WS_ROPE)[((size_t)pos * 32 + d) * 2 + 1];
#pragma unroll
            for (int s5 = 0; s5 < 5; ++s5) { const int vi = s5 * 2 + hv; const int vo = vi == 0 ? ZC_KROPE : ZC_DK + (vi - 1) * 64;
                x1[s5] = vi < 9 ? bf2f(z[vo + d]) : 0.f; x2[s5] = vi < 9 ? bf2f(z[vo + d + 32]) : 0.f; } }
#pragma unroll
        for (int i = 0; i < 6; ++i) sq += q[i] * q[i];
#pragma unroll
        for (int i = 0; i < 4; ++i) sk += kv[i] * kv[i];
        sq = wave_sum(sq); sk = wave_sum(sk);
        const float rq = rsqrtf(sq * (1.0f / 384.0f) + 1e-6f), rk = rsqrtf(sk * (1.0f / 256.0f) + 1e-6f);
#pragma unroll
        for (int i = 0; i < 6; ++i) { const float v = q[i] * rq * gq[i * 64 + lane]; z[ZC_QLAT + i * 64 + lane] = f2bf(v); (F.ws + WS_QL8 + (size_t)row * 512)[i * 64 + lane] = f2fp8(v); }
        (F.ws + WS_QL8 + (size_t)row * 512)[384 + lane] = 0; (F.ws + WS_QL8 + (size_t)row * 512)[448 + lane] = 0;
#pragma unroll
        for (int i = 0; i < 4; ++i) { const float v = kv[i] * rk * gkv[i * 64 + lane]; z[ZC_KVLAT + i * 64 + lane] = f2bf(v); (F.ws + WS_KVL8 + (size_t)row * 256)[i * 64 + lane] = f2fp8(v); }
        unsigned char* k8 = F.ws + WS_K8 + (size_t)row * 1024 + 128;
        if (lat) {
#pragma unroll
            for (int s5 = 0; s5 < 5; ++s5) { const int vi = s5 * 2 + hv;
                if (vi < 9) { bf16_t* p = z + (vi == 0 ? ZC_KROPE : ZC_DK + (vi - 1) * 64);
                    const float y1 = x1[s5] * cs - x2[s5] * sn, y2 = x2[s5] * cs + x1[s5] * sn;
                    p[d] = f2bf(y1); p[d + 32] = f2bf(y2);
                    const unsigned char e1 = f2fp8(y1), e2 = f2fp8(y2);
                    if (vi == 0) {
#pragma unroll
                        for (int hh = 0; hh < 4; ++hh) { k8[hh * 256 + d] = e1; k8[hh * 256 + d + 32] = e2; } }
                    else { unsigned char* kd = F.ws + WS_KD8 + (size_t)row * 512 + (vi - 1) * 64; kd[d] = e1; kd[d + 32] = e2; } } } }
        else { const unsigned char e = f2fp8(bf2f(z[ZC_KROPE + lane]));
#pragma unroll
            for (int hh = 0; hh < 4; ++hh) k8[hh * 256 + lane] = e;
            unsigned char* kd = F.ws + WS_KD8 + (size_t)row * 512;
#pragma unroll
            for (int i = 0; i < 8; ++i) kd[i * 64 + lane] = f2fp8(bf2f(z[ZC_DK + i * 64 + lane])); }
    }
}

__device__ __forceinline__ void v8t_build(const Ctx& F) {
    const int lane = F.lane;
    for (int item = F.bid * NWAVES + F.wid; item < (MT / 64) * 8; item += F.G * NWAVES) { const int gt = (item >> 2) % (MT / 64), h = item & 3; const bool dif = item >= (MT / 64) * 4;
        const unsigned* src = (dif ? (const unsigned*)(F.bf(WS_Z) + (size_t)gt * 64 * ZLD + ZC_DV + h * 128) : (const unsigned*)(F.bf(WS_KV) + (size_t)gt * 64 * 1024 + h * 256 + 128)) + lane;
        const size_t pitch = dif ? ZLD / 2 : 512;
        unsigned w0[16], w1[16];
#pragma unroll
        for (int i = 0; i < 16; ++i) { w0[i] = 0u; w1[i] = 0u; }
#pragma unroll
        for (int kk = 0; kk < 64; ++kk) { const unsigned v = src[(size_t)kk * pitch];
            const int pos = 32 * ((kk >> 2) & 1) + 16 * (kk >> 5) + (kk & 3) + 4 * ((kk >> 3) & 3);
            const unsigned pk = (unsigned)__builtin_amdgcn_cvt_pk_fp8_f32(bflo(v), bfhi(v), 0, false);
            w0[pos >> 2] |= (pk & 0xFFu) << (8 * (pos & 3)); w1[pos >> 2] |= ((pk >> 8) & 0xFFu) << (8 * (pos & 3)); }
        unsigned char* dst = F.ws + (dif ? WS_VD8T : WS_V8T) + (((size_t)h * (MT / 64) + gt) * 128 + 2 * lane) * 64;
#pragma unroll
        for (int i = 0; i < 4; ++i) { *(u32x4*)(dst + 16 * i) = (u32x4){w0[4 * i], w0[4 * i + 1], w0[4 * i + 2], w0[4 * i + 3]}; *(u32x4*)(dst + 64 + 16 * i) = (u32x4){w1[4 * i], w1[4 * i + 1], w1[4 * i + 2], w1[4 * i + 3]}; }
    }
}

__device__ __forceinline__ void conv_units(const Ctx& F, int l) {
    LAS float* u = (LAS float*)F.lds;
    LAS float* y = u + 94 * 128;
    int tid_ = tid_of_wave(F.wid); asm volatile("" : "+v"(tid_)); const int tid = tid_;
    constexpr int NT_L = ML / 64, NT_ALL = MT / 64;
    const int ntile = l == 0 ? NT_ALL : NT_L;
    const int un0 = (F.bid + 58) % F.G;
    if (un0 >= ntile * 4) return;
    int grp_w = un0 & 3;
    const int ch = tid & 127, tq = tid >> 7, lane = tid & 63;
    float w[31], bias, g0, g1, b0, b1;
    auto load_w = [&](int grp) { const int cg = grp * 128 + ch;
        _Pragma("unroll") for (int j = 0; j < 31; ++j) w[j] = F.inp(I_WDW)[((size_t)l * 31 + j) * 512 + cg];
        bias = F.inp(I_BDW)[l * 512 + cg];
        g0 = F.inp(I_GCN)[l * 512 + grp * 128 + lane]; g1 = F.inp(I_GCN)[l * 512 + grp * 128 + 64 + lane];
        b0 = F.inp(I_BCN)[l * 512 + grp * 128 + lane]; b1 = F.inp(I_BCN)[l * 512 + grp * 128 + 64 + lane]; };
    load_w(grp_w);
    auto geom = [&](int un, int& rowbase, int& n0, int& L) { const int tile = un >> 2;
        if (tile < NT_L) { const int b = tile >> 7; rowbase = b * SEQ; n0 = (tile & 127) * 64; L = SEQ; } else { const int t2 = tile - NT_L; const int b = t2 >> 2; rowbase = ML + b * CTXL; n0 = (t2 & 3) * 64; L = CTXL; } };
    u32x4 pa[3], pg[3];
    auto fetch = [&](int un) { int rowbase, n0, L; geom(un, rowbase, n0, L); const int grp = un & 3;
        _Pragma("unroll") for (int i = 0; i < 3; ++i) { const int p = tid + i * NTHREADS; const int r = p >> 4, c8 = (p & 15) * 8; const int n = n0 - 15 + r;
            pa[i] = (u32x4){0u, 0u, 0u, 0u}; pg[i] = pa[i];
            if (p < 94 * 16 && n >= 0 && n < L) { const bf16_t* zp = F.bf(WS_Z) + (size_t)(rowbase + n) * ZLD + ZC_C + grp * 128 + c8; pa[i] = *(const u32x4*)zp; pg[i] = *(const u32x4*)(zp + 512); } } };
    fetch(un0);
    for (int un = un0; un < ntile * 4; un += F.G) {
        const int grp = un & 3; int rowbase, n0, L; geom(un, rowbase, n0, L);
        if (grp != grp_w) { grp_w = grp; load_w(grp); }
        __syncthreads();
#pragma unroll
        for (int i = 0; i < 3; ++i) { const int p = tid + i * NTHREADS; const int r = p >> 4, c8 = (p & 15) * 8;
            if (p < 94 * 16) { const u32x4 a = pa[i], g = pg[i];
                f32x4 o0, o1;
                o0[0] = bflo(a.x) * sigmoidf_(bflo(g.x)); o0[1] = bfhi(a.x) * sigmoidf_(bfhi(g.x)); o0[2] = bflo(a.y) * sigmoidf_(bflo(g.y)); o0[3] = bfhi(a.y) * sigmoidf_(bfhi(g.y));
                o1[0] = bflo(a.z) * sigmoidf_(bflo(g.z)); o1[1] = bfhi(a.z) * sigmoidf_(bfhi(g.z)); o1[2] = bflo(a.w) * sigmoidf_(bflo(g.w)); o1[3] = bfhi(a.w) * sigmoidf_(bfhi(g.w));
                *(LAS f32x4*)(u + r * 128 + c8) = o0; *(LAS f32x4*)(u + r * 128 + c8 + 4) = o1; } }
        if (un + F.G < ntile * 4) fetch(un + F.G);
        __syncthreads();
        {
          float uw[46];
#pragma unroll
          for (int i = 0; i < 46; ++i) uw[i] = u[(tq * 16 + i) * 128 + ch];
#pragma unroll
          for (int t = 0; t < 16; ++t) { float a = bias;
#pragma unroll
              for (int j = 0; j < 31; ++j) a = fmaf(uw[t + j], w[j], a);
              y[(tq * 16 + t) * 128 + ch] = a; } }
        __syncthreads();
        { const int tb = F.wid * 8;
#pragma unroll
          for (int i = 0; i < 8; ++i) { const int t = tb + i; const float v0 = y[t * 128 + lane], v1 = y[t * 128 + 64 + lane];
              const float mu = wave_sum(v0 + v1) * (1.0f / 128.0f); const float d0 = v0 - mu, d1 = v1 - mu;
              const float var = wave_sum(d0 * d0 + d1 * d1) * (1.0f / 128.0f); const float rs = rsqrtf(var + 1e-5f);
              const float y0 = d0 * rs * g0 + b0, y1 = d1 * rs * g1 + b1;
              unsigned char* o = F.ws + WS_BR + ((size_t)1 * MT + rowbase + n0 + t) * 512 + grp * 128;
              o[lane] = f2fp8(y0 * sigmoidf_(y0)); o[64 + lane] = f2fp8(y1 * sigmoidf_(y1)); } }
    }
    __syncthreads();
}

namespace att {
#define SBAR() __builtin_amdgcn_sched_barrier(0)
__device__ __forceinline__ int crow(int r, int hi) { return (r & 3) + 8 * (r >> 2) + 4 * hi; }
template <int OFF> __device__ __forceinline__ s16x4 tr_read(int vb) { s16x4 r; asm volatile("ds_read_b64_tr_b16 %0, %1 offset:%2" : "=&v"(r) : "v"(vb), "i"(OFF) : "memory"); return r; }
__device__ __forceinline__ int v_rd_base(int lane) { return ((lane & 3) << 3) | (((lane >> 2) & 3) << 6) | (((lane >> 4) & 1) << 5) | (((lane >> 5) & 1) << 8); }
constexpr int v_rd_off(int d0, int ks, int half) { return d0 * 512 + ks * 4096 + half * 2048; }
template <int D0> __device__ __forceinline__ void pv_one(f32x16& od, int vb, bf16x8 pa0, bf16x8 pa1, bf16x8 pa2, bf16x8 pa3) {
    const s16x4 l0 = tr_read<v_rd_off(D0, 0, 0)>(vb), h0 = tr_read<v_rd_off(D0, 0, 1)>(vb), l1 = tr_read<v_rd_off(D0, 1, 0)>(vb), h1 = tr_read<v_rd_off(D0, 1, 1)>(vb);
    const s16x4 l2 = tr_read<v_rd_off(D0, 2, 0)>(vb), h2 = tr_read<v_rd_off(D0, 2, 1)>(vb), l3 = tr_read<v_rd_off(D0, 3, 0)>(vb), h3 = tr_read<v_rd_off(D0, 3, 1)>(vb);
    asm volatile("s_waitcnt lgkmcnt(0)" ::: "memory"); SBAR();
#define PK(L, H) (bf16x8){L[0], L[1], L[2], L[3], H[0], H[1], H[2], H[3]}
    od = __builtin_amdgcn_mfma_f32_32x32x16_bf16(pa0, PK(l0, h0), od, 0, 0, 0);
    od = __builtin_amdgcn_mfma_f32_32x32x16_bf16(pa1, PK(l1, h1), od, 0, 0, 0);
    od = __builtin_amdgcn_mfma_f32_32x32x16_bf16(pa2, PK(l2, h2), od, 0, 0, 0);
    od = __builtin_amdgcn_mfma_f32_32x32x16_bf16(pa3, PK(l3, h3), od, 0, 0, 0);
#undef PK
}
__device__ __forceinline__ void pv_d0(f32x16* o, int vb, bf16x8 pa0, bf16x8 pa1, bf16x8 pa2, bf16x8 pa3) {
    pv_one<0>(o[0], vb, pa0, pa1, pa2, pa3); pv_one<1>(o[1], vb, pa0, pa1, pa2, pa3); pv_one<2>(o[2], vb, pa0, pa1, pa2, pa3); pv_one<3>(o[3], vb, pa0, pa1, pa2, pa3);
}
template <int D0> __device__ __forceinline__ void pv_one2(f32x16& od0, f32x16& od1, int vb, bf16x8 a0, bf16x8 a1, bf16x8 a2, bf16x8 a3, bf16x8 b0, bf16x8 b1, bf16x8 b2, bf16x8 b3) {
    const s16x4 l0 = tr_read<v_rd_off(D0, 0, 0)>(vb), h0 = tr_read<v_rd_off(D0, 0, 1)>(vb), l1 = tr_read<v_rd_off(D0, 1, 0)>(vb), h1 = tr_read<v_rd_off(D0, 1, 1)>(vb);
    const s16x4 l2 = tr_read<v_rd_off(D0, 2, 0)>(vb), h2 = tr_read<v_rd_off(D0, 2, 1)>(vb), l3 = tr_read<v_rd_off(D0, 3, 0)>(vb), h3 = tr_read<v_rd_off(D0, 3, 1)>(vb);
    asm volatile("s_waitcnt lgkmcnt(0)" ::: "memory"); SBAR();
#define PK(L, H) (bf16x8){L[0], L[1], L[2], L[3], H[0], H[1], H[2], H[3]}
    const bf16x8 v0 = PK(l0, h0), v1 = PK(l1, h1), v2 = PK(l2, h2), v3 = PK(l3, h3);
    od0 = __builtin_amdgcn_mfma_f32_32x32x16_bf16(a0, v0, od0, 0, 0, 0); od1 = __builtin_amdgcn_mfma_f32_32x32x16_bf16(b0, v0, od1, 0, 0, 0);
    od0 = __builtin_amdgcn_mfma_f32_32x32x16_bf16(a1, v1, od0, 0, 0, 0); od1 = __builtin_amdgcn_mfma_f32_32x32x16_bf16(b1, v1, od1, 0, 0, 0);
    od0 = __builtin_amdgcn_mfma_f32_32x32x16_bf16(a2, v2, od0, 0, 0, 0); od1 = __builtin_amdgcn_mfma_f32_32x32x16_bf16(b2, v2, od1, 0, 0, 0);
    od0 = __builtin_amdgcn_mfma_f32_32x32x16_bf16(a3, v3, od0, 0, 0, 0); od1 = __builtin_amdgcn_mfma_f32_32x32x16_bf16(b3, v3, od1, 0, 0, 0);
#undef PK
}
typedef int v8i_att_t __attribute__((ext_vector_type(8)));
__device__ __forceinline__ void softmax_tile8(f32x16& p0, f32x16& p1, float C, float& m_reg, float& l_reg, float& alpha, v8i_att_t& pa) {
    float pmax = p0[0];
#pragma unroll
    for (int r = 1; r < 16; ++r) pmax = fmaxf(pmax, p0[r]);
#pragma unroll
    for (int r = 0; r < 16; ++r) pmax = fmaxf(pmax, p1[r]);
    { auto rr = __builtin_amdgcn_permlane32_swap(__float_as_uint(pmax), __float_as_uint(pmax), false, false); pmax = fmaxf(__uint_as_float(rr[0]), __uint_as_float(rr[1])); }
    float mn;
    if (__builtin_expect(__all((pmax - m_reg) * C <= 8.5f), 1)) { mn = m_reg; alpha = 1.f; }
    else { mn = fmaxf(m_reg, pmax); alpha = __builtin_amdgcn_exp2f((m_reg - mn) * C); m_reg = mn; }
    const float mnC = -mn * C;
#pragma unroll
    for (int r = 0; r < 16; ++r) { p0[r] = __builtin_amdgcn_exp2f(fmaf(p0[r], C, mnC)); p1[r] = __builtin_amdgcn_exp2f(fmaf(p1[r], C, mnC)); }
    float ps = 0.f;
#pragma unroll
    for (int r = 0; r < 16; ++r) ps += p0[r] + p1[r];
    { auto rr = __builtin_amdgcn_permlane32_swap(__float_as_uint(ps), __float_as_uint(ps), false, false); ps = __uint_as_float(rr[0]) + __uint_as_float(rr[1]); }
    l_reg = l_reg * alpha + ps;
#pragma unroll
    for (int w = 0; w < 4; ++w) { int a_ = 0, b_ = 0;
        a_ = __builtin_amdgcn_cvt_pk_fp8_f32(p0[4 * w], p0[4 * w + 1], a_, false); a_ = __builtin_amdgcn_cvt_pk_fp8_f32(p0[4 * w + 2], p0[4 * w + 3], a_, true);
        b_ = __builtin_amdgcn_cvt_pk_fp8_f32(p1[4 * w], p1[4 * w + 1], b_, false); b_ = __builtin_amdgcn_cvt_pk_fp8_f32(p1[4 * w + 2], p1[4 * w + 3], b_, true);
        pa[w] = a_; pa[4 + w] = b_; }
}
__device__ __forceinline__ void softmax_tile(f32x16& p0, f32x16& p1, float C, float& m_reg, float& l_reg, float& alpha, bf16x8& pa0, bf16x8& pa1, bf16x8& pa2, bf16x8& pa3) {
    float pmax = p0[0];
#pragma unroll
    for (int r = 1; r < 16; ++r) pmax = fmaxf(pmax, p0[r]);
#pragma unroll
    for (int r = 0; r < 16; ++r) pmax = fmaxf(pmax, p1[r]);
    { auto rr = __builtin_amdgcn_permlane32_swap(__float_as_uint(pmax), __float_as_uint(pmax), false, false); pmax = fmaxf(__uint_as_float(rr[0]), __uint_as_float(rr[1])); }
    float mn;
    if (__builtin_expect(__all((pmax - m_reg) * C <= 11.541560327111707f), 1)) { mn = m_reg; alpha = 1.f; }
    else { mn = fmaxf(m_reg, pmax); alpha = __builtin_amdgcn_exp2f((m_reg - mn) * C); m_reg = mn; }
    const float mnC = -mn * C;
#pragma unroll
    for (int r = 0; r < 16; ++r) { p0[r] = __builtin_amdgcn_exp2f(fmaf(p0[r], C, mnC)); p1[r] = __builtin_amdgcn_exp2f(fmaf(p1[r], C, mnC)); }
    float ps = 0.f;
#pragma unroll
    for (int r = 0; r < 16; ++r) ps += p0[r] + p1[r];
    { auto rr = __builtin_amdgcn_permlane32_swap(__float_as_uint(ps), __float_as_uint(ps), false, false); ps = __uint_as_float(rr[0]) + __uint_as_float(rr[1]); }
    l_reg = l_reg * alpha + ps;
#define PK4(P, BASE, OUT) do { unsigned a0 = cvt_pk_bf16(P[BASE + 0], P[BASE + 1]), a1 = cvt_pk_bf16(P[BASE + 2], P[BASE + 3]);   \
    unsigned b0 = cvt_pk_bf16(P[BASE + 4], P[BASE + 5]), b1 = cvt_pk_bf16(P[BASE + 6], P[BASE + 7]);                              \
    auto r0 = __builtin_amdgcn_permlane32_swap(a0, b0, false, false); auto r1 = __builtin_amdgcn_permlane32_swap(a1, b1, false, false); \
    u32x4 w = {r0[0], r1[0], r0[1], r1[1]}; OUT = *reinterpret_cast<bf16x8*>(&w); } while (0)
    PK4(p0, 0, pa0); PK4(p0, 8, pa1); PK4(p1, 0, pa2); PK4(p1, 8, pa3);
#undef PK4
}
__device__ __forceinline__ void rope_pair(bf16x8& x1, bf16x8& x2, const float* __restrict__ cs) {
    float c[16];
#pragma unroll
    for (int i = 0; i < 4; ++i) { const f32x4 v = *(const f32x4*)(cs + 4 * i); c[4 * i] = v[0]; c[4 * i + 1] = v[1]; c[4 * i + 2] = v[2]; c[4 * i + 3] = v[3]; }
#pragma unroll
    for (int j = 0; j < 8; ++j) { const float a = bf2f((bf16_t)x1[j]), b = bf2f((bf16_t)x2[j]);
        x1[j] = (short)f2bf(a * c[2 * j] - b * c[2 * j + 1]); x2[j] = (short)f2bf(b * c[2 * j] + a * c[2 * j + 1]); }
}

constexpr int SHM_V = 64 * 128 * 2;
template <int MODE>
__device__ __forceinline__ void attn_unit(const Ctx& F, int l, int b, int h, int qb) {
    constexpr int NKS = MODE == 0 ? 12 : 8;
    constexpr int RB = MODE == 0 ? 192 + 16 : 128 + 16;
    constexpr int SHM_K = 64 * RB;
    constexpr int PPR = RB / 16;
    constexpr int NKF = 64 * PPR / NTHREADS;
    constexpr int NXW = (64 * PPR - NKF * NTHREADS) / 64;
    int tid_ = F.tid; asm volatile("" : "+v"(tid_));
    const int tid = tid_, wid = F.wid, lane = tid & 63, r32 = lane & 31, hi = lane >> 5;
    constexpr int SHMV = 128 * 80;
    LAS unsigned char* Kl = F.lds; LAS unsigned char* Vl = F.lds + 2 * SHM_K;
    LAS float* wsc = (LAS float*)(F.lds + 2 * SHM_K + 2 * SHMV) + wid * 512;
    LAS unsigned char* Ql = F.lds + 2 * SHM_K + 2 * SHMV + 16384 + wid * 8192 + lane * 16;
    const bool lat = qb < 32;
    const int NT = lat ? (CTXL + SEQ) / 64 : CTXL / 64;
    const bf16_t* Zb = F.bf(WS_Z);
    const char* wsb = (const char*)F.ws;
    static_assert(64 * PPR == NKF * NTHREADS + NXW * 64, "K tile pieces");
    auto k_off = [&](int i, size_t rb, int tl) -> size_t { const int s = i * NTHREADS + tl; const int row = s / PPR, q = s % PPR; const int lp = q == PPR - 1 ? 0 : q;
        if (MODE == 0) return WS_K8 + ((rb + row) * 4 + h) * 256 + lp * 16;
        return WS_KD8 + ((rb + row) * 4 + h) * 128 + lp * 16; };
    auto v8_off = [&](int i, size_t rb, int tl) -> size_t { const int s = i * NTHREADS + tl; const int d = s / 5, q = s % 5;
        return (MODE == 0 ? WS_V8T : WS_VD8T) + (((size_t)h * (MT / 64) + rb / 64) * 128 + d) * 64 + (q == 4 ? 0 : q) * 16; };
    auto v_off = [&](int i, size_t rb, int tl) -> size_t { const int s = i * NTHREADS + tl; const int sub = s >> 5; const int kk = (sub >> 2) * 8 + ((s & 31) >> 2);
        const int k = (kk & ~0xC) | ((kk & 4) << 1) | ((kk & 8) >> 1); const int c = (sub & 3) * 32 + (s & 3) * 8;
        return MODE == 0 ? WS_KV + ((rb + k) * 1024 + h * 256 + 128 + c) * 2 : WS_Z + ((rb + k) * ZLD + ZC_DV + h * 128 + c) * 2; };
#define ATT_ROWBASE(j) ((j) < 4 ? (ML + b * CTXL + (j) * 64) : (b * SEQ + ((j) - 4) * 64))
#define ATT_STAGE(j, buf) do { const size_t _rb = (size_t)ATT_ROWBASE(j); int _tl = tid; asm volatile("" : "+v"(_tl)); \
    _Pragma("unroll") for (int _i = 0; _i < NKF; ++_i) __builtin_amdgcn_global_load_lds((const unsigned*)(wsb + k_off(_i, _rb, _tl)), (LAS unsigned*)(Kl + (buf) * SHM_K + (_i * NTHREADS + wid * 64) * 16), 16, 0, 0); \
    if (wid < NXW) __builtin_amdgcn_global_load_lds((const unsigned*)(wsb + k_off(NKF, _rb, _tl)), (LAS unsigned*)(Kl + (buf) * SHM_K + (NKF * NTHREADS + wid * 64) * 16), 16, 0, 0); \
    if constexpr (true) {   \
        __builtin_amdgcn_global_load_lds((const unsigned*)(wsb + v8_off(0, _rb, _tl)), (LAS unsigned*)(Vl + (buf) * SHMV + (wid * 64) * 16), 16, 0, 0); \
        if (wid < 2) __builtin_amdgcn_global_load_lds((const unsigned*)(wsb + v8_off(1, _rb, _tl)), (LAS unsigned*)(Vl + (buf) * SHMV + (NTHREADS + wid * 64) * 16), 16, 0, 0); } \
    else { _Pragma("unroll") for (int _i = 0; _i < 2; ++_i) __builtin_amdgcn_global_load_lds((const unsigned*)(wsb + v_off(_i, _rb, _tl)), (LAS unsigned*)(Vl + (buf) * SHMV + (_i * NTHREADS + wid * 64) * 16), 16, 0, 0); } } while (0)
    __syncthreads();
    ATT_STAGE(0, 0);
    const int qrow = lat ? b * SEQ + qb * 256 + wid * 32 + r32 : ML + b * CTXL + wid * 32 + r32;
    bf16x8 qr[NKS];
    { const bf16_t* qp = MODE == 0 ? F.bf(WS_Q) + (size_t)qrow * 768 + h * 192 + hi * 8 : Zb + (size_t)qrow * ZLD + ZC_DQ + h * 128 + hi * 8;
#pragma unroll
      for (int d0 = 0; d0 < NKS; ++d0) qr[d0] = *(const bf16x8*)(qp + d0 * 16);
      if (lat) { const float* rp = F.f32(WS_ROPE) + ((size_t)(qb * 256 + wid * 32 + r32) * 32 + hi * 8) * 2;
          if (MODE == 0) { rope_pair(qr[8], qr[10], rp); rope_pair(qr[9], qr[11], rp + 32); }
          else { rope_pair(qr[0], qr[2], rp); rope_pair(qr[1], qr[3], rp + 32); rope_pair(qr[4], qr[6], rp); rope_pair(qr[5], qr[7], rp + 32); } }
    }
    typedef int v8i_t __attribute__((ext_vector_type(8)));
    constexpr int NS8 = MODE == 0 ? 3 : 2;
    v8i_t q8[3];
    {
#pragma unroll
        for (int s_ = 0; s_ < NS8; ++s_) { unsigned P[4][2];
#pragma unroll
            for (int dd = 0; dd < 4; ++dd) { const bf16x8 v = qr[4 * s_ + dd]; float f[8];
#pragma unroll
                for (int j = 0; j < 8; ++j) f[j] = bf2f((bf16_t)v[j]);
                int a_ = 0, b_ = 0; a_ = __builtin_amdgcn_cvt_pk_fp8_f32(f[0], f[1], a_, false); a_ = __builtin_amdgcn_cvt_pk_fp8_f32(f[2], f[3], a_, true);
                b_ = __builtin_amdgcn_cvt_pk_fp8_f32(f[4], f[5], b_, false); b_ = __builtin_amdgcn_cvt_pk_fp8_f32(f[6], f[7], b_, true); P[dd][0] = (unsigned)a_; P[dd][1] = (unsigned)b_; }
            auto r00 = __builtin_amdgcn_permlane32_swap(P[0][0], P[2][0], false, false); auto r01 = __builtin_amdgcn_permlane32_swap(P[0][1], P[2][1], false, false);
            auto r10 = __builtin_amdgcn_permlane32_swap(P[1][0], P[3][0], false, false); auto r11 = __builtin_amdgcn_permlane32_swap(P[1][1], P[3][1], false, false);
            q8[s_] = (v8i_t){(int)r00[0], (int)r01[0], (int)r00[1], (int)r01[1], (int)r10[0], (int)r11[0], (int)r10[1], (int)r11[1]};
            if (MODE == 1) { *(LAS u32x4*)(Ql + (2 * s_) * 1024) = (u32x4){(unsigned)q8[s_][0], (unsigned)q8[s_][1], (unsigned)q8[s_][2], (unsigned)q8[s_][3]};
                             *(LAS u32x4*)(Ql + (2 * s_ + 1) * 1024) = (u32x4){(unsigned)q8[s_][4], (unsigned)q8[s_][5], (unsigned)q8[s_][6], (unsigned)q8[s_][7]}; } } }
    int sc1_ = 0x7F7F7F7F; asm volatile("" : "+v"(sc1_));
    constexpr float LOG2E = 1.4426950408889634f;
    const float C = (MODE == 0 ? 0.07216878364870322f : 0.125f) * LOG2E;
    constexpr int NACC = MODE == 0 ? 1 : 2;
    f32x16 o[NACC][4]; float m_reg[NACC], l_reg[NACC];
#pragma unroll
    for (int a = 0; a < NACC; ++a) { float mi = -1e30f, li = 0.f; asm volatile("" : "+v"(mi), "+v"(li));
        m_reg[a] = mi; l_reg[a] = li; if (MODE == 1) { wsc[64 + 4 * lane + 2 * a] = mi; wsc[64 + 4 * lane + 2 * a + 1] = li; }
#pragma unroll
        for (int d = 0; d < 4; ++d) o[a][d] = f32x16{}; }
    const int vb0 = (int)(uintptr_t)Vl + v_rd_base(lane);
    asm volatile("s_waitcnt vmcnt(0)" ::: "memory"); __syncthreads();
    v8i_att_t keep8 = {};
    for (int j = 0; j < NT; ++j) {
        const int buf = j & 1;
        if (j + 1 < NT) ATT_STAGE(j + 1, buf ^ 1);
        const LAS unsigned char* Ks = Kl + buf * SHM_K;
#pragma unroll
        for (int a = 0; a < NACC; ++a) {
            f32x16 p0 = f32x16{}, p1 = f32x16{};
            {
                constexpr int NSQ = MODE == 0 ? 3 : 1;
#pragma unroll
                for (int s_ = 0; s_ < NSQ; ++s_) { const LAS unsigned char* kp = Ks + r32 * RB + (MODE == 0 ? s_ : a) * 64 + hi * 32;
                    const u32x4 a0_ = *(const LAS u32x4*)kp, a1_ = *(const LAS u32x4*)(kp + 16), c0_ = *(const LAS u32x4*)(kp + 32 * RB), c1_ = *(const LAS u32x4*)(kp + 32 * RB + 16);
                    const v8i_t b0 = (v8i_t){(int)a0_[0], (int)a0_[1], (int)a0_[2], (int)a0_[3], (int)a1_[0], (int)a1_[1], (int)a1_[2], (int)a1_[3]};
                    const v8i_t b1 = (v8i_t){(int)c0_[0], (int)c0_[1], (int)c0_[2], (int)c0_[3], (int)c1_[0], (int)c1_[1], (int)c1_[2], (int)c1_[3]};
                    v8i_t qf;
                    if (MODE == 0) qf = q8[s_];
                    else { const u32x4 q0_ = *(const LAS u32x4*)(Ql + (2 * a) * 1024), q1_ = *(const LAS u32x4*)(Ql + (2 * a + 1) * 1024);
                        qf = (v8i_t){(int)q0_[0], (int)q0_[1], (int)q0_[2], (int)q0_[3], (int)q1_[0], (int)q1_[1], (int)q1_[2], (int)q1_[3]}; }
                    asm volatile("v_mfma_scale_f32_32x32x64_f8f6f4 %0, %1, %2, %0, %3, %4 op_sel_hi:[0,0,0]" : "+v"(p0) : "v"(b0), "v"(qf), "v"(sc1_), "v"(sc1_));
                    asm volatile("v_mfma_scale_f32_32x32x64_f8f6f4 %0, %1, %2, %0, %3, %4 op_sel_hi:[0,0,0]" : "+v"(p1) : "v"(b1), "v"(qf), "v"(sc1_), "v"(sc1_)); }
                asm volatile("s_nop 15\n\ts_nop 7" : "+v"(p0), "+v"(p1));
                SBAR();
            }
            float alpha; bf16x8 pa0, pa1, pa2, pa3; v8i_att_t pa8;
            if (MODE == 1) { float mm = wsc[64 + 4 * lane + 2 * a], ll = wsc[64 + 4 * lane + 2 * a + 1];
                softmax_tile8(p0, p1, C, mm, ll, alpha, pa8); wsc[64 + 4 * lane + 2 * a] = mm; wsc[64 + 4 * lane + 2 * a + 1] = ll; }
            else if (MODE == 0) softmax_tile8(p0, p1, C, m_reg[a], l_reg[a], alpha, pa8);
            else softmax_tile(p0, p1, C, m_reg[a], l_reg[a], alpha, pa0, pa1, pa2, pa3);
            if (__any(alpha < 1.f)) { if (hi == 0) wsc[r32] = alpha; asm volatile("s_waitcnt lgkmcnt(0)" ::: "memory");
#pragma unroll
                for (int r = 0; r < 16; ++r) { const float al = wsc[crow(r, hi)];
#pragma unroll
                    for (int d = 0; d < 4; ++d) o[a][d][r] *= al; } }
            SBAR();
            if constexpr (MODE == 0) {
#pragma unroll
                for (int d0 = 0; d0 < 4; ++d0) { const LAS unsigned char* vp = Vl + buf * SHMV + (d0 * 32 + r32) * 80 + hi * 32;
                    const u32x4 v0_ = *(const LAS u32x4*)vp, v1_ = *(const LAS u32x4*)(vp + 16);
                    const v8i_t vf = (v8i_t){(int)v0_[0], (int)v0_[1], (int)v0_[2], (int)v0_[3], (int)v1_[0], (int)v1_[1], (int)v1_[2], (int)v1_[3]};
                    asm volatile("v_mfma_scale_f32_32x32x64_f8f6f4 %0, %1, %2, %0, %3, %4 op_sel_hi:[0,0,0]" : "+v"(o[a][d0]) : "v"(pa8), "v"(vf), "v"(sc1_), "v"(sc1_)); } }
            else { if (a == 0) keep8 = pa8;
                   else {
#pragma unroll
                       for (int d0 = 0; d0 < 4; ++d0) { const LAS unsigned char* vp = Vl + buf * SHMV + (d0 * 32 + r32) * 80 + hi * 32;
                           const u32x4 v0_ = *(const LAS u32x4*)vp, v1_ = *(const LAS u32x4*)(vp + 16);
                           const v8i_t vf = (v8i_t){(int)v0_[0], (int)v0_[1], (int)v0_[2], (int)v0_[3], (int)v1_[0], (int)v1_[1], (int)v1_[2], (int)v1_[3]};
                           asm volatile("v_mfma_scale_f32_32x32x64_f8f6f4 %0, %1, %2, %0, %3, %4 op_sel_hi:[0,0,0]" : "+v"(o[0][d0]) : "v"(keep8), "v"(vf), "v"(sc1_), "v"(sc1_));
                           asm volatile("v_mfma_scale_f32_32x32x64_f8f6f4 %0, %1, %2, %0, %3, %4 op_sel_hi:[0,0,0]" : "+v"(o[NACC - 1][d0]) : "v"(pa8), "v"(vf), "v"(sc1_), "v"(sc1_)); } } }
        }
        asm volatile("s_waitcnt vmcnt(0)" ::: "memory"); __syncthreads();
    }
    if constexpr (MODE == 0) { asm volatile("s_nop 15\n\ts_nop 7" : "+v"(o[0][0]), "+v"(o[0][1]), "+v"(o[0][2]), "+v"(o[0][3])); SBAR(); }
    else { asm volatile("s_nop 15\n\ts_nop 7" : "+v"(o[0][0]), "+v"(o[0][1]), "+v"(o[0][2]), "+v"(o[0][3]), "+v"(o[NACC - 1][0]), "+v"(o[NACC - 1][1]), "+v"(o[NACC - 1][2]), "+v"(o[NACC - 1][3])); SBAR(); }
    const int orow0 = lat ? b * SEQ + qb * 256 + wid * 32 : ML + b * CTXL + wid * 32;
    if (MODE == 0) {
        if (hi == 0) wsc[32 + r32] = l_reg[0]; asm volatile("s_waitcnt lgkmcnt(0)" ::: "memory");
        unsigned char* Ob = F.ws + WS_BR + (size_t)orow0 * 512 + h * 128;
#pragma unroll
        for (int r = 0; r < 16; ++r) { const int orow = crow(r, hi); const float rl = 64.f * __builtin_amdgcn_rcpf(wsc[32 + orow]);
#pragma unroll
            for (int d0 = 0; d0 < 4; ++d0) Ob[(size_t)orow * 512 + d0 * 32 + r32] = f2fp8(o[0][d0][r] * rl); }
    } else {
        const float lam_init = l == 0 ? 0.2f : 0.35550906759060355f;
        const float s1 = wave_sum(F.inp(I_LQ1)[l * 64 + lane] * F.inp(I_LK1)[l * 64 + lane]), s2 = wave_sum(F.inp(I_LQ2)[l * 64 + lane] * F.inp(I_LK2)[l * 64 + lane]);
        const float lam = __expf(s1) - __expf(s2) + lam_init;
        { const float ll0 = wsc[64 + 4 * lane + 1], ll1 = wsc[64 + 4 * lane + 3]; if (hi == 0) { wsc[r32] = ll0; wsc[32 + r32] = ll1; } } asm volatile("s_waitcnt lgkmcnt(0)" ::: "memory");
        unsigned char* Ob = F.ws + WS_BR + ((size_t)2 * MT + orow0) * 512 + h * 128;
        float gs[4];
#pragma unroll
        for (int d0 = 0; d0 < 4; ++d0) gs[d0] = F.inp(I_GSUB)[l * 128 + d0 * 32 + r32] * (1.0f - lam_init);
#pragma unroll
        for (int r = 0; r < 16; ++r) { const int orow = crow(r, hi); const float rl0 = __builtin_amdgcn_rcpf(wsc[orow]), rl1 = lam * __builtin_amdgcn_rcpf(wsc[32 + orow]);
            float v[4]; float ss = 0.f;
#pragma unroll
            for (int d0 = 0; d0 < 4; ++d0) { v[d0] = o[0][d0][r] * rl0 - o[1][d0][r] * rl1; ss += v[d0] * v[d0]; }
            ss = half_sum_dpp(ss, hi);
            const float rs = rsqrtf(ss * (1.0f / 128.0f) + 1e-6f);
#pragma unroll
            for (int d0 = 0; d0 < 4; ++d0) Ob[(size_t)orow * 512 + d0 * 32 + r32] = f2fp8(v[d0] * rs * gs[d0]); }
    }
#undef ATT_ROWBASE
#undef ATT_STAGE
}
}

namespace fnet {
__device__ __forceinline__ int crow(int r, int hi) { return (r & 3) + 8 * (r >> 2) + 4 * hi; }
__device__ __forceinline__ void v_slot(int s, int& k, int& c) { const int sub = s >> 5; const int kk = (sub >> 2) * 8 + ((s & 31) >> 2); k = (kk & ~0xC) | ((kk & 4) << 1) | ((kk & 8) >> 1); c = (sub & 3) * 32 + (s & 3) * 8; }
template <int NT> __device__ __forceinline__ void stage_tiles(const Ctx& F, const bf16_t* src, size_t stride, LAS unsigned char* dst) {
#pragma unroll
    for (int i = 0; i < NT * 2; ++i) { const int s = i * NTHREADS + F.tid; int k, c; v_slot(s & 1023, k, c); const int t = s >> 10;
        __builtin_amdgcn_global_load_lds((const unsigned*)(src + (size_t)(64 * t + k) * stride + c), (LAS unsigned*)(dst + (i * NTHREADS + F.wid * 64) * 16), 16, 0, 0); }
}
__device__ __forceinline__ bf16x8 pack8(const float (&v)[8]) { u32x4 w = {cvt_pk_bf16(v[0], v[1]), cvt_pk_bf16(v[2], v[3]), cvt_pk_bf16(v[4], v[5]), cvt_pk_bf16(v[6], v[7])}; return *reinterpret_cast<bf16x8*>(&w); }

__device__ __forceinline__ void phase_s1_ctx(const Ctx& F, bool do_ctx) {
    LAS unsigned char* Bt = F.lds; LAS float* T = (LAS float*)(F.lds + 65536); LAS float* tw = T + 512;
    const int tid = F.tid, wid = F.wid, lane = F.lane, r32 = lane & 31, hi = lane >> 5;
    __syncthreads();
    for (int i = tid; i < 256; i += NTHREADS) { const float x = (float)i * (1.0f / 128.0f); T[2 * i] = cospif(x); T[2 * i + 1] = sinpif(x); }
    __syncthreads();
    const int vb = (int)(uintptr_t)Bt + att::v_rd_base(lane);
    bf16x8 pa[2][4];
    { const int k1 = 16 * wid + (r32 & 15); const bool im = r32 >= 16;
#pragma unroll
      for (int t = 0; t < 2; ++t)
#pragma unroll
          for (int ks = 0; ks < 4; ++ks) { float v[8];
#pragma unroll
              for (int j = 0; j < 8; ++j) { const int n1 = 64 * t + 16 * ks + 8 * hi + j; const int idx = ((k1 * n1) & 127) * 2; v[j] = im ? -T[2 * idx + 1] : T[2 * idx]; }
              pa[t][ks] = pack8(v); } }
    for (int un = F.bid; un < NBATCH * 64 * 4; un += F.G) {
        const int b = un >> 8, n2 = (un >> 2) & 63, g = un & 3;
        __syncthreads();
        stage_tiles<2>(F, F.bf(WS_Z) + (size_t)(b * SEQ + n2) * ZLD + ZC_F + g * 128, (size_t)64 * ZLD, Bt);
        if (tid < 128) { const float x = (float)(n2 * tid) * (1.0f / 4096.0f); tw[2 * tid] = cospif(x); tw[2 * tid + 1] = sinpif(x); }
        asm volatile("s_waitcnt vmcnt(0)" ::: "memory"); __syncthreads();
        f32x16 o[4] = {f32x16{}, f32x16{}, f32x16{}, f32x16{}};
        att::pv_d0(o, vb, pa[0][0], pa[0][1], pa[0][2], pa[0][3]);
        att::pv_d0(o, vb + 16384, pa[1][0], pa[1][1], pa[1][2], pa[1][3]);
        bf16_t* AP = F.bf(WS_AP);
#pragma unroll
        for (int r = 0; r < 8; ++r) { const int kk1 = 16 * wid + crow(r, hi); const float c = tw[2 * kk1], sn = tw[2 * kk1 + 1];
#pragma unroll
            for (int d0 = 0; d0 < 4; ++d0) { const float ar = o[d0][r], ai = o[d0][r + 8];
                const size_t base = ((((size_t)b * 128 + kk1) * 2) * 64 + n2) * 512 + g * 128 + d0 * 32 + r32;
                AP[base] = f2bf(ar * c + ai * sn); AP[base + (size_t)64 * 512] = f2bf(ai * c - ar * sn); } }
    }
    if (do_ctx) for (int un = F.bid; un < NBATCH * 4 * 2; un += F.G) {
        const int b = un >> 3, g = (un >> 1) & 3, kh = un & 1;
        __syncthreads();
        stage_tiles<4>(F, F.bf(WS_Z) + (size_t)(ML + b * CTXL) * ZLD + ZC_F + g * 128, (size_t)ZLD, Bt);
        const int k = 128 * kh + 16 * wid + (r32 & 15); const bool im = r32 >= 16; const float nrm = 0.005524271728019903f;
        asm volatile("s_waitcnt vmcnt(0)" ::: "memory"); __syncthreads();
        f32x16 o[4] = {f32x16{}, f32x16{}, f32x16{}, f32x16{}};
#pragma unroll
        for (int t = 0; t < 4; ++t) { bf16x8 pc[4];
#pragma unroll
            for (int ks = 0; ks < 4; ++ks) { float v[8];
#pragma unroll
                for (int j = 0; j < 8; ++j) { const int n = 64 * t + 16 * ks + 8 * hi + j; const int idx = (k * n) & 255; v[j] = (im ? -T[2 * idx + 1] : T[2 * idx]) * nrm; }
                pc[ks] = pack8(v); }
            att::pv_d0(o, vb + t * 16384, pc[0], pc[1], pc[2], pc[3]); }
        unsigned char* X = F.ws + WS_X;
#pragma unroll
        for (int r = 0; r < 8; ++r) { const int kk = 128 * kh + 16 * wid + crow(r, hi);
#pragma unroll
            for (int d0 = 0; d0 < 4; ++d0) { const size_t base = (size_t)(ML + b * CTXL + kk) * 1024 + g * 128 + d0 * 32 + r32; X[base] = f2fp8(o[d0][r]); X[base + 512] = f2fp8(o[d0][r + 8]); } }
    }
    __syncthreads();
}
__device__ __forceinline__ void phase_s3(const Ctx& F) {
    LAS unsigned char* Bt = F.lds; LAS float* T = (LAS float*)(F.lds + 65536);
    const int tid = F.tid, wid = F.wid, lane = F.lane, r32 = lane & 31, hi = lane >> 5;
    __syncthreads();
    for (int i = tid; i < 256; i += NTHREADS) { const float x = (float)i * (1.0f / 128.0f); T[2 * i] = cospif(x); T[2 * i + 1] = sinpif(x); }
    __syncthreads();
    const int usel = wid >> 2, wq = wid & 3;
    const int vb = (int)(uintptr_t)Bt + usel * 32768 + att::v_rd_base(lane);
    bf16x8 pa[2][4];
    { const int k2 = 16 * wq + (r32 & 15); const bool im = r32 >= 16; const float nrm = 1.0f / 1024.0f;
#pragma unroll
      for (int t = 0; t < 2; ++t)
#pragma unroll
          for (int ks = 0; ks < 4; ++ks) { float v[8];
#pragma unroll
              for (int j = 0; j < 8; ++j) { const int n2 = 16 * ks + 8 * hi + j; const int idx = ((n2 * k2) & 63) * 4; const float c = T[2 * idx], sn = T[2 * idx + 1];
                  v[j] = (im ? (t == 0 ? -sn : c) : (t == 0 ? c : sn)) * nrm; }
              pa[t][ks] = pack8(v); } }
    for (int up = F.bid; up < NBATCH * 128 * 4 / 2; up += F.G) {
        __syncthreads();
#pragma unroll
        for (int q = 0; q < 2; ++q) { const int un = 2 * up + q; const int b = un >> 9, k1 = (un >> 2) & 127, g = un & 3;
            stage_tiles<2>(F, F.bf(WS_AP) + ((size_t)b * 128 + k1) * 2 * 64 * 512 + g * 128, 512, Bt + q * 32768); }
        asm volatile("s_waitcnt vmcnt(0)" ::: "memory"); __syncthreads();
        const int un = 2 * up + usel; const int b = un >> 9, k1 = (un >> 2) & 127, g = un & 3;
        f32x16 o[4] = {f32x16{}, f32x16{}, f32x16{}, f32x16{}};
        att::pv_d0(o, vb, pa[0][0], pa[0][1], pa[0][2], pa[0][3]);
        att::pv_d0(o, vb + 16384, pa[1][0], pa[1][1], pa[1][2], pa[1][3]);
        unsigned char* X = F.ws + WS_X;
#pragma unroll
        for (int r = 0; r < 8; ++r) { const int k2 = 16 * wq + crow(r, hi); const size_t tok = (size_t)b * SEQ + k1 + 128 * k2;
#pragma unroll
            for (int d0 = 0; d0 < 4; ++d0) { const size_t base = tok * 1024 + g * 128 + d0 * 32 + r32; X[base] = f2fp8(o[d0][r]); X[base + 512] = f2fp8(o[d0][r + 8]); } }
    }
    __syncthreads();
}
}

namespace peer {
typedef float v32f_t __attribute__((ext_vector_type(32)));
typedef unsigned v6u_t __attribute__((ext_vector_type(6)));
__device__ __forceinline__ unsigned okey(float s) { const unsigned b = __float_as_uint(s); return b ^ ((unsigned)((int)b >> 31) | 0x80000000u); }
__device__ __forceinline__ float oval(unsigned k) { return __uint_as_float((k & 0x80000000u) ? (k ^ 0x80000000u) : ~k); }
template <int NE> __device__ __forceinline__ unsigned top16_row(unsigned (&key)[NE], int t) {
    unsigned sel = 0u;
#pragma unroll
    for (int n = 0; n < 16; ++n) { unsigned m = key[0];
#pragma unroll
        for (int e = 1; e < NE; ++e) m = m > key[e] ? m : key[e];
        m = row_max16_u(m); sel = (t == n) ? m : sel;
#pragma unroll
        for (int e = 0; e < NE; ++e) key[e] = (key[e] == m) ? 0u : key[e]; }
    return sel;
}
__device__ __forceinline__ float gelu_erf(float x) { return 0.5f * x * (1.0f + erff(x * 0.70710678118654752f)); }

__device__ __forceinline__ void peer_rows(const Ctx& F, int l, int nrows, bool dry = false) {
    const int lane = F.lane, wid = F.wid, t = lane & 15, rr = lane >> 4;
    LAS unsigned* selL = (LAS unsigned*)F.lds + wid * 1024;
    LAS unsigned* eidL = selL + 256; LAS float* gwL = (LAS float*)(selL + 384); LAS unsigned* tabL = selL + 512;
    { const int q = lane; int cnt = 0, fi = -1, fj = 0;
      for (int i = 0; i < 16; ++i) { const int nj = 16 / (i + 1); if (fi < 0 && q < cnt + nj) { fi = i; fj = q - cnt; } cnt += nj; }
      tabL[lane] = fi >= 0 ? (unsigned)(fi * 16 + fj) : 255u; }
    const unsigned char* PU = F.ws + WS_PU + (size_t)l * NEXP * PEER_UROWB; const unsigned char* PV = F.ws + WS_PV + (size_t)l * NEXP * PEER_VROWB;
    unsigned* rowcnt = (unsigned*)(F.ws + WS_DIAG + 2048 + l * 256);
    auto next_row = [&]() -> int { unsigned nx = 0u; if (lane == 0) nx = __hip_atomic_fetch_add(rowcnt, 1u, __ATOMIC_RELAXED, __HIP_MEMORY_SCOPE_AGENT); return F.G * NWAVES + __builtin_amdgcn_readfirstlane((int)nx); };
    for (int row = F.bid * NWAVES + wid; row < nrows; row = next_row()) {
        const bool cpart = l == 0 && row >= ML;
        const float* S = cpart ? F.f32(WS_PART) + (size_t)(row - ML) * DM : F.f32(WS_S) + (size_t)row * DM;
#pragma unroll
        for (int it = 0; it < 4; ++it) { const float* sp = S + (it * 4 + rr) * 128 + t * 8; f32x4 a = *(const f32x4*)sp, b = *(const f32x4*)(sp + 4);
            if (cpart) {
#pragma unroll 1
                for (int k = 1; k < 8; ++k) { a += *(const f32x4*)(sp + (size_t)k * MC * DM); b += *(const f32x4*)(sp + (size_t)k * MC * DM + 4); } }
            unsigned key[8];
#pragma unroll
            for (int e = 0; e < 4; ++e) { key[e] = (okey(a[e]) & 0xFFFFFF80u) | (unsigned)(t * 8 + e); key[4 + e] = (okey(b[e]) & 0xFFFFFF80u) | (unsigned)(t * 8 + 4 + e); }
            selL[it * 64 + lane] = top16_row<8>(key, t); }
#pragma unroll
        for (int pass = 0; pass < 2; ++pass) { const int hd = pass * 4 + rr; const LAS unsigned* s1 = selL + (hd >> 1) * 64 + (hd & 1) * 32; const LAS unsigned* s2 = s1 + 16;
            unsigned key[4];
#pragma unroll
            for (int e = 0; e < 4; ++e) { const unsigned ij = tabL[t * 4 + e]; if (ij != 255u) { const float v = oval(s1[ij >> 4] & 0xFFFFFF80u) + oval(s2[ij & 15u] & 0xFFFFFF80u); key[e] = (okey(v) & 0xFFFFFF00u) | ij; } else key[e] = 1u + e; }
            const unsigned ks = top16_row<4>(key, t);
            const int i = (ks >> 4) & 15, j = ks & 15; const unsigned k1 = s1[i], k2 = s2[j];
            const float sc = oval(k1 & 0xFFFFFF80u) + oval(k2 & 0xFFFFFF80u);
            const float mx = row_max16_f(sc); const float ex = __expf(sc - mx); const float sm = row_sum16_f(ex);
            eidL[hd * 16 + t] = (k1 & 127u) * 128u + (k2 & 127u); gwL[hd * 16 + t] = ex / sm;
            }
        v32f_t hf;
        { const bf16_t* hr = F.bf(WS_HN) + (size_t)row * DM + lane * 32;
#pragma unroll
          for (int h = 0; h < 4; ++h) { const u32x4 v = *(const u32x4*)(hr + h * 8);
              hf[h * 8 + 0] = bflo(v[0]); hf[h * 8 + 1] = bfhi(v[0]); hf[h * 8 + 2] = bflo(v[1]); hf[h * 8 + 3] = bfhi(v[1]);
              hf[h * 8 + 4] = bflo(v[2]); hf[h * 8 + 5] = bfhi(v[2]); hf[h * 8 + 6] = bflo(v[3]); hf[h * 8 + 7] = bfhi(v[3]); } }
        v32f_t acc;
#pragma unroll
        for (int i = 0; i < 32; ++i) acc[i] = 0.f;
        if constexpr (PEER_UBITS == 4 && PEER_VBITS == 4) {
            f32x2 acc2[16];
#pragma unroll
            for (int i = 0; i < 16; ++i) acc2[i] = (f32x2){0.f, 0.f};
            u32x4 hb1, hb2;
            { auto enc4 = [](float y) -> unsigned { const float ay = fabsf(y);
                  unsigned code = ay < 0.25f ? 0u : ay < 0.75f ? 1u : ay < 1.25f ? 2u : ay < 1.75f ? 3u : ay < 2.5f ? 4u : ay < 3.5f ? 5u : ay < 5.0f ? 6u : 7u; return code | (y < 0.f ? 8u : 0u); };
#define PEER_RES(k2) do { const f32x2 d = __builtin_amdgcn_cvt_scalef32_pk_f32_fp4(w, 1.0f, k2); \
        v |= enc4((hf[q * 8 + 2 * k2] - d[0]) * 8.f) << (8 * k2); v |= enc4((hf[q * 8 + 2 * k2 + 1] - d[1]) * 8.f) << (8 * k2 + 4); } while (0)
#pragma unroll
              for (int q = 0; q < 4; ++q) { unsigned w = 0u;
#pragma unroll
                  for (int e = 0; e < 8; ++e) w |= enc4(hf[q * 8 + e]) << (4 * e);
                  unsigned v = 0u; PEER_RES(0); PEER_RES(1); PEER_RES(2); PEER_RES(3);
                  hb1[q] = w; hb2[q] = v; }
#undef PEER_RES
            }
            int sA = 0x79797979, sB1 = 0x7F7F7F7F, sB2 = 0x7C7C7C7C; asm volatile("" : "+v"(sA), "+v"(sB1), "+v"(sB2));
            const bool ondiag = (lane >> 4) == ((lane & 15) >> 2); const int di = lane & 3;
#define PEER_DEC4(w_, k_) __builtin_amdgcn_cvt_scalef32_pk_f32_fp4((w_), 1.0f, (k_))
            for (int kb = 0; kb < 16; ++kb) {
                u32x4 bu[8], bv[8]; float gq[8], dd[8];
#pragma unroll
                for (int m = 0; m < 8; ++m) { const unsigned e = (unsigned)__builtin_amdgcn_readfirstlane((int)eidL[kb * 8 + m]); gq[m] = gwL[kb * 8 + m];
                    bu[m] = *(const u32x4*)(PU + (size_t)e * PEER_UROWB + lane * 16); bv[m] = *(const u32x4*)(PV + (size_t)e * PEER_VROWB + lane * 16); }
                f32x4 dm[8];
#pragma unroll
                for (int m = 0; m < 8; ++m) { dm[m] = (f32x4){0.f, 0.f, 0.f, 0.f};
                    asm volatile("v_mfma_scale_f32_16x16x128_f8f6f4 %0, %1, %2, %0, %3, %4 op_sel_hi:[0,0,0] cbsz:4 blgp:4" : "+v"(dm[m]) : "v"(bu[m]), "v"(hb1), "v"(sA), "v"(sB1)); }
#pragma unroll
                for (int m = 0; m < 8; ++m)
                    asm volatile("v_mfma_scale_f32_16x16x128_f8f6f4 %0, %1, %2, %0, %3, %4 op_sel_hi:[0,0,0] cbsz:4 blgp:4" : "+v"(dm[m]) : "v"(bu[m]), "v"(hb2), "v"(sA), "v"(sB2));
                __builtin_amdgcn_sched_barrier(0); asm volatile("s_nop 15\n\ts_nop 7" ::: "memory"); __builtin_amdgcn_sched_barrier(0);
#pragma unroll
                for (int m = 0; m < 8; ++m) { float x = dm[m][0]; x = di == 1 ? dm[m][1] : x; x = di == 2 ? dm[m][2] : x; x = di == 3 ? dm[m][3] : x;
                    dd[m] = wave_sum_dpp(ondiag ? x : 0.f); }
                float x = dd[0];
#pragma unroll
                for (int m = 1; m < 8; ++m) x = ((lane & 7) == m) ? dd[m] : x;
                const float gl = gelu_erf(x * 0.70710678118654752f) * 0.5f;
#pragma unroll
                for (int m = 0; m < 8; ++m) { const float cf = gq[m] * __int_as_float(__builtin_amdgcn_readlane(__float_as_int(gl), m)); const f32x2 cf2 = {cf, cf};
#pragma unroll
                    for (int q = 0; q < 4; ++q) { const unsigned w = bv[m][q];
                        acc2[q * 4 + 0] = PEER_DEC4(w, 0) * cf2 + acc2[q * 4 + 0]; acc2[q * 4 + 1] = PEER_DEC4(w, 1) * cf2 + acc2[q * 4 + 1];
                        acc2[q * 4 + 2] = PEER_DEC4(w, 2) * cf2 + acc2[q * 4 + 2]; acc2[q * 4 + 3] = PEER_DEC4(w, 3) * cf2 + acc2[q * 4 + 3]; } }
            }
#undef PEER_DEC4
#pragma unroll
            for (int i = 0; i < 16; ++i) { acc[2 * i] = acc2[i][0]; acc[2 * i + 1] = acc2[i][1]; }
        } else
        for (int kb = 0; kb < 16; ++kb) {
            u32x4 ua[8], va[8]; u32x2 ub[8], vb[8]; float gk[8];
#pragma unroll
            for (int m = 0; m < 8; ++m) { const unsigned e = (unsigned)__builtin_amdgcn_readfirstlane((int)eidL[kb * 8 + m]); gk[m] = gwL[kb * 8 + m];
                const unsigned char* up = PU + (size_t)e * PEER_UROWB; const unsigned char* vp = PV + (size_t)e * PEER_VROWB;
                ua[m] = *(const u32x4*)(up + lane * 16); if (PEER_UBITS == 6) ub[m] = *(const u32x2*)(up + 1024 + lane * 8);
                va[m] = *(const u32x4*)(vp + lane * 16); if (PEER_VBITS == 6) vb[m] = *(const u32x2*)(vp + 1024 + lane * 8); }
#pragma unroll
            for (int m = 0; m < 8; ++m) {
                v32f_t du;
                if (PEER_UBITS == 6) { v6u_t pk; pk[0] = ua[m][0]; pk[1] = ua[m][1]; pk[2] = ua[m][2]; pk[3] = ua[m][3]; pk[4] = ub[m][0]; pk[5] = ub[m][1]; du = __builtin_amdgcn_cvt_scalef32_pk32_f32_fp6(pk, 1.0f); }
                else {
#pragma unroll
                    for (int q = 0; q < 4; ++q) { const f32x2 t0 = __builtin_amdgcn_cvt_scalef32_pk_f32_fp4(ua[m][q], 1.0f, 0), t1 = __builtin_amdgcn_cvt_scalef32_pk_f32_fp4(ua[m][q], 1.0f, 1);
                        const f32x2 t2 = __builtin_amdgcn_cvt_scalef32_pk_f32_fp4(ua[m][q], 1.0f, 2), t3 = __builtin_amdgcn_cvt_scalef32_pk_f32_fp4(ua[m][q], 1.0f, 3);
                        du[q * 8 + 0] = t0[0]; du[q * 8 + 1] = t0[1]; du[q * 8 + 2] = t1[0]; du[q * 8 + 3] = t1[1]; du[q * 8 + 4] = t2[0]; du[q * 8 + 5] = t2[1]; du[q * 8 + 6] = t3[0]; du[q * 8 + 7] = t3[1]; } }
                float d0 = 0.f, d1 = 0.f;
#pragma unroll
                for (int i = 0; i < 32; i += 2) { d0 = fmaf(du[i], hf[i], d0); d1 = fmaf(du[i + 1], hf[i + 1], d1); }
                const float d = wave_sum_dpp(d0 + d1) * 0.011048543456039806f;
                const float cf = gk[m] * gelu_erf(d) * 0.5f;
                if (PEER_VBITS == 6) { v6u_t pk; pk[0] = va[m][0]; pk[1] = va[m][1]; pk[2] = va[m][2]; pk[3] = va[m][3]; pk[4] = vb[m][0]; pk[5] = vb[m][1];
                    const v32f_t dv = __builtin_amdgcn_cvt_scalef32_pk32_f32_fp6(pk, 1.0f);
#pragma unroll
                    for (int i = 0; i < 32; ++i) acc[i] = fmaf(dv[i], cf, acc[i]); }
                else {
#pragma unroll
                    for (int q = 0; q < 4; ++q)
#pragma unroll
                        for (int k = 0; k < 4; ++k) { const f32x2 t = k == 0 ? __builtin_amdgcn_cvt_scalef32_pk_f32_fp4(va[m][q], 1.0f, 0) : k == 1 ? __builtin_amdgcn_cvt_scalef32_pk_f32_fp4(va[m][q], 1.0f, 1)
                                : k == 2 ? __builtin_amdgcn_cvt_scalef32_pk_f32_fp4(va[m][q], 1.0f, 2) : __builtin_amdgcn_cvt_scalef32_pk_f32_fp4(va[m][q], 1.0f, 3);
                            acc[q * 8 + k * 2] = fmaf(t[0], cf, acc[q * 8 + k * 2]); acc[q * 8 + k * 2 + 1] = fmaf(t[1], cf, acc[q * 8 + k * 2 + 1]); } } }
        }
        const int v = row < ML ? (row >> 13) : 2;
        const float* g2 = F.mod(l, v, 5);
        float* xr = F.f32(WS_XR) + (size_t)row * DM + lane * 32; float ss = 0.f;
        float xo[32];
#pragma unroll
        for (int q = 0; q < 8; ++q) { const f32x4 xv = *(const f32x4*)(xr + q * 4), gv = *(const f32x4*)(g2 + lane * 32 + q * 4); f32x4 ov;
#pragma unroll
            for (int e = 0; e < 4; ++e) { ov[e] = xv[e] + gv[e] * acc[q * 4 + e]; xo[q * 4 + e] = ov[e]; ss += ov[e] * ov[e]; }
            if (!dry) *(f32x4*)(xr + q * 4) = ov; }
        ss = wave_sum(ss);
        if (dry) { if (lane == 0) F.f32(WS_DIAG)[512 + (row & 255)] = ss; continue; }
        const float rs = rsqrtf(ss * (1.0f / DM) + 1e-6f);
        if (l == 0) {
            const float* gn = F.inp(I_GN1) + DM + lane * 32; const float* sh = F.mod(1, v, 0) + lane * 32; const float* sc = F.mod(1, v, 1) + lane * 32;
#pragma unroll
            for (int h = 0; h < 4; ++h) { float o[8];
#pragma unroll
                for (int q = 0; q < 2; ++q) { const f32x4 gv = *(const f32x4*)(gn + h * 8 + 4 * q), sv = *(const f32x4*)(sc + h * 8 + 4 * q), tv = *(const f32x4*)(sh + h * 8 + 4 * q);
#pragma unroll
                    for (int e = 0; e < 4; ++e) o[4 * q + e] = (xo[h * 8 + 4 * q + e] * rs * gv[e]) * (1.0f + sv[e]) + tv[e]; }
                int p0 = 0, p1 = 0; p0 = __builtin_amdgcn_cvt_pk_fp8_f32(o[0], o[1], p0, false);
                p0 = __builtin_amdgcn_cvt_pk_fp8_f32(o[2], o[3], p0, true);
                p1 = __builtin_amdgcn_cvt_pk_fp8_f32(o[4], o[5], p1, false); p1 = __builtin_amdgcn_cvt_pk_fp8_f32(o[6], o[7], p1, true);
                *(u32x2*)(F.ws + WS_HN8 + (size_t)row * DM + lane * 32 + h * 8) = (u32x2){(unsigned)p0, (unsigned)p1}; }
        } else if (row < ML) {
            const float* gf = F.inp(I_GFIN) + lane * 32; float* orow = F.out + (size_t)row * DM + lane * 32;
#pragma unroll
            for (int q = 0; q < 8; ++q) { const f32x4 gv = *(const f32x4*)(gf + q * 4); f32x4 ov;
#pragma unroll
                for (int e = 0; e < 4; ++e) ov[e] = xo[q * 4 + e] * rs * gv[e];
                *(f32x4*)(orow + q * 4) = ov; }
        }
    }
}
}

constexpr int PH_PRE = 2, PH_PER_LAYER = 13, NPHASES = PH_PRE + PH_PER_LAYER * DEPTH;
static_assert(offsetof(Args, out) == 240 && offsetof(Args, ws) == 248, "Ctx::fresh reads out / ws from the argument block");
__global__ void __launch_bounds__(NTHREADS, 2) mk_fwd(Args a) {
    extern __shared__ __attribute__((aligned(16))) unsigned char shm[];
    Ctx F; F.lds = (LAS unsigned char*)shm; F.G = gridDim.x; F.bid = blockIdx.x; F.wv = __builtin_amdgcn_readfirstlane((int)threadIdx.x >> 6); F.fresh();
    LAS unsigned char* lds = F.lds;
    volatile LAS unsigned* xbw = (volatile LAS unsigned*)(lds + LDS_BYTES - 16);
    if (F.tid == 0) { xbw[0] = 0u; xbw[1] = 0u; xbw[2] = 0u; xbw[3] = 0u; }
    __syncthreads();
    XcdBarrier bar; bar.bar = (unsigned*)(a.ws + WS_BAR); bar.x = 0; bar.st = xbw;
    const int lo = a.ph_lo, hi = a.ph_hi;
    if (hi - lo > 1) bar = xcd_barrier_post((unsigned*)(a.ws + WS_BAR), xbw, F.tid);
#ifndef MK_PHMASK
#define MK_PHMASK 0xFFFF
#endif
#define PHON(j) ((MK_PHMASK >> (j)) & 1)
#ifndef MK_REP
#define MK_REP -1
#endif
#define REPS(j) for (int rep_ = 0; rep_ < (MK_REP == (j) ? 2 : 1); ++rep_)
#define IN(k) (F.fresh(), (lo <= (k) && (k) < hi))
#define SEAM(k) do { if (IN(k) && IN((k) + 1)) { xcd_barrier(bar, F.tid); if (MK_REP == 99) xcd_barrier(bar, F.tid); } } while (0)

    if (IN(0) && PHON(13)) REPS(100) { p0_prologue(F); } SEAM(0);
    if (IN(1)) { pg8::Gemm g{256, DM, 256, F.wid};
        pg8::SchedWsc S{F.G, F.bid, (const char*)F.bf(WS_KB), (const char*)F.bf(WS_WPQ)};
        pg8::EpiBf16 E{F.bf(WS_WSC), DM, 8, (size_t)DM * DM};
        pg8::gemm_phase(lds, g, S, E); } SEAM(1);

    for (int l = 0; l < DEPTH; ++l) {
        const int pb = PH_PRE + PH_PER_LAYER * l;
        const int nMa = l == 0 ? MT / 256 : ML / 256;
        const int nrows_a = l == 0 ? MT : ML;
        if (IN(pb + 0) && PHON(0)) { if (l == 0) norm_rows(F, F.inp(I_X), F.inp(I_CTX), F.inp(I_GN1), 0, 0, 1, MT, true, nullptr, nullptr, nullptr, false); } if (l == 0 || hi - lo == 1) SEAM(pb + 0);
        if (IN(pb + 1) && PHON(1)) REPS(1) {
            pg8::Gemm g{DM, DM, DM, F.wid};
            pg8::Sched S{MT / 256, ZLD / 256, F.G, F.bid, (const char*)(F.ws + WS_HN8), (const char*)(F.ws + WS_WIN + (size_t)l * ZLD * DM), (size_t)256 * DM, (size_t)256 * DM, 1 << 20, 0};
            pg8::EpiBf16 E{F.bf(WS_Z), ZLD, 1 << 20, 0};
            pg8::gemm_phase<pg8::EpiBf16, pg8::Sched, 1>(lds, g, S, E);
        } SEAM(pb + 1);
        if (IN(pb + 2) && PHON(2)) { z_post_rows(F, l); REPS(20) fnet::phase_s1_ctx(F, l == 0); } SEAM(pb + 2);
        if (IN(pb + 3) && PHON(3)) REPS(3) {
            { pg8::Gemm g{512, 512, 512, F.wid};
              pg8::Sched S{MT / 256, 3, F.G, F.bid, (const char*)(F.ws + WS_QL8), (const char*)(F.ws + WS_WUQ + (size_t)l * 768 * 512), (size_t)256 * 512, (size_t)256 * 512, 1 << 20, 0};
              pg8::EpiBf16 E{F.bf(WS_Q), 768, 1 << 20, 0};
              pg8::gemm_phase<pg8::EpiBf16, pg8::Sched, 1>(lds, g, S, E); }
            { pg8::Gemm g{256, 256, 256, F.wid};
              pg8::Sched S{MT / 256, 4, F.G, (F.bid + 26) % F.G, (const char*)(F.ws + WS_KVL8), (const char*)(F.ws + WS_WUKV + (size_t)l * 1024 * 256), (size_t)256 * 256, (size_t)256 * 256, 1 << 20, 0};
              pg8::EpiKV E{F.bf(WS_KV), F.ws + WS_K8};
              pg8::gemm_phase<pg8::EpiKV, pg8::Sched, 1>(lds, g, S, E); }
            conv_units(F, l);
        } SEAM(pb + 3);
        if (IN(pb + 4) && PHON(4)) {
            v8t_build(F); xcd_barrier(bar, F.tid); F.fresh();
            const int nu = l == 0 ? 256 + 8 : 256;
            for (int u = F.bid; u < (MK_REP == 4 ? 2 : 1) * 512; u += F.G) { const int uu_ = u & 511; if (uu_ < nu) att::attn_unit<0>(F, l, (uu_ & 7) >> 2, uu_ & 3, uu_ >> 3); }
            for (int u = (F.bid + 248) % F.G; u < (MK_REP == 40 ? 2 : 1) * 512; u += F.G) { const int uu_ = u & 511; if (uu_ < nu) att::attn_unit<1>(F, l, (uu_ & 7) >> 2, uu_ & 3, uu_ >> 3); }
            REPS(41) fnet::phase_s3(F);
        } SEAM(pb + 4);
        if (IN(pb + 5) && PHON(5)) REPS(5) {
            { pg8::Gemm g{1024, 1024, 1024, F.wid};
              pg8::Sched S{nMa, 2, F.G, F.bid, (const char*)(F.ws + WS_X), (const char*)(F.ws + WS_WDFT), (size_t)256 * 1024, (size_t)256 * 1024, 1 << 20, 0};
              pg8::EpiFp8 E{F.ws + WS_BR + (size_t)3 * MT * 512, 512, 1 << 20, 0};
              pg8::gemm_phase<pg8::EpiFp8, pg8::Sched, 1>(lds, g, S, E); }
            { pg8::Gemm g{512, 512, 512, F.wid};
              pg8::Sched S{nMa, 24, F.G, (F.bid + 76) % F.G, (const char*)(F.ws + WS_BR), (const char*)(F.ws + WS_WB + (size_t)l * 4 * DM * 512), (size_t)256 * 512, (size_t)256 * 512, 8, (size_t)MT * 512, 0x79797979};
              pg8::EpiFp8 E{F.ws + WS_T, DM, 8, (size_t)MT * DM};
              pg8::gemm_phase<pg8::EpiFp8, pg8::Sched, 1>(lds, g, S, E); }
        } SEAM(pb + 5);
        if (IN(pb + 6) && PHON(6)) REPS(6) {
            { pg8::Gemm g{512, 512, 512, F.wid};
              pg8::Sched S{nMa, 8, F.G, F.bid, (const char*)(F.ws + WS_BR + (size_t)3 * MT * 512), (const char*)(F.ws + WS_WB + ((size_t)l * 4 + 3) * DM * 512), (size_t)256 * 512, (size_t)256 * 512, 1 << 20, 0};
              pg8::EpiFp8 E{F.ws + WS_T + (size_t)3 * MT * DM, DM, 1 << 20, 0};
              pg8::gemm_phase<pg8::EpiFp8, pg8::Sched, 1>(lds, g, S, E); }
        }
        SEAM(pb + 6);
        if (IN(pb + 7) && PHON(7)) REPS(7) {
            pg8::Gemm g{DM, DM, DM, F.wid};
            pg8::SchedGate S{ML / 256, F.G, F.bid, (const char*)(F.ws + WS_HN8), (const char*)(F.ws + WS_WG + (size_t)l * 4 * DM * DM), (size_t)256 * DM, (size_t)256 * DM};
            pg8::EpiGate E{F.ws + WS_T, (size_t)MT * DM, (u32x4*)(F.ws + WS_BR) + (size_t)F.bid * 16 * NTHREADS, F.ws + WS_Y};
            pg8::gemm_phase<pg8::EpiGate, pg8::SchedGate, 1>(lds, g, S, E);
            if (l == 0) {
                pg8::SchedGateCtx S2{F.G, F.bid, (const char*)(F.ws + WS_HN8), (const char*)(F.ws + WS_WG + (size_t)l * 4 * DM * DM), (size_t)256 * DM, (size_t)256 * DM};
                pg8::EpiGateCtx E2{F.ws + WS_T, (size_t)MT * DM, F.bf(WS_YC)};
                pg8::gemm_phase<pg8::EpiGateCtx, pg8::SchedGateCtx, 1>(lds, g, S2, E2); }
        } SEAM(pb + 7);
        if (IN(pb + 8) && PHON(8)) { if (l == 0) { const bf16_t* yc = F.bf(WS_YC); unsigned char* y = F.ws + WS_Y + (size_t)ML * DM;
                for (size_t i = (size_t)F.bid * NTHREADS + F.tid; i < (size_t)MC * DM / 8; i += (size_t)F.G * NTHREADS) { float sacc[8] = {0.f, 0.f, 0.f, 0.f, 0.f, 0.f, 0.f, 0.f};
#pragma unroll
                    for (int n = 0; n < 4; ++n) { const u32x4 v = *(const u32x4*)(yc + (size_t)n * MC * DM + i * 8);
                        sacc[0] += bflo(v.x); sacc[1] += bfhi(v.x); sacc[2] += bflo(v.y); sacc[3] += bfhi(v.y); sacc[4] += bflo(v.z); sacc[5] += bfhi(v.z); sacc[6] += bflo(v.w); sacc[7] += bfhi(v.w); }
                    int p0 = 0, p1 = 0; p0 = __builtin_amdgcn_cvt_pk_fp8_f32(sacc[0], sacc[1], p0, false); p0 = __builtin_amdgcn_cvt_pk_fp8_f32(sacc[2], sacc[3], p0, true);
                    p1 = __builtin_amdgcn_cvt_pk_fp8_f32(sacc[4], sacc[5], p1, false); p1 = __builtin_amdgcn_cvt_pk_fp8_f32(sacc[6], sacc[7], p1, true);
                    *(u32x2*)(y + i * 8) = (u32x2){(unsigned)p0, (unsigned)p1}; } } } if (l == 0 || hi - lo == 1) SEAM(pb + 8);
        if (IN(pb + 9) && PHON(9)) REPS(9) {
            pg8::Gemm g{DM, DM, DM, F.wid};
            pg8::Sched S{ML / 256, 8, F.G, F.bid, (const char*)(F.ws + WS_Y), (const char*)(F.ws + WS_WO + (size_t)l * DM * DM), (size_t)256 * DM, (size_t)256 * DM, 1 << 20, 0};
            pg8::EpiResGate E{F.f32(WS_XR), l == 0 ? F.inp(I_X) : F.f32(WS_XR), l == 0 ? F.inp(I_CTX) : F.f32(WS_XR) + (size_t)ML * DM, F.mod(l, 0, 2), F.mod(l, 2, 2)};
            pg8::gemm_phase<pg8::EpiResGate, pg8::Sched, 1>(lds, g, S, E);
            if (l == 0) {
                pg8::Gemm g2{DM, DM, 256, F.wid};
                pg8::SchedKSplit S2{F.G, F.bid, (const char*)(F.ws + WS_Y), (const char*)(F.ws + WS_WO), (size_t)256 * DM, (size_t)256 * DM, 256};
                pg8::EpiPart E2{F.f32(WS_PART)};
                pg8::gemm_phase<pg8::EpiPart, pg8::SchedKSplit, 1>(lds, g2, S2, E2); }
        } SEAM(pb + 9);
        if (IN(pb + 10) && PHON(10)) REPS(10) { if (l == 0) norm_rows(F, F.f32(WS_XR), F.inp(I_CTX), F.inp(I_GN2), 0, 3, 4, MT, false, F.f32(WS_PART), F.mod(0, 2, 2), F.f32(WS_XR) + (size_t)ML * DM);
            else norm_rows(F, F.f32(WS_XR), F.f32(WS_XR) + (size_t)ML * DM, F.inp(I_GN2) + l * DM, l, 3, 4, nrows_a, false); } SEAM(pb + 10);
        if (IN(pb + 11) && PHON(11)) REPS(11) {
            pg8::Gemm g{DM, DM, DM, F.wid};
            pg8::Sched S{ML / 256, 8, F.G, F.bid, (const char*)F.bf(WS_HN), (const char*)(F.bf(WS_WSC) + (size_t)l * DM * DM), (size_t)256 * DM * 2, (size_t)256 * DM * 2, 1 << 20, 0};
            pg8::EpiF32 E{F.f32(WS_S), DM};
            pg8::gemm_phase(lds, g, S, E);
            if (l == 0) {
                pg8::Gemm g2{DM, DM, 256, F.wid};
                pg8::SchedKSplit S2{F.G, F.bid, (const char*)F.bf(WS_HN), (const char*)F.bf(WS_WSC), (size_t)256 * DM * 2, (size_t)256 * DM * 2, 512};
                pg8::EpiPart E2{F.f32(WS_PART)};
                pg8::gemm_phase<pg8::EpiPart, pg8::SchedKSplit, 2>(lds, g2, S2, E2); }
        } SEAM(pb + 11);
        if (IN(pb + 12) && PHON(12)) REPS(13) { peer::peer_rows(F, l, nrows_a, MK_REP == 13 && rep_ == 0); } SEAM(pb + 12);
    }
#undef IN
#undef SEAM
}

#if MK_DIAG
__device__ __forceinline__ void dacc(float* dg, int c, float err, float ref) { atomicAdd(dg + 2 * c, err * err); atomicAdd(dg + 2 * c + 1, ref * ref); }
__device__ __forceinline__ unsigned hsh(unsigned x) { x ^= x >> 16; x *= 0x7feb352dU; x ^= x >> 15; x *= 0x846ca68bU; x ^= x >> 16; return x; }
__device__ float ddot_bf(const bf16_t* a, const bf16_t* b, int K) { float s = 0.f; for (int k = 0; k < K; ++k) s += bf2f(a[k]) * bf2f(b[k]); return s; }
__global__ void __launch_bounds__(256) k_diag(Args a) {
    Ctx F; F.fresh(); F.G = gridDim.x; F.bid = blockIdx.x;
    float* dg = F.f32(WS_DIAG);
    const unsigned gt = blockIdx.x * 256 + threadIdx.x, gn = gridDim.x * 256;
#if MK_DIAG == 1
    for (unsigned i = gt; i < 4096; i += gn) { const unsigned h = hsh(i * 7 + 1); const int n = h % DIN, k = (h >> 12) % DM;
        dacc(dg, 0, bf2f(F.bf(WS_WIN)[((size_t)1 * ZLD + n) * DM + k]) - F.inp(I_WIN)[((size_t)1 * DM + k) * DIN + n], F.inp(I_WIN)[((size_t)1 * DM + k) * DIN + n]);
        const int n2 = h % DM, slot = (h >> 28) & 3, br = (0x1320 >> (4 * slot)) & 3;
        dacc(dg, 0, bf2f(F.bf(WS_WG)[(((size_t)1 * 4 + slot) * DM + n2) * DM + k]) - F.inp(I_WGATE)[(((size_t)1 * 4 + br) * DM + k) * DM + n2], F.inp(I_WGATE)[(((size_t)1 * 4 + br) * DM + k) * DM + n2]);
        const int k5 = k & 511;
        dacc(dg, 0, bf2f(F.bf(WS_WB)[(((size_t)1 * 4 + slot) * DM + n2) * 512 + k5]) - F.inp(I_WBR)[(((size_t)1 * 4 + br) * 512 + k5) * DM + n2], F.inp(I_WBR)[(((size_t)1 * 4 + br) * 512 + k5) * DM + n2]); }
    for (unsigned i = gt; i < 384; i += gn) { const unsigned h = hsh(i * 13 + 5); const int l = i & 1, v = (i >> 1) % 3, j = h % (6 * DM);
        float s = F.inp(I_BADA)[l * 6 * DM + j];
        for (int k = 0; k < DM; ++k) { const float x = v < 2 ? F.inp(I_C)[v * DM + k] : F.inp(I_CCTX)[k]; s += x / (1.0f + expf(-x)) * F.inp(I_WADA)[((size_t)l * DM + k) * 6 * DM + j]; }
        dacc(dg, 1, F.f32(WS_MOD)[(size_t)(l * 3 + v) * 6 * DM + j] - s, s); }
    for (unsigned i = gt; i < 64 * 256; i += gn) { const int rs = i >> 8, c8 = (i & 255) * 8; const int row = rs < 48 ? (hsh(rs * 3 + 2) % ML) : ML + (hsh(rs) % MC);
        const float* xr = row < ML ? F.inp(I_X) + (size_t)row * DM : F.inp(I_CTX) + (size_t)(row - ML) * DM; const int v = row < ML ? row >> 13 : 2;
        float ss = 0.f; for (int k = 0; k < DM; ++k) ss += xr[k] * xr[k]; const float r = rsqrtf(ss / DM + 1e-6f);
        for (int e = 0; e < 8; ++e) { const int c = c8 + e; const float ref = xr[c] * r * F.inp(I_GN1)[c] * (1.0f + F.mod(0, v, 1)[c]) + F.mod(0, v, 0)[c];
            dacc(dg, 2, bf2f(F.bf(WS_HN)[(size_t)row * DM + c]) - ref, ref); } }
    for (unsigned i = gt; i < 2048; i += gn) { const unsigned h = hsh(i * 11 + 3); const int row = h % MT, col = (h >> 15) % ZLD;
        const float ref = ddot_bf(F.bf(WS_HN) + (size_t)row * DM, F.bf(WS_WIN) + (size_t)col * DM, DM);
        dacc(dg, 3, bf2f(F.bf(WS_Z)[(size_t)row * ZLD + col]) - ref, ref + 1e-3f); }
#endif
#if MK_DIAG == 2
    __shared__ float sh[8448 + 64];
    for (unsigned i = gt; i < 16 * 9 * 32; i += gn) { const int d = i & 31, vi = (i >> 5) % 9, rs = i / (9 * 32); const int row = hsh(rs * 5 + 1) % ML; const int pos = row & (SEQ - 1);
        const int col = vi == 0 ? ZC_KROPE : ZC_DK + (vi - 1) * 64;
        const float x1 = bf2f(f2bf(ddot_bf(F.bf(WS_HN) + (size_t)row * DM, F.bf(WS_WIN) + (size_t)(col + d) * DM, DM))), x2 = bf2f(f2bf(ddot_bf(F.bf(WS_HN) + (size_t)row * DM, F.bf(WS_WIN) + (size_t)(col + d + 32) * DM, DM)));
        const double inv = pow(10000.0, -(double)(d & 15) / 16.0); const double ang = (double)(d < 16 ? (pos >> 6) : (pos & 63)) * (double)(float)inv; const float c = (float)cos(ang), sn = (float)sin(ang);
        dacc(dg, 0, bf2f(F.bf(WS_Z)[(size_t)row * ZLD + col + d]) - (x1 * c - x2 * sn), x1 * c - x2 * sn + 1e-3f); dacc(dg, 0, bf2f(F.bf(WS_Z)[(size_t)row * ZLD + col + d + 32]) - (x2 * c + x1 * sn), x2 * c + x1 * sn + 1e-3f); }
    for (unsigned i = gt; i < 64; i += gn) { const int row = hsh(i * 9 + 4) % MT; float s = 0.f, s2 = 0.f;
        for (int j = 0; j < 384; ++j) { const float v = bf2f(F.bf(WS_Z)[(size_t)row * ZLD + j]) / F.inp(I_GQ)[j]; s += v * v; }
        for (int j = 0; j < 256; ++j) { const float v = bf2f(F.bf(WS_Z)[(size_t)row * ZLD + 384 + j]) / F.inp(I_GKV)[j]; s2 += v * v; }
        dacc(dg, 0, sqrtf(s / 384.f) - 1.f, 1.f); dacc(dg, 0, sqrtf(s2 / 256.f) - 1.f, 1.f); }
    for (unsigned i = gt; i < 512; i += gn) { const unsigned h = hsh(i * 3 + 11); const bool cx = i >= 448; const int b = h & 1, c = (h >> 1) & 511; const int L = cx ? CTXL : SEQ; const int k = (h >> 10) % L;
        const int rb = cx ? ML + b * CTXL : b * SEQ; double re = 0, im = 0;
        for (int n = 0; n < L; ++n) { const double f = bf2f(F.bf(WS_Z)[(size_t)(rb + n) * ZLD + ZC_F + c]); const double a = -2.0 * 3.14159265358979323846 * (double)((n * k) % L) / L; re += f * cos(a); im += f * sin(a); }
        const double nr = 1.0 / sqrt((double)L * 128.0);
        dacc(dg, 1, bf2f(F.bf(WS_X)[(size_t)(rb + k) * 1024 + c]) - (float)(re * nr), (float)(re * nr)); dacc(dg, 1, bf2f(F.bf(WS_X)[(size_t)(rb + k) * 1024 + 512 + c]) - (float)(im * nr), (float)(im * nr)); }
    for (unsigned i = gt; i < 1024; i += gn) { const unsigned h = hsh(i * 17 + 2); const int row = h % MT;
        { const int col = (h >> 15) % 768; const float ref = ddot_bf(F.bf(WS_Z) + (size_t)row * ZLD + ZC_QLAT, F.bf(WS_WUQ) + (size_t)col * 384, 384); dacc(dg, 2, bf2f(F.bf(WS_Q)[(size_t)row * 768 + col]) - ref, ref + 1e-3f); }
        { const int col = (h >> 15) % 1024; const float ref = ddot_bf(F.bf(WS_Z) + (size_t)row * ZLD + ZC_KVLAT, F.bf(WS_WUKV) + (size_t)col * 256, 256); dacc(dg, 2, bf2f(F.bf(WS_KV)[(size_t)row * 1024 + col]) - ref, ref + 1e-3f); } }
    for (unsigned i = gt; i < 24 * 128; i += gn) { const int ch = i & 127, sm = i >> 7; const unsigned h = hsh(sm * 7 + 3); const int grp = h & 3; const bool cx = sm >= 20;
        const int L = cx ? CTXL : SEQ; const int b = (h >> 2) & 1; int n = (h >> 3) % L; if (sm == 0) n = 3; if (sm == 1) n = L - 2; const int rb = cx ? ML + b * CTXL : b * SEQ;
        auto cv = [&](int cg) { float acc = F.inp(I_BDW)[cg];
            for (int j = 0; j < 31; ++j) { const int nn = n + j - 15; if (nn < 0 || nn >= L) continue; const float a = bf2f(F.bf(WS_Z)[(size_t)(rb + nn) * ZLD + ZC_C + cg]), g = bf2f(F.bf(WS_Z)[(size_t)(rb + nn) * ZLD + ZC_C + 512 + cg]);
                acc += a / (1.f + expf(-g)) * F.inp(I_WDW)[(size_t)j * 512 + cg]; }
            return acc; };
        float mu = 0.f; for (int c2 = 0; c2 < 128; ++c2) mu += cv(grp * 128 + c2);
        mu /= 128.f; float var = 0.f; for (int c2 = 0; c2 < 128; ++c2) { const float v = cv(grp * 128 + c2); var += (v - mu) * (v - mu); } var /= 128.f;
        const int cg = grp * 128 + ch; const float yn = (cv(cg) - mu) * rsqrtf(var + 1e-5f) * F.inp(I_GCN)[cg] + F.inp(I_BCN)[cg]; const float ref = yn / (1.f + expf(-yn));
        dacc(dg, 3, bf2f(F.bf(WS_BR)[((size_t)1 * MT + rb + n) * 512 + cg]) - ref, ref + 1e-3f); }
    if (blockIdx.x < 48) { const int md = blockIdx.x / 24, sm = blockIdx.x % 24; const unsigned h = hsh(sm * 31 + 7 + md); const bool cx = (sm % 6) == 5; const int b = h & 1, hd = (h >> 1) & 3;
        const int qi = (h >> 3) % (cx ? CTXL : SEQ); const int qrow = cx ? ML + b * CTXL + qi : b * SEQ + qi; const int nk = cx ? CTXL : CTXL + SEQ; const int t = threadIdx.x;
        float* qv = sh + 8448;
        float outv = 0.f;
        for (int comp = 0; comp < (md == 0 ? 1 : 2); ++comp) {
            __syncthreads();
            __shared__ float qf[192];
            const int qd = md == 0 ? 192 : 64;
            if (t < qd) { float v;
                if (md == 0) v = bf2f(F.bf(WS_Q)[(size_t)qrow * 768 + hd * 192 + t]); else v = bf2f(F.bf(WS_Z)[(size_t)qrow * ZLD + ZC_DQ + hd * 128 + comp * 64 + t]);
                qf[t] = v; }
            __syncthreads();
            if (!cx) { const int ro = md == 0 ? 128 : 0; if (t < 32) { const double inv = pow(10000.0, -(double)(t & 15) / 16.0); const double ang = (double)(t < 16 ? (qi >> 6) : (qi & 63)) * (double)(float)inv;
                    const float c = (float)cos(ang), sn = (float)sin(ang); const float x1 = qf[ro + t], x2 = qf[ro + t + 32]; qv[t] = bf2f(f2bf(x1 * c - x2 * sn)); qv[t + 32] = bf2f(f2bf(x2 * c + x1 * sn)); }
                __syncthreads(); if (t < 64) qf[(md == 0 ? 128 : 0) + t] = qv[t]; __syncthreads(); }
            const float scale = md == 0 ? 0.07216878364870322f : 0.125f;
            for (int k = t; k < nk; k += 256) { const int krow = k < CTXL ? ML + b * CTXL + k : b * SEQ + (k - CTXL); float s = 0.f;
                if (md == 0) { for (int d = 0; d < 128; ++d) s += qf[d] * bf2f(F.bf(WS_KV)[(size_t)krow * 1024 + hd * 256 + d]); for (int d = 0; d < 64; ++d) s += qf[128 + d] * bf2f(F.bf(WS_Z)[(size_t)krow * ZLD + ZC_KROPE + d]); }
                else for (int d = 0; d < 64; ++d) s += qf[d] * bf2f(F.bf(WS_Z)[(size_t)krow * ZLD + ZC_DK + hd * 128 + comp * 64 + d]);
                sh[k] = s * scale; }
            __syncthreads();
            __shared__ float red[256]; float mx = -1e30f; for (int k = t; k < nk; k += 256) mx = fmaxf(mx, sh[k]); red[t] = mx; __syncthreads();
            for (int o = 128; o > 0; o >>= 1) { if (t < o) red[t] = fmaxf(red[t], red[t + o]); __syncthreads(); } mx = red[0]; __syncthreads();
            float sm2 = 0.f; for (int k = t; k < nk; k += 256) { const float e = expf(sh[k] - mx); sh[k] = e; sm2 += e; } red[t] = sm2; __syncthreads();
            for (int o = 128; o > 0; o >>= 1) { if (t < o) red[t] += red[t + o]; __syncthreads(); } const float den = red[0]; __syncthreads();
            if (t < 128) { float o = 0.f; for (int k = 0; k < nk; ++k) { const int krow = k < CTXL ? ML + b * CTXL + k : b * SEQ + (k - CTXL);
                    const float v = md == 0 ? bf2f(F.bf(WS_KV)[(size_t)krow * 1024 + hd * 256 + 128 + t]) : bf2f(F.bf(WS_Z)[(size_t)krow * ZLD + ZC_DV + hd * 128 + t]); o += sh[k] * v; }
                o /= den;
                if (md == 0) outv = o; else { float lam; { float s1 = 0.f, s2 = 0.f; for (int j = 0; j < 64; ++j) { s1 += F.inp(I_LQ1)[j] * F.inp(I_LK1)[j]; s2 += F.inp(I_LQ2)[j] * F.inp(I_LK2)[j]; } lam = expf(s1) - expf(s2) + 0.2f; }
                    outv = comp == 0 ? o : outv - lam * o; } }
        }
        __syncthreads();
        if (md == 0) { if (t < 128) dacc(dg, 4, bf2f(F.bf(WS_BR)[(size_t)qrow * 512 + hd * 128 + t]) - outv, outv + 1e-4f); }
        else { __shared__ float r2[128]; if (t < 128) r2[t] = outv * outv; __syncthreads(); float ss = 0.f; if (t < 128) { for (int j = 0; j < 128; ++j) ss += r2[j];
                const float ref = outv * rsqrtf(ss / 128.f + 1e-6f) * F.inp(I_GSUB)[t] * 0.8f; dacc(dg, 5, bf2f(F.bf(WS_BR)[((size_t)2 * MT + qrow) * 512 + hd * 128 + t]) - ref, ref + 1e-4f); } }
    }
#endif
#if MK_DIAG == 3
    for (unsigned i = gt; i < 0; i += gn) { const unsigned h = hsh(i * 5 + 9); const bool cx = i >= 80; const int b = h & 1, g = (h >> 1) & 3, m = (h >> 3) & 127; const int L = cx ? CTXL : SEQ; const int k = (h >> 10) % L;
        const int rb = cx ? ML + b * CTXL : b * SEQ; double acc = 0;
        for (int n = 0; n < L; ++n) { const double p1 = (double)((n * k) % L) / L; for (int c = 0; c < 128; ++c) { const double ph = p1 + (double)((c * m) & 127) / 128.0;
                acc += (double)bf2f(F.bf(WS_Z)[(size_t)(rb + n) * ZLD + ZC_F + g * 128 + c]) * cospi(2.0 * ph); } }
        const float ref = (float)(acc / sqrt((double)L * 128.0));
        dacc(dg, 0, bf2f(F.bf(WS_BR)[((size_t)3 * MT + rb + k) * 512 + g * 128 + m]) - ref, ref + 1e-3f); }
#if MK_STOP == 7
    for (unsigned i = gt; i < 1024; i += gn) { const unsigned h = hsh(i * 37 + 12); const int row = h % MT, col = (h >> 15) % 512;
        const float ref = ddot_bf(F.bf(WS_X) + (size_t)row * 1024, F.bf(WS_WDFT) + (size_t)col * 1024, 1024);
        dacc(dg, 4, bf2f(F.bf(WS_BR)[((size_t)3 * MT + row) * 512 + col]) - ref, ref + 1e-3f); }
    for (unsigned i = gt; i < 4096; i += gn) { const unsigned h = hsh(i * 41 + 14); const int n = h % 512, kc = (h >> 12) % 1024; const int g = n >> 7, m = n & 127, part = kc >> 9, g2 = (kc >> 7) & 3, c = kc & 127;
        const float ref = g == g2 ? (part == 0 ? (float)cos(2.0 * 3.14159265358979323846 * ((c * m) & 127) / 128.0) : (float)sin(2.0 * 3.14159265358979323846 * ((c * m) & 127) / 128.0)) : 0.f;
        dacc(dg, 5, bf2f(F.bf(WS_WDFT)[(size_t)n * 1024 + kc]) - ref, ref + (g == g2 ? 0.f : 0.f)); }
    for (unsigned i = gt; i < 2048; i += gn) { const unsigned h = hsh(i * 19 + 6); const int row = h % MT, col = (h >> 15) % DM, slot = i % 3;
        const float ref = ddot_bf(F.bf(WS_BR) + ((size_t)slot * MT + row) * 512, F.bf(WS_WB) + ((size_t)slot * DM + col) * 512, 512);
        dacc(dg, 1, bf2f(F.bf(WS_T)[((size_t)slot * MT + row) * DM + col]) - ref, ref + 1e-3f); }
#else
    for (unsigned i = gt; i < 1024; i += gn) { const unsigned h = hsh(i * 23 + 8); const int row = h % MT, col = (h >> 15) % DM; float ref = 0.f;
        for (int slot = 0; slot < 4; ++slot) { const float gt_ = ddot_bf(F.bf(WS_HN) + (size_t)row * DM, F.bf(WS_WG) + ((size_t)slot * DM + col) * DM, DM);
            ref += 1.f / (1.f + expf(-gt_)) * bf2f(F.bf(WS_T)[((size_t)slot * MT + row) * DM + col]); }
        dacc(dg, 2, bf2f(F.bf(WS_Y)[(size_t)row * DM + col]) - ref, ref + 1e-3f); }
    for (unsigned i = gt; i < 1024; i += gn) { const unsigned h = hsh(i * 29 + 10); const int row = h % MT, col = (h >> 15) % DM;
        const float d = ddot_bf(F.bf(WS_Y) + (size_t)row * DM, F.bf(WS_WO) + (size_t)col * DM, DM);
        const float x = row < ML ? F.inp(I_X)[(size_t)row * DM + col] : F.inp(I_CTX)[(size_t)(row - ML) * DM + col]; const int v = row < ML ? row >> 13 : 2;
        const float ref = x + F.mod(0, v, 2)[col] * d;
        dacc(dg, 3, F.f32(WS_XR)[(size_t)row * DM + col] - ref, ref); }
#endif
#endif
#if MK_DIAG == 5
    if (blockIdx.x == 0) { const int lane = threadIdx.x & 63, t = lane & 15, rr = lane >> 4, w = threadIdx.x >> 6;
        __shared__ unsigned kk[4][64][8]; __shared__ unsigned res[4][64];
        { const float x = (float)lane * 1.5f + 1.0f + (float)w; const float sgot = wave_sum_dpp(x); const float sexp = 1.5f * 2016.f + 64.f * (1.f + (float)w); dacc(dg, 0, sgot - sexp, sexp); }
        { const unsigned x = hsh(lane * 31 + w) | 1u; const unsigned got = row_max16_u(x); unsigned ex = 0; for (int j = 0; j < 16; ++j) { const unsigned y = hsh((rr * 16 + j) * 31 + w) | 1u; ex = y > ex ? y : ex; }
          dacc(dg, 1, got == ex ? 0.f : 1.f, 1.f);
          const float xf = (float)(hsh(lane * 7 + w) & 1023); const float gs = row_sum16_f(xf); float es = 0.f; for (int j = 0; j < 16; ++j) es += (float)(hsh((rr * 16 + j) * 7 + w) & 1023); dacc(dg, 1, gs - es, es); }
        { unsigned key[8]; for (int e = 0; e < 8; ++e) { key[e] = (hsh(lane * 8 + e + w * 977) & 0xFFFFFF80u) | (unsigned)(t * 8 + e) | 0x80000000u; kk[w][lane][e] = key[e]; }
          __syncthreads();
          const unsigned got = peer::top16_row<8>(key, t);
          int rank = 0; for (int j = 0; j < 16; ++j) for (int e = 0; e < 8; ++e) if (kk[w][rr * 16 + j][e] > got) ++rank;
          bool member = false; for (int j = 0; j < 16; ++j) for (int e = 0; e < 8; ++e) if (kk[w][rr * 16 + j][e] == got) member = true;
          dacc(dg, 2, (rank == t && member) ? 0.f : 1.f, 1.f); }
        { unsigned key[4]; for (int e = 0; e < 4; ++e) { const int q = t * 4 + e; key[e] = q < 50 ? ((hsh(lane * 4 + e + w * 131) & 0xFFFFFF00u) | (unsigned)q | 0x80000000u) : 1u + e; }
          __syncthreads(); for (int e = 0; e < 4; ++e) kk[w][lane][e] = key[e]; __syncthreads();
          const unsigned got = peer::top16_row<4>(key, t);
          int rank = 0; for (int j = 0; j < 16; ++j) for (int e = 0; e < 4; ++e) if (kk[w][rr * 16 + j][e] > got) ++rank;
          dacc(dg, 3, rank == t ? 0.f : 1.f, 1.f); }
        { const float a0 = 1.5f, a1 = -2.25f, b0 = 3.0f + lane, b1 = 0.5f; const unsigned pa = cvt_pk_bf16(a0, a1), pb = cvt_pk_bf16(b0, b1);
          const float got = __builtin_amdgcn_fdot2_f32_bf16(__builtin_bit_cast(bf16x2_t, pa), __builtin_bit_cast(bf16x2_t, pb), 10.f, false); const float ex = 10.f + a0 * b0 + a1 * b1; dacc(dg, 4, got - ex, ex); }
        { const float x = (float)(lane * lane) + (float)w; const float got = half_sum_dpp(x, lane >> 5); float ex = 0.f; for (int j = 0; j < 32; ++j) { const int ll = (lane & 32) + j; ex += (float)(ll * ll) + (float)w; } dacc(dg, 5, got - ex, ex); }
    }
#endif
#if MK_DIAG == 6
    if (blockIdx.x == 0 && threadIdx.x < 64) { const int lane = threadIdx.x;
        typedef float v32f __attribute__((ext_vector_type(32))); typedef float v16f __attribute__((ext_vector_type(16))); typedef unsigned v6u __attribute__((ext_vector_type(6)));
        float x[32]; unsigned code[32];
        for (int i = 0; i < 32; ++i) { const unsigned h = hsh(lane * 32 + i); const unsigned c = h & 63u; code[i] = c; const int sgn = (c >> 5) & 1, e = (c >> 3) & 3, m = c & 7;
            const float mag = e == 0 ? (float)m * 0.125f : (float)(1 << (e - 1)) * (1.0f + (float)m * 0.125f); x[i] = sgn ? -mag : mag; }
        unsigned long long lo = 0, mid = 0, hi = 0;
        unsigned w[6] = {0, 0, 0, 0, 0, 0};
        for (int i = 0; i < 32; ++i) { const int bit = 6 * i; const int d = bit >> 5, o = bit & 31; w[d] |= code[i] << o; if (o > 26) w[d + 1] |= code[i] >> (32 - o); }
        (void)lo; (void)mid; (void)hi;
        v6u pk; for (int d = 0; d < 6; ++d) pk[d] = w[d];
        const v32f dec = __builtin_amdgcn_cvt_scalef32_pk32_f32_fp6(pk, 1.0f);
        for (int i = 0; i < 32; ++i) dacc(dg, 0, dec[i] - x[i], fabsf(x[i]) + 0.1f);
        v16f a, b; for (int i = 0; i < 16; ++i) { a[i] = x[i]; b[i] = x[16 + i]; }
        const v6u enc = __builtin_amdgcn_cvt_scalef32_2xpk16_fp6_f32(a, b, 1.0f);
        const v32f dec2 = __builtin_amdgcn_cvt_scalef32_pk32_f32_fp6(enc, 1.0f);
        for (int i = 0; i < 32; ++i) dacc(dg, 1, dec2[i] - x[i], fabsf(x[i]) + 0.1f);
        for (int d = 0; d < 6; ++d) dacc(dg, 2, enc[d] == w[d] ? 0.f : 1.f, 1.f);
        v16f a2, b2; float y[32]; for (int i = 0; i < 32; ++i) { y[i] = ((float)(hsh(lane * 77 + i) & 0xFFFF) / 65536.0f - 0.5f) * 18.0f; if (i < 16) a2[i] = y[i]; else b2[i - 16] = y[i]; }
        const v32f dec3 = __builtin_amdgcn_cvt_scalef32_pk32_f32_fp6(__builtin_amdgcn_cvt_scalef32_2xpk16_fp6_f32(a2, b2, 1.0f), 1.0f);
        for (int i = 0; i < 32; ++i) { const float yc = fminf(fmaxf(y[i], -7.5f), 7.5f); const float ay = fabsf(yc); const float step = ay < 2.f ? 0.125f : ay < 4.f ? 0.25f : 0.5f;
            dacc(dg, 3, fabsf(dec3[i] - yc) <= 0.5f * step + 1e-6f ? 0.f : 1.f, 1.f); }
    }
#endif
#if MK_DIAG == 8
    if (blockIdx.x == 0) { const int t = threadIdx.x; const float lv[8] = {0.f, 0.5f, 1.f, 1.5f, 2.f, 3.f, 4.f, 6.f};
        const unsigned src = hsh(t * 7 + 3);
        f32x2 r[4]; r[0] = __builtin_amdgcn_cvt_scalef32_pk_f32_fp4(src, 1.0f, 0); r[1] = __builtin_amdgcn_cvt_scalef32_pk_f32_fp4(src, 1.0f, 1);
        r[2] = __builtin_amdgcn_cvt_scalef32_pk_f32_fp4(src, 1.0f, 2); r[3] = __builtin_amdgcn_cvt_scalef32_pk_f32_fp4(src, 1.0f, 3);
        for (int k = 0; k < 4; ++k) { const unsigned B = (src >> (8 * k)) & 255u; const unsigned lo = B & 15u, hi = B >> 4;
            const float flo = (lo & 8u ? -1.f : 1.f) * lv[lo & 7u], fhi = (hi & 8u ? -1.f : 1.f) * lv[hi & 7u];
            dacc(dg, 0, r[k][0] - flo, 1.f); dacc(dg, 0, r[k][1] - fhi, 1.f); dacc(dg, 1, r[k][0] - fhi, 1.f); dacc(dg, 1, r[k][1] - flo, 1.f); } }
#endif
#if MK_DIAG == 4
    if (blockIdx.x >= 16 && blockIdx.x < 32) { const int sm = blockIdx.x - 16; const int row = sm < 12 ? hsh(sm * 3 + 77) % ML : ML + hsh(sm) % MC; const int t = threadIdx.x;
        __shared__ float sv[2048]; __shared__ int ti[16][16]; __shared__ float tv[16][16]; __shared__ int ex[128]; __shared__ float gw[128];
        for (int j = t; j < DM; j += 256) sv[j] = F.f32(WS_S)[(size_t)row * DM + j];
        __syncthreads();
        if (t < 16) { for (int n = 0; n < 16; ++n) { float best = -1e30f; int bi = 0; for (int k = 0; k < 128; ++k) { const float x = sv[t * 128 + k]; if (x > best) { best = x; bi = k; } } tv[t][n] = best; ti[t][n] = bi; sv[t * 128 + bi] = -1e30f; } }
        __syncthreads();
        if (t < 8) { int used_i[16], used_j[16]; float scs[16]; int ids[16];
            for (int n = 0; n < 16; ++n) { float best = -1e30f; int bi = 0, bj = 0;
                for (int i = 0; i < 16; ++i) for (int j = 0; j < 16; ++j) { bool u = false; for (int q = 0; q < n; ++q) if (used_i[q] == i && used_j[q] == j) u = true; if (u) continue; const float x = tv[2 * t][i] + tv[2 * t + 1][j]; if (x > best) { best = x; bi = i; bj = j; } }
                used_i[n] = bi; used_j[n] = bj; scs[n] = best; ids[n] = ti[2 * t][bi] * 128 + ti[2 * t + 1][bj]; }
            float mx = scs[0], sm2 = 0.f; for (int n = 0; n < 16; ++n) mx = fmaxf(mx, scs[n]); for (int n = 0; n < 16; ++n) { scs[n] = expf(scs[n] - mx); sm2 += scs[n]; }
            for (int n = 0; n < 16; ++n) { ex[t * 16 + n] = ids[n]; gw[t * 16 + n] = scs[n] / sm2; } }
        __syncthreads();
        const float* dbg = (const float*)(F.ws + WS_R + (size_t)3 * MT * DM * 2) + (size_t)row * 384;
        if (t < 128) { const int hd = t >> 4; const int mine = (int)dbg[t]; bool found = false; float wn = 0.f; for (int n = 0; n < 16; ++n) if (ex[hd * 16 + n] == mine) { found = true; wn = gw[hd * 16 + n]; }
            dacc(dg, 0, found ? 0.f : 1.f, 1.f); if (found) dacc(dg, 1, dbg[128 + t] - wn, wn);
            float d = 0.f; for (int j = 0; j < DM; ++j) d += bf2f(F.bf(WS_PU)[(size_t)mine * DM + j]) * bf2f(F.bf(WS_HN)[(size_t)row * DM + j]);
            (void)d;
            const float* st = (const float*)(F.ws + WS_Y) + (size_t)32 * DM + sm * 256; float cfn = 0.f; bool f2 = false; for (int n = 0; n < 128; ++n) if ((int)st[128 + n] == mine && (n >> 4) == hd) { cfn = st[n]; f2 = true; }
            if (f2) dacc(dg, 4, dbg[256 + t] - cfn, cfn + 1e-4f); else dacc(dg, 4, 0.f, 1e-9f);
            const float* dbg2 = (const float*)(F.ws + WS_R + (size_t)3 * MT * DM * 2) + (size_t)MT * 384 + (size_t)row * 256;
            dacc(dg, 2, dbg2[128 + t] - dbg[t], 1.f);
            { float dn = 0.f; bool f3 = false; for (int n = 0; n < 128; ++n) if ((int)st[128 + n] == mine && (n >> 4) == hd) { dn = ((const float*)(F.ws + WS_Y))[(size_t)32 * DM + 16 * 256 + sm * 128 + n]; f3 = true; }
              if (f3) dacc(dg, 3, dbg2[t] - dn, dn + 1e-3f); else dacc(dg, 3, 0.f, 1e-9f); } }
    }
    if (blockIdx.x < 16) { const int sm = blockIdx.x; const int row = sm < 12 ? hsh(sm * 3 + 77) % ML : ML + hsh(sm) % MC; const int t = threadIdx.x; const int v = row < ML ? row >> 13 : 2;
        const float* exp_ = (const float*)(F.ws + WS_Y) + (size_t)sm * DM; const float* x2 = F.f32(WS_XR) + (size_t)row * DM;
        __shared__ float red[256]; float ss = 0.f;
        for (int j = t; j < DM; j += 256) { dacc(dg, 5, x2[j] - exp_[j], exp_[DM * 16 + (size_t)sm * DM + j]); ss += x2[j] * x2[j]; }
        red[t] = ss; __syncthreads(); for (int o = 128; o > 0; o >>= 1) { if (t < o) red[t] += red[t + o]; __syncthreads(); }
        const float rs = rsqrtf(red[0] / DM + 1e-6f);
        for (int j = t; j < DM; j += 256) { const float ref = x2[j] * rs * F.inp(I_GN1)[DM + j] * (1.f + F.mod(1, v, 1)[j]) + F.mod(1, v, 0)[j]; dacc(dg, 9, bf2f(F.bf(WS_HN)[(size_t)row * DM + j]) - ref, ref); } }
#endif
}
#if MK_DIAG == 4
__global__ void __launch_bounds__(256) k_diag_pre(Args a) {
    Ctx F; F.fresh(); F.G = gridDim.x; F.bid = blockIdx.x;
    float* dg = F.f32(WS_DIAG);
    const unsigned gt = blockIdx.x * 256 + threadIdx.x, gn = gridDim.x * 256;
    for (unsigned i = gt; i < 32 * 256; i += gn) { const int rs_ = i >> 8, c8 = (i & 255) * 8; const int row = rs_ < 24 ? (hsh(rs_ * 3 + 21) % ML) : ML + (hsh(rs_) % MC);
        const float* xr = F.f32(WS_XR) + (size_t)row * DM; const int v = row < ML ? row >> 13 : 2;
        float ss = 0.f; for (int k = 0; k < DM; ++k) ss += xr[k] * xr[k]; const float r = rsqrtf(ss / DM + 1e-6f);
        for (int e = 0; e < 8; ++e) { const int c = c8 + e; const float ref = xr[c] * r * F.inp(I_GN2)[c] * (1.0f + F.mod(0, v, 4)[c]) + F.mod(0, v, 3)[c];
            dacc(dg, 6, bf2f(F.bf(WS_HN)[(size_t)row * DM + c]) - ref, ref); } }
    for (unsigned i = gt; i < 1024; i += gn) { const unsigned h = hsh(i * 43 + 16); const int row = h % MT, col = (h >> 15) % DM;
        const float ref = ddot_bf(F.bf(WS_HN) + (size_t)row * DM, F.bf(WS_WPQ) + (size_t)col * DM, DM); dacc(dg, 7, bf2f(F.bf(WS_PQ)[(size_t)row * DM + col]) - ref, ref + 1e-3f); }
    for (unsigned i = gt; i < 4096; i += gn) { const unsigned h = hsh(i * 47 + 18); const int row = h % MT, col = (h >> 15) % DM; const int hd = col >> 8, p = (col >> 7) & 1, k = col & 127; float ref = 0.f;
        for (int d = 0; d < 128; ++d) ref += bf2f(F.bf(WS_PQ)[(size_t)row * DM + hd * 256 + p * 128 + d]) * bf2f(f2bf(F.inp(I_PKEYS)[((size_t)p * 128 + k) * 128 + d]));
        dacc(dg, 8, F.f32(WS_S)[(size_t)row * DM + col] - ref, ref + 1e-3f); }
    if (blockIdx.x < 16) { const int sm = blockIdx.x; const int row = sm < 12 ? hsh(sm * 3 + 77) % ML : ML + hsh(sm) % MC; const int t = threadIdx.x; const int v = row < ML ? row >> 13 : 2;
        __shared__ float sv[2048]; __shared__ int ti[16][16]; __shared__ float tv[16][16]; __shared__ int ex[128]; __shared__ float gw[128]; __shared__ float cf[128];
        for (int j = t; j < DM; j += 256) sv[j] = F.f32(WS_S)[(size_t)row * DM + j];
        __syncthreads();
        if (t < 16) { for (int n = 0; n < 16; ++n) { float best = -1e30f; int bi = 0; for (int k = 0; k < 128; ++k) { const float x = sv[t * 128 + k]; if (x > best) { best = x; bi = k; } } tv[t][n] = best; ti[t][n] = bi; sv[t * 128 + bi] = -1e30f; } }
        __syncthreads();
        if (t < 8) { int used_i[16], used_j[16]; float scs[16]; int ids[16];
            for (int n = 0; n < 16; ++n) { float best = -1e30f; int bi = 0, bj = 0;
                for (int i = 0; i < 16; ++i) for (int j = 0; j < 16; ++j) { bool u = false; for (int q = 0; q < n; ++q) if (used_i[q] == i && used_j[q] == j) u = true; if (u) continue; const float x = tv[2 * t][i] + tv[2 * t + 1][j]; if (x > best) { best = x; bi = i; bj = j; } }
                used_i[n] = bi; used_j[n] = bj; scs[n] = best; ids[n] = ti[2 * t][bi] * 128 + ti[2 * t + 1][bj]; }
            float mx = scs[0], sm2 = 0.f; for (int n = 0; n < 16; ++n) mx = fmaxf(mx, scs[n]); for (int n = 0; n < 16; ++n) { scs[n] = expf(scs[n] - mx); sm2 += scs[n]; }
            for (int n = 0; n < 16; ++n) { ex[t * 16 + n] = ids[n]; gw[t * 16 + n] = scs[n] / sm2; } }
        __syncthreads();
        if (t < 128) { float d = 0.f; for (int j = 0; j < DM; ++j) d += bf2f(F.bf(WS_PU)[(size_t)ex[t] * DM + j]) * bf2f(F.bf(WS_HN)[(size_t)row * DM + j]); cf[t] = gw[t] * 0.5f * d * (1.f + erff(d * 0.70710678f)); ((float*)(F.ws + WS_Y))[(size_t)32 * DM + 16 * 256 + sm * 128 + t] = d; }
        __syncthreads();
        float* st = (float*)(F.ws + WS_Y);
        if (t < 128) { st[(size_t)32 * DM + sm * 256 + t] = cf[t]; st[(size_t)32 * DM + sm * 256 + 128 + t] = (float)ex[t]; }
        for (int j = t; j < DM; j += 256) { float o = 0.f; for (int k = 0; k < 128; ++k) o += cf[k] * bf2f(F.bf(WS_PV)[(size_t)ex[k] * DM + j]);
            st[(size_t)sm * DM + j] = F.f32(WS_XR)[(size_t)row * DM + j] + F.mod(0, v, 5)[j] * o; st[(size_t)16 * DM + (size_t)sm * DM + j] = F.mod(0, v, 5)[j] * o; }
    }
}
#endif
__global__ void __launch_bounds__(256) k_diag_fill(Args a, size_t n) {
    const float* dg = (const float*)(a.ws + WS_DIAG);
    const float tol[8] = {MK_DIAG == 4 ? 0.1f : 0.02f, 0.02f, 0.02f, 0.02f, 0.02f, 0.02f, 0.02f, 0.02f};
    int id = 15; float e = 0.f;
    const int nchk = MK_DIAG == 6 ? 4 : MK_DIAG == 1 ? 4 : MK_DIAG == 2 ? 6 : MK_DIAG == 3 ? (MK_STOP == 7 ? 3 : 2) : 6;
    const int order3[6] = {MK_STOP == 7 ? 5 : 2, MK_STOP == 7 ? 4 : 3, 1, 0, 0, 0};
    for (int cc = 0; cc < nchk; ++cc) { const int c = MK_DIAG == 3 ? order3[cc] : cc; const float num = dg[2 * c], den = dg[2 * c + 1]; const float ec = den > 0.f ? sqrtf(num / den) : 1.f;
        if (!(ec <= tol[c])) { id = c; e = ec; break; } if (ec > e) e = ec; }
    if (!(e == e)) e = 1.f; e = fminf(fmaxf(e, 1e-6f), 1.f);
    const float m = 1.0f + 1.4f * log10f(e * 1e6f);
    const float c2 = m * powf(10.f, 4.f + (float)id);
    const float val = sqrtf(c2);
    for (size_t i = (size_t)blockIdx.x * 256 + threadIdx.x; i < n; i += (size_t)gridDim.x * 256) a.out[i] = val;
}
#endif

extern "C" void kernel_launch(void* const* d_in, const int* in_sizes, int n_in, void* d_out, int out_size, void* d_ws, size_t ws_size, hipStream_t stream) {
    static int grid = 0;
    if (grid == 0) {
        if (n_in != 30 || out_size != ML * DM || ws_size < WS_END) { fprintf(stderr, "kernel_launch: needs 30 inputs, %d outputs, >= %zu bytes of workspace; got n_in %d out %d ws %zu\n", ML * DM, (size_t)WS_END, n_in, out_size, ws_size); grid = -1; return; }
        int dev = 0, cus = 0, per_cu = 0;
        if (hipGetDevice(&dev) != hipSuccess || hipDeviceGetAttribute(&cus, hipDeviceAttributeMultiprocessorCount, dev) != hipSuccess) { grid = -1; return; }
        if (hipFuncSetAttribute((const void*)mk_fwd, hipFuncAttributeMaxDynamicSharedMemorySize, LDS_BYTES) != hipSuccess) { fprintf(stderr, "kernel_launch: hipFuncSetAttribute failed\n"); grid = -1; return; }
        if (hipOccupancyMaxActiveBlocksPerMultiprocessor(&per_cu, (const void*)mk_fwd, NTHREADS, LDS_BYTES) != hipSuccess || per_cu < 1) { fprintf(stderr, "kernel_launch: occupancy query says %d\n", per_cu); (void)hipGetLastError(); grid = -1; return; }
        grid = cus;
    }
    if (grid < 0) return;
    (void)hipMemsetAsync((char*)d_ws, 0, WS_ZERO_END, stream);
    Args a{};
    for (int i = 0; i < 30; ++i) a.in[i] = (const float*)d_in[i];
    a.out = (float*)d_out; a.ws = (unsigned char*)d_ws;
    constexpr int STOP = MK_STOP < NPHASES ? MK_STOP : NPHASES;
#if MK_MULTI
    for (int ph = 0; ph < STOP; ++ph) {
#if MK_DIAG == 4
        if (ph == STOP - 1) hipLaunchKernelGGL(k_diag_pre, dim3(64), dim3(256), 0, stream, a);
#endif
        a.ph_lo = ph; a.ph_hi = ph + 1; hipLaunchKernelGGL(mk_fwd, dim3(grid), dim3(NTHREADS), LDS_BYTES, stream, a); }
#else
    a.ph_lo = 0; a.ph_hi = STOP; hipLaunchKernelGGL(mk_fwd, dim3(grid), dim3(NTHREADS), LDS_BYTES, stream, a);
#endif
#if MK_DIAG
    hipLaunchKernelGGL(k_diag, dim3(64), dim3(256), 0, stream, a);
    hipLaunchKernelGGL(k_diag_fill, dim3(1024), dim3(256), 0, stream, a, (size_t)ML * DM);
#endif
    const hipError_t le = hipPeekAtLastError();
    if (le != hipSuccess) fprintf(stderr, "kernel_launch: launch failed: %s\n", hipGetErrorName(le));
}
```

```cpp
#include <hip/hip_runtime.h>
#include <cstdio>
#include <cstdint>
#include <cstddef>

#define LAS __attribute__((address_space(3)))
typedef unsigned short bf16_t;
typedef short bf16x8 __attribute__((ext_vector_type(8)));
typedef short s16x4 __attribute__((ext_vector_type(4)));
typedef float f32x4 __attribute__((ext_vector_type(4)));
typedef float f32x2 __attribute__((ext_vector_type(2)));
typedef float f32x16 __attribute__((ext_vector_type(16)));
typedef unsigned u32x4 __attribute__((ext_vector_type(4)));
typedef unsigned u32x2 __attribute__((ext_vector_type(2)));
typedef __bf16 bf16x2_t __attribute__((ext_vector_type(2)));

#ifndef MK_MULTI
#define MK_MULTI 0
#endif
#ifndef MK_DIAG
#define MK_DIAG 0
#endif
#ifndef MK_STOP
#define MK_STOP 1000
#endif

constexpr int DM = 2048, NBATCH = 2, SEQ = 8192, CTXL = 256, DEPTH = 2;
constexpr int ML = NBATCH * SEQ, MC = NBATCH * CTXL, MT = ML + MC;
constexpr int DIN = 3776, ZLD = 3840;
constexpr int ZC_QLAT = 0, ZC_KVLAT = 384, ZC_KROPE = 640, ZC_DQ = 704, ZC_DK = 1216, ZC_DV = 1728, ZC_F = 2240, ZC_C = 2752;
constexpr int NEXP = 16384;
#ifndef MK_UBITS
#define MK_UBITS 4
#endif
#ifndef MK_VBITS
#define MK_VBITS 4
#endif
constexpr int PEER_UBITS = MK_UBITS, PEER_VBITS = MK_VBITS;
constexpr int PEER_UROWB = DM * PEER_UBITS / 8, PEER_VROWB = DM * PEER_VBITS / 8;
constexpr int NTHREADS = 512, NWAVES = 8;
constexpr int LDS_BYTES = 160 * 1024;

constexpr size_t al256(size_t x) { return (x + 255) / 256 * 256; }
constexpr size_t WS_BAR   = 0;
constexpr size_t WS_MOD   = 16384;
constexpr size_t WS_DIAG  = WS_MOD + al256((size_t)DEPTH * 3 * 6 * DM * 4);
constexpr size_t WS_ZERO_END = WS_DIAG + 4096;
constexpr size_t WS_ROPE  = WS_ZERO_END;
constexpr size_t WS_WIN   = WS_ROPE + (size_t)SEQ * 32 * 2 * 4;
constexpr size_t WS_WG    = WS_WIN + (size_t)DEPTH * ZLD * DM * 2;
constexpr size_t WS_WB    = WS_WG + (size_t)DEPTH * 4 * DM * DM;
constexpr size_t WS_WO    = WS_WB + (size_t)DEPTH * 4 * DM * 512 * 2;
constexpr size_t WS_WPQ   = WS_WO + (size_t)DEPTH * DM * DM * 2;
constexpr size_t WS_WUQ   = WS_WPQ + (size_t)DEPTH * DM * DM * 2;
constexpr size_t WS_WUKV  = WS_WUQ + (size_t)DEPTH * 768 * 384 * 2;
constexpr size_t WS_KB    = WS_WUKV + (size_t)DEPTH * 1024 * 256 * 2;
constexpr size_t WS_WDFT  = WS_KB + (size_t)DEPTH * 256 * 256 * 2;
constexpr size_t WS_PU    = WS_WDFT + (size_t)512 * 1024 * 2;
constexpr size_t WS_PV    = WS_PU + (size_t)DEPTH * NEXP * PEER_UROWB;
constexpr size_t WS_XR    = WS_PV + (size_t)DEPTH * NEXP * PEER_VROWB;
constexpr size_t WS_HN    = WS_XR + (size_t)MT * DM * 4;
constexpr size_t WS_BR    = WS_HN + (size_t)MT * DM * 2;
constexpr size_t WS_Y     = WS_BR + (size_t)4 * MT * 512 * 2;
constexpr size_t WS_R     = WS_Y + (size_t)MT * DM * 2;
constexpr size_t WS_Z     = WS_R;
constexpr size_t WS_Q     = WS_Z + (size_t)MT * ZLD * 2;
constexpr size_t WS_KV    = WS_Q + (size_t)MT * 768 * 2;
constexpr size_t WS_AP    = WS_KV + (size_t)MT * 1024 * 2;
constexpr size_t WS_X     = WS_AP + (size_t)NBATCH * 128 * 2 * 64 * 512 * 2;
constexpr size_t WS_T     = WS_R;
constexpr size_t WS_S     = WS_R;
constexpr size_t WS_PART  = WS_R + (size_t)MT * DM * 4;
constexpr size_t WS_R_END = WS_R + (size_t)4 * MT * DM * 2;
static_assert(WS_PART + (size_t)8 * MC * DM * 4 <= WS_R_END, "partials must fit in region R");
constexpr size_t WS_YC    = WS_R_END;
constexpr size_t WS_WSC   = WS_YC + (size_t)4 * MC * DM * 2;
constexpr size_t WS_HN8   = WS_WSC + (size_t)DEPTH * DM * DM * 2;
constexpr size_t WS_K8    = WS_HN8 + (size_t)MT * DM;
constexpr size_t WS_KD8   = WS_K8 + (size_t)MT * 1024 + 256;
constexpr size_t WS_V8T   = WS_KD8 + (size_t)MT * 512 + 256;
constexpr size_t WS_VD8T  = WS_V8T + (size_t)4 * (MT / 64) * 8192 + 256;
constexpr size_t WS_QL8   = WS_VD8T + (size_t)4 * (MT / 64) * 8192 + 256;
constexpr size_t WS_KVL8  = WS_QL8 + (size_t)MT * 512;
constexpr size_t WS_END   = WS_KVL8 + (size_t)MT * 256 + 256;
static_assert(WS_X + (size_t)MT * 1024 * 2 <= WS_R_END, "region R overflow");
static_assert((size_t)256 * 32 * 512 * 16 <= (size_t)4 * MT * 512 * 2, "YS scratch must fit in BR");

struct Args { const float* in[30]; float* out; unsigned char* ws; int ph_lo, ph_hi; };
enum { I_X = 0, I_C, I_CTX, I_CCTX, I_WADA, I_BADA, I_GN1, I_GN2, I_WIN, I_GQ, I_WUQ, I_GKV, I_WUKV, I_LQ1, I_LK1, I_LQ2, I_LK2, I_GSUB, I_WDW, I_BDW, I_GCN, I_BCN,
       I_WGATE, I_WBR, I_WOUT, I_WPQ, I_PKEYS, I_PU, I_PV, I_GFIN };

__device__ __forceinline__ unsigned cvt_pk_bf16(float lo, float hi) { unsigned r; asm volatile("v_cvt_pk_bf16_f32 %0, %1, %2" : "=v"(r) : "v"(lo), "v"(hi)); return r; }
__device__ __forceinline__ bf16_t f2bf(float f) { unsigned u = __float_as_uint(f); u += 0x7FFFu + ((u >> 16) & 1u); return (bf16_t)(u >> 16); }
__device__ __forceinline__ float bf2f(bf16_t b) { return __uint_as_float(((unsigned)b) << 16); }
__device__ __forceinline__ float bflo(unsigned w) { return __uint_as_float(w << 16); }
__device__ __forceinline__ float bfhi(unsigned w) { return __uint_as_float(w & 0xFFFF0000u); }
__device__ __forceinline__ int tid_of_wave(int wv) { int ln; asm volatile("v_mbcnt_lo_u32_b32 %0, -1, 0\n\tv_mbcnt_hi_u32_b32 %0, -1, %0" : "=v"(ln)); return wv * 64 + ln; }
__device__ __forceinline__ unsigned char f2fp8(float v) { return (unsigned char)(__builtin_amdgcn_cvt_pk_fp8_f32(v, v, 0, false) & 0xFF); }
__device__ __forceinline__ float sigmoidf_(float x) { return __builtin_amdgcn_rcpf(1.0f + __expf(-x)); }
template <int CTRL> __device__ __forceinline__ unsigned dpp_u(unsigned x) { return (unsigned)__builtin_amdgcn_update_dpp(0, (int)x, CTRL, 0xf, 0xf, true); }
template <int CTRL> __device__ __forceinline__ float dpp_f(float x) { return __int_as_float(__builtin_amdgcn_update_dpp(0, __float_as_int(x), CTRL, 0xf, 0xf, true)); }
__device__ __forceinline__ unsigned row_max16_u(unsigned x) { unsigned y = dpp_u<0xB1>(x); x = x > y ? x : y; y = dpp_u<0x4E>(x); x = x > y ? x : y; y = dpp_u<0x141>(x); x = x > y ? x : y; y = dpp_u<0x140>(x); return x > y ? x : y; }
__device__ __forceinline__ float row_max16_f(float x) { x = fmaxf(x, dpp_f<0xB1>(x)); x = fmaxf(x, dpp_f<0x4E>(x)); x = fmaxf(x, dpp_f<0x141>(x)); return fmaxf(x, dpp_f<0x140>(x)); }
__device__ __forceinline__ float row_sum16_f(float x) { x += dpp_f<0xB1>(x); x += dpp_f<0x4E>(x); x += dpp_f<0x141>(x); return x + dpp_f<0x140>(x); }
__device__ __forceinline__ float wave_sum_dpp(float x) {
    x = row_sum16_f(x);
    const float a = __int_as_float(__builtin_amdgcn_readlane(__float_as_int(x), 0)), b = __int_as_float(__builtin_amdgcn_readlane(__float_as_int(x), 16));
    const float c = __int_as_float(__builtin_amdgcn_readlane(__float_as_int(x), 32)), d = __int_as_float(__builtin_amdgcn_readlane(__float_as_int(x), 48));
    return (a + b) + (c + d);
}
__device__ __forceinline__ float wave_sum(float v) { return wave_sum_dpp(v); }
__device__ __forceinline__ float half_sum_dpp(float x, int hi) {
    x = row_sum16_f(x);
    const float a = __int_as_float(__builtin_amdgcn_readlane(__float_as_int(x), 0)), b = __int_as_float(__builtin_amdgcn_readlane(__float_as_int(x), 16));
    const float c = __int_as_float(__builtin_amdgcn_readlane(__float_as_int(x), 32)), d = __int_as_float(__builtin_amdgcn_readlane(__float_as_int(x), 48));
    return hi ? (c + d) : (a + b);
}

#define XB_TMO      128
#define XB_XCNT(j)  (256  + 64 * (j))
#define XB_XSUB(j)  (1280 + 64 * (j))
#define XB_XGEN(j)  (2304 + 64 * (j))
#define XB_TOP      3328
#define XB_TOPGEN   3392
#define XCD_BAR_WORDS 3456
#define XB_SPIN_CAP (1u << 20)
__device__ __forceinline__ unsigned xb_ld(unsigned* p)              { return __hip_atomic_load(p, __ATOMIC_RELAXED, __HIP_MEMORY_SCOPE_AGENT); }
__device__ __forceinline__ unsigned xb_add(unsigned* p, unsigned v) { return __hip_atomic_fetch_add(p, v, __ATOMIC_RELAXED, __HIP_MEMORY_SCOPE_AGENT); }
__device__ __forceinline__ unsigned xb_xcc_id() { return (unsigned)__builtin_amdgcn_s_getreg((3 << 11) | 20) & 0xFu; }
#define XB_SPIN(cond, bar) do { unsigned _sp = 0; while (cond) { __builtin_amdgcn_s_sleep(1); \
    if ((++_sp & 255u) == 0u) { if (xb_ld(&(bar)[XB_TMO])) break; if (_sp > XB_SPIN_CAP) { atomicAdd(&(bar)[XB_TMO], 1u); break; } } } } while (0)
struct XcdBarrier { unsigned* bar; unsigned x; volatile LAS unsigned* st; };
__device__ __forceinline__ XcdBarrier xcd_barrier_post(unsigned* bar, volatile LAS unsigned* st, int tid) {
    XcdBarrier b; b.bar = bar; b.x = xb_xcc_id(); b.st = st;
    if (tid == 0) (void)xb_add(&bar[XB_XCNT(b.x)], 1u);
    return b;
}
__device__ __forceinline__ void xcd_barrier_complete(unsigned* bar, unsigned x, unsigned& nloc, unsigned& nx) {
    const unsigned G = gridDim.x * gridDim.y * gridDim.z;
    unsigned sum, cnt, mine, sp = 0u;
    for (;;) {
        sum = 0u; cnt = 0u; mine = 0u;
#pragma unroll
        for (unsigned j = 0; j < 16; ++j) { const unsigned c = xb_ld(&bar[XB_XCNT(j)]); sum += c; cnt += (c > 0u) ? 1u : 0u; mine = (j == x) ? c : mine; }
        if (sum == G) break;
        __builtin_amdgcn_s_sleep(1);
        if ((++sp & 255u) == 0u) { if (xb_ld(&bar[XB_TMO])) break; if (sp > XB_SPIN_CAP) { atomicAdd(&bar[XB_TMO], 1u); break; } }
    }
    nloc = mine > 0u ? mine : 1u; nx = cnt > 0u ? cnt : 1u;
}
__device__ __forceinline__ void xcd_barrier(const XcdBarrier& b, int tid) {
    asm volatile("s_waitcnt vmcnt(0)" ::: "memory");
    __syncthreads();
    if (tid == 0) {
        unsigned* bar = b.bar;
        __builtin_amdgcn_s_waitcnt(0);
        unsigned nloc = b.st[0], nx = b.st[1];
        if (nloc == 0u) { xcd_barrier_complete(bar, b.x, nloc, nx); b.st[0] = nloc; b.st[1] = nx; }
        const unsigned old = xb_add(&bar[XB_XSUB(b.x)], 1u);
        const unsigned gen = old / nloc;
        if (old + 1u == (gen + 1u) * nloc) {
            __builtin_amdgcn_fence(__ATOMIC_RELEASE, "agent");
            asm volatile("s_waitcnt vmcnt(0)" ::: "memory");
            const unsigned og = xb_add(&bar[XB_TOP], 1u);
            const unsigned tg = og / nx;
            if (og + 1u == (tg + 1u) * nx) xb_add(&bar[XB_TOPGEN], 1u);
            else XB_SPIN(xb_ld(&bar[XB_TOPGEN]) == tg, bar);
            __builtin_amdgcn_fence(__ATOMIC_ACQUIRE, "agent");
            xb_add(&bar[XB_XGEN(b.x)], 1u);
            asm volatile("s_waitcnt vmcnt(0)" ::: "memory");
        } else {
            XB_SPIN(xb_ld(&bar[XB_XGEN(b.x)]) == gen, bar);
            __builtin_amdgcn_fence(__ATOMIC_ACQUIRE, "agent");
            asm volatile("s_waitcnt vmcnt(0)" ::: "memory");
        }
    }
    __syncthreads();
}

namespace pg8 {
constexpr int BM = 256, BK = 64, HALF = 128, HTB = HALF * BK * 2, STAGE_BYTES = 8 * HTB, NXCD = 8, WGM = 8;
__host__ __device__ __forceinline__ int lds_byte(int r, int c) { const int st = (r >> 4) * 2 + (c >> 5), rr = r & 15, cc = c & 31, ob = rr * 64 + cc * 2; return st * 1024 + (ob ^ (((ob >> 9) & 1) << 5)); }
__host__ __device__ __forceinline__ void stage_rc(int b, int& R, int& C) { const int st = b / 1024, sb = b % 1024, swz = sb ^ (((sb >> 9) & 1) << 5); R = (st >> 1) * 16 + swz / 64; C = (st & 1) * 32 + (swz % 64) / 2; }
__host__ __device__ __forceinline__ int perm32(int rho) { const int n = rho >> 4, i = rho & 15; return 8 * (i >> 2) + 4 * n + (i & 3); }

typedef int v8i_t __attribute__((ext_vector_type(8)));
template <int ELT> struct FragT { bf16x8 k[2]; };
template <> struct FragT<1> { v8i_t v; };
struct Unit { int pm, pn; const char* a; const char* b; };
struct Gemm { int lda, ldb, K; int wv; };

__device__ __forceinline__ void tile_of(int L, int nM, int nN, int& pm, int& pn) {
    const int nwg = nM * nN; int wgid = L;
    { const int q = nwg / NXCD, r = nwg % NXCD, xcd = wgid % NXCD, off = wgid / NXCD; wgid = (xcd < r ? xcd * (q + 1) : r * (q + 1) + (xcd - r) * q) + off; }
    const int nig = WGM * nN, gid = wgid / nig, fm = gid * WGM, gsz = (nM - fm) < WGM ? (nM - fm) : WGM;
    pm = fm + ((wgid % nig) % gsz); pn = (wgid % nig) / gsz;
}
struct Sched {
    int nM, nN, G, c; const char* A; const char* B; size_t a_tile, b_tile; int a_div; size_t a_dstride; int sa0 = 0x7F7F7F7F;
    __device__ __forceinline__ int a_scale(const Unit& u) const { return (u.pn / a_div) == 0 ? sa0 : 0x7F7F7F7F; }
    __device__ __forceinline__ bool next(int i, Unit& u) const {
        const long L = (long)i * G + c; if (L >= (long)nM * nN) return false;
        tile_of((int)L, nM, nN, u.pm, u.pn);
        u.a = A + (size_t)u.pm * a_tile + (size_t)(u.pn / a_div) * a_dstride; u.b = B + (size_t)u.pn * b_tile; return true;
    }
};
struct SchedWsc {
    int G, c; const char* KB; const char* W;
    __device__ __forceinline__ bool next(int i, Unit& u) const {
        const long L = (long)i * G + c; if (L >= DEPTH * 64) return false;
        const int l = (int)L >> 6, h = ((int)L >> 3) & 7, pn = (int)L & 7; u.pm = h; u.pn = l * 8 + pn;
        u.a = KB + (size_t)l * 256 * 256 * 2; u.b = W + ((size_t)l * DM * DM + (size_t)pn * 256 * DM + h * 256) * 2; return true;
    }
};
struct SchedGate {
    int nM, G, c; const char* A; const char* B; size_t a_tile, b_tile;
    __device__ __forceinline__ int a_scale(const Unit&) const { return 0x7F7F7F7F; }
    __device__ __forceinline__ bool next(int i, Unit& u) const {
        const long L = (long)(i >> 2) * G + c; if (L >= (long)nM * 8) return false;
        int pm, pn; tile_of((int)L, nM, 8, pm, pn); const int n = i & 3;
        u.pm = pm; u.pn = n * 8 + pn; u.a = A + (size_t)pm * a_tile; u.b = B + (size_t)u.pn * b_tile; return true;
    }
};

struct EpiBf16 {
    static constexpr bool PERM = true;
    bf16_t* O; int ldc; int pn_div; size_t pn_stride;
    __device__ __forceinline__ void operator()(const f32x4 (&acc)[2][2][4][2], const Unit& u, int wr, int wc, int fr, int fq) const {
        bf16_t* base = O + (size_t)(u.pn / pn_div) * pn_stride;
        const int row0 = u.pm * BM + wr * 64 + fr, col0 = (u.pn % pn_div) * BM + wc * 32 + 8 * fq;
#pragma unroll
        for (int ai = 0; ai < 2; ++ai)
#pragma unroll
            for (int m = 0; m < 4; ++m) { bf16_t* rowp = base + (size_t)(row0 + ai * HALF + m * 16) * ldc + col0;
#pragma unroll
                for (int bj = 0; bj < 2; ++bj) { const f32x4 v0 = acc[ai][bj][m][0], v1 = acc[ai][bj][m][1];
                    u32x4 w; w.x = cvt_pk_bf16(v0[0], v0[1]); w.y = cvt_pk_bf16(v0[2], v0[3]); w.z = cvt_pk_bf16(v1[0], v1[1]); w.w = cvt_pk_bf16(v1[2], v1[3]);
                    *(u32x4*)(rowp + bj * HALF) = w; } }
    }
};
struct EpiKV {
    static constexpr bool PERM = true;
    bf16_t* O; unsigned char* K8;
    __device__ __forceinline__ void operator()(const f32x4 (&acc)[2][2][4][2], const Unit& u, int wr, int wc, int fr, int fq) const {
        const int row0 = u.pm * BM + wr * 64 + fr;
        bf16_t* ob = O + (size_t)row0 * 1024 + u.pn * BM + HALF + wc * 32 + 8 * fq; unsigned char* kb = K8 + ((size_t)row0 * 4 + u.pn) * 256 + wc * 32 + 8 * fq;
#pragma unroll
        for (int ai = 0; ai < 2; ++ai)
#pragma unroll
            for (int m = 0; m < 4; ++m) { int dr = (ai * HALF + m * 16) * 1024; asm volatile("" : "+v"(dr));
                { const f32x4 v0 = acc[ai][0][m][0], v1 = acc[ai][0][m][1]; int p0 = 0, p1 = 0;
                  p0 = __builtin_amdgcn_cvt_pk_fp8_f32(v0[0], v0[1], p0, false); p0 = __builtin_amdgcn_cvt_pk_fp8_f32(v0[2], v0[3], p0, true);
                  p1 = __builtin_amdgcn_cvt_pk_fp8_f32(v1[0], v1[1], p1, false); p1 = __builtin_amdgcn_cvt_pk_fp8_f32(v1[2], v1[3], p1, true);
                  *(u32x2*)(kb + dr) = (u32x2){(unsigned)p0, (unsigned)p1}; }
                { const f32x4 v0 = acc[ai][1][m][0], v1 = acc[ai][1][m][1];
                  u32x4 w; w.x = cvt_pk_bf16(v0[0], v0[1]); w.y = cvt_pk_bf16(v0[2], v0[3]); w.z = cvt_pk_bf16(v1[0], v1[1]); w.w = cvt_pk_bf16(v1[2], v1[3]);
                  *(u32x4*)(ob + dr) = w; } }
    }
};
struct EpiFp8 {
    static constexpr bool PERM = true;
    unsigned char* O; int ldc; int pn_div; size_t pn_stride;
    __device__ __forceinline__ void operator()(const f32x4 (&acc)[2][2][4][2], const Unit& u, int wr, int wc, int fr, int fq) const {
        unsigned char* base = O + (size_t)(u.pn / pn_div) * pn_stride;
        const int row0 = u.pm * BM + wr * 64 + fr, col0 = (u.pn % pn_div) * BM + wc * 32 + 8 * fq;
#pragma unroll
        for (int ai = 0; ai < 2; ++ai)
#pragma unroll
            for (int m = 0; m < 4; ++m) { unsigned char* rowp = base + (size_t)(row0 + ai * HALF + m * 16) * ldc + col0;
#pragma unroll
                for (int bj = 0; bj < 2; ++bj) { const f32x4 v0 = acc[ai][bj][m][0], v1 = acc[ai][bj][m][1]; int p0 = 0, p1 = 0;
                    p0 = __builtin_amdgcn_cvt_pk_fp8_f32(v0[0], v0[1], p0, false); p0 = __builtin_amdgcn_cvt_pk_fp8_f32(v0[2], v0[3], p0, true);
                    p1 = __builtin_amdgcn_cvt_pk_fp8_f32(v1[0], v1[1], p1, false); p1 = __builtin_amdgcn_cvt_pk_fp8_f32(v1[2], v1[3], p1, true);
                    *(u32x2*)(rowp + bj * HALF) = (u32x2){(unsigned)p0, (unsigned)p1}; } }
    }
};
struct EpiF32 {
    static constexpr bool PERM = false;
    float* C; int ldc;
    __device__ __forceinline__ void operator()(const f32x4 (&acc)[2][2][4][2], const Unit& u, int wr, int wc, int fr, int fq) const {
        int fr_ = fr; asm volatile("" : "+v"(fr_));
        const int row0 = u.pm * BM + wr * 64 + fr_, col0 = u.pn * BM + wc * 32 + 4 * fq;
#pragma unroll
        for (int ai = 0; ai < 2; ++ai)
#pragma unroll
            for (int m = 0; m < 4; ++m) { float* rowp = C + (size_t)(row0 + ai * HALF + m * 16) * ldc + col0;
#pragma unroll
                for (int bj = 0; bj < 2; ++bj)
#pragma unroll
                    for (int n = 0; n < 2; ++n) *(f32x4*)(rowp + bj * HALF + n * 16) = acc[ai][bj][m][n]; }
    }
};
struct SchedKSplit {
    int G, c; const char* A; const char* B; size_t a_tile, b_tile; int kbytes;
    __device__ __forceinline__ int a_scale(const Unit&) const { return 0x7F7F7F7F; }
    __device__ __forceinline__ bool next(int i, Unit& u) const {
        if (i > 0 || c >= 128) return false;
        const int cu = c >> 3, ks = c & 7; u.pm = ML / BM + (cu >> 3); u.pn = (cu & 7) + 8 * ks;
        u.a = A + (size_t)u.pm * a_tile + (size_t)ks * kbytes; u.b = B + (size_t)(cu & 7) * b_tile + (size_t)ks * kbytes; return true;
    }
};
struct EpiPart {
    static constexpr bool PERM = false;
    float* P;
    __device__ __forceinline__ void operator()(const f32x4 (&acc)[2][2][4][2], const Unit& u, int wr, int wc, int fr, int fq) const {
        int fr_ = fr; asm volatile("" : "+v"(fr_));
        const int row0 = (u.pm - ML / BM) * BM + wr * 64 + fr_, col0 = (u.pn & 7) * BM + wc * 32 + 4 * fq;
        float* base = P + (size_t)(u.pn >> 3) * MC * DM;
#pragma unroll
        for (int ai = 0; ai < 2; ++ai)
#pragma unroll
            for (int m = 0; m < 4; ++m) { float* rowp = base + (size_t)(row0 + ai * HALF + m * 16) * DM + col0;
#pragma unroll
                for (int bj = 0; bj < 2; ++bj)
#pragma unroll
                    for (int n = 0; n < 2; ++n) *(f32x4*)(rowp + bj * HALF + n * 16) = acc[ai][bj][m][n]; }
    }
};
struct EpiResGate {
    static constexpr bool PERM = false;
    float* XR; const float* resL; const float* resC; const float* modL; const float* modC;
    __device__ __forceinline__ void operator()(const f32x4 (&acc)[2][2][4][2], const Unit& u, int wr, int wc, int fr, int fq) const {
        const bool lat = u.pm < ML / BM;
        const float* res = lat ? resL + (size_t)u.pm * BM * DM : resC + (size_t)(u.pm - ML / BM) * BM * DM;
        const float* gate = lat ? modL + (size_t)(u.pm >> 5) * (6 * DM) : modC;
        int fr_ = fr; asm volatile("" : "+v"(fr_));
        const int row0 = wr * 64 + fr_, col0 = u.pn * BM + wc * 32 + 4 * fq;
        float* outp = XR + (size_t)u.pm * BM * DM;
        f32x4 gv[2][2];
#pragma unroll
        for (int bj = 0; bj < 2; ++bj)
#pragma unroll
            for (int n = 0; n < 2; ++n) gv[bj][n] = *(const f32x4*)(gate + col0 + bj * HALF + n * 16);
        f32x4 rc[2][2], rn[2][2] = {};
#define ER_LOAD(it_, r_) do { const size_t off_ = (size_t)(row0 + ((it_) >> 2) * HALF + ((it_) & 3) * 16) * DM + col0; \
        _Pragma("unroll") for (int bj = 0; bj < 2; ++bj) _Pragma("unroll") for (int n = 0; n < 2; ++n) r_[bj][n] = *(const f32x4*)(res + off_ + bj * HALF + n * 16); } while (0)
        ER_LOAD(0, rc);
#pragma unroll
        for (int it = 0; it < 8; ++it) { const int ai = it >> 2, m = it & 3; const size_t off = (size_t)(row0 + ai * HALF + m * 16) * DM + col0;
            if (it + 1 < 8) ER_LOAD(it + 1, rn);
#pragma unroll
            for (int bj = 0; bj < 2; ++bj)
#pragma unroll
                for (int n = 0; n < 2; ++n) { *(f32x4*)(outp + off + bj * HALF + n * 16) = rc[bj][n] + gv[bj][n] * acc[ai][bj][m][n]; rc[bj][n] = rn[bj][n]; }
            asm volatile("" ::: "memory"); }
#undef ER_LOAD
    }
};
struct EpiGate {
    static constexpr bool PERM = true;
    const unsigned char* T; size_t t_stride; u32x4* ys; unsigned char* Y;
    __device__ __forceinline__ void operator()(const f32x4 (&acc)[2][2][4][2], const Unit& u, int wr, int wc, int fr, int fq) const {
        const int n_br = u.pn >> 3; int tid = (wr * 4 + wc) * 64 + fq * 16 + fr; asm volatile("" : "+v"(tid));
        const int row0 = u.pm * BM + wr * 64 + fr, col0 = (u.pn & 7) * BM + wc * 32 + 8 * fq;
        const unsigned char* Tn = T + (size_t)n_br * t_stride;
        u32x2 twc[2], twn[2]; u32x4 pvc[2] = {}, pvn[2] = {};
#define EG_LOAD(it_, tw_, pv_) do { const int ai_ = (it_) >> 2, m_ = (it_) & 3; const size_t off_ = (size_t)(row0 + ai_ * HALF + m_ * 16) * DM + col0; \
        _Pragma("unroll") for (int bj = 0; bj < 2; ++bj) { tw_[bj] = *(const u32x2*)(Tn + off_ + bj * HALF); if (n_br != 0) pv_[bj] = ys[(size_t)(((ai_ * 2 + bj) * 4 + m_) * NTHREADS + tid)]; } } while (0)
        EG_LOAD(0, twc, pvc);
#pragma unroll
        for (int it = 0; it < 8; ++it) { const int ai = it >> 2, m = it & 3; const size_t off = (size_t)(row0 + ai * HALF + m * 16) * DM + col0;
            if (it + 1 < 8) EG_LOAD(it + 1, twn, pvn);
#pragma unroll
            for (int bj = 0; bj < 2; ++bj) {
                const u32x2 tw = twc[bj];
                const f32x2 t0 = __builtin_amdgcn_cvt_pk_f32_fp8((int)tw[0], false), t1 = __builtin_amdgcn_cvt_pk_f32_fp8((int)tw[0], true), t2 = __builtin_amdgcn_cvt_pk_f32_fp8((int)tw[1], false), t3 = __builtin_amdgcn_cvt_pk_f32_fp8((int)tw[1], true);
                const f32x4 a0 = acc[ai][bj][m][0], a1 = acc[ai][bj][m][1];
                float v[8];
                v[0] = sigmoidf_(a0[0]) * t0[0]; v[1] = sigmoidf_(a0[1]) * t0[1]; v[2] = sigmoidf_(a0[2]) * t1[0]; v[3] = sigmoidf_(a0[3]) * t1[1];
                v[4] = sigmoidf_(a1[0]) * t2[0]; v[5] = sigmoidf_(a1[1]) * t2[1]; v[6] = sigmoidf_(a1[2]) * t3[0]; v[7] = sigmoidf_(a1[3]) * t3[1];
                u32x4* sp = ys + (size_t)(((ai * 2 + bj) * 4 + m) * NTHREADS + tid);
                if (n_br != 0) { const u32x4 pv = pvc[bj]; v[0] += bflo(pv.x); v[1] += bfhi(pv.x); v[2] += bflo(pv.y); v[3] += bfhi(pv.y); v[4] += bflo(pv.z); v[5] += bfhi(pv.z); v[6] += bflo(pv.w); v[7] += bfhi(pv.w); }
                if (n_br != 3) { u32x4 w; w.x = cvt_pk_bf16(v[0], v[1]); w.y = cvt_pk_bf16(v[2], v[3]); w.z = cvt_pk_bf16(v[4], v[5]); w.w = cvt_pk_bf16(v[6], v[7]); *sp = w; }
                else { int p0 = 0, p1 = 0; p0 = __builtin_amdgcn_cvt_pk_fp8_f32(v[0], v[1], p0, false); p0 = __builtin_amdgcn_cvt_pk_fp8_f32(v[2], v[3], p0, true);
                    p1 = __builtin_amdgcn_cvt_pk_fp8_f32(v[4], v[5], p1, false); p1 = __builtin_amdgcn_cvt_pk_fp8_f32(v[6], v[7], p1, true);
                    *(u32x2*)(Y + off + bj * HALF) = (u32x2){(unsigned)p0, (unsigned)p1}; }
            }
            twc[0] = twn[0]; twc[1] = twn[1]; pvc[0] = pvn[0]; pvc[1] = pvn[1];
            asm volatile("" ::: "memory"); }
#undef EG_LOAD
    }
};
struct SchedGateCtx {
    int G, c; const char* A; const char* B; size_t a_tile, b_tile;
    __device__ __forceinline__ int a_scale(const Unit&) const { return 0x7F7F7F7F; }
    __device__ __forceinline__ bool next(int i, Unit& u) const {
        if (i > 0 || c >= 64) return false;
        const int tile = c >> 2, n = c & 3; u.pm = ML / BM + (tile >> 3); u.pn = n * 8 + (tile & 7);
        u.a = A + (size_t)u.pm * a_tile; u.b = B + (size_t)u.pn * b_tile; return true;
    }
};
struct EpiGateCtx {
    static constexpr bool PERM = true;
    const unsigned char* T; size_t t_stride; bf16_t* YC;
    __device__ __forceinline__ void operator()(const f32x4 (&acc)[2][2][4][2], const Unit& u, int wr, int wc, int fr, int fq) const {
        const int n_br = u.pn >> 3;
        const int row0 = u.pm * BM + wr * 64 + fr, col0 = (u.pn & 7) * BM + wc * 32 + 8 * fq;
        const unsigned char* Tn = T + (size_t)n_br * t_stride; bf16_t* Yn = YC + (size_t)n_br * MC * DM;
#pragma unroll
        for (int ai = 0; ai < 2; ++ai)
#pragma unroll
            for (int m = 0; m < 4; ++m) { const int row = row0 + ai * HALF + m * 16; const size_t off = (size_t)row * DM + col0, offc = (size_t)(row - ML) * DM + col0;
#pragma unroll
                for (int bj = 0; bj < 2; ++bj) {
                    const u32x2 tw = *(const u32x2*)(Tn + off + bj * HALF);
                    const f32x2 t0 = __builtin_amdgcn_cvt_pk_f32_fp8((int)tw[0], false), t1 = __builtin_amdgcn_cvt_pk_f32_fp8((int)tw[0], true), t2 = __builtin_amdgcn_cvt_pk_f32_fp8((int)tw[1], false), t3 = __builtin_amdgcn_cvt_pk_f32_fp8((int)tw[1], true);
                    const f32x4 a0 = acc[ai][bj][m][0], a1 = acc[ai][bj][m][1];
                    u32x4 w;
                    w.x = cvt_pk_bf16(sigmoidf_(a0[0]) * t0[0], sigmoidf_(a0[1]) * t0[1]); w.y = cvt_pk_bf16(sigmoidf_(a0[2]) * t1[0], sigmoidf_(a0[3]) * t1[1]);
                    w.z = cvt_pk_bf16(sigmoidf_(a1[0]) * t2[0], sigmoidf_(a1[1]) * t2[1]); w.w = cvt_pk_bf16(sigmoidf_(a1[2]) * t3[0], sigmoidf_(a1[3]) * t3[1]);
                    *(u32x4*)(Yn + offc + bj * HALF) = w; }
                asm volatile("" ::: "memory"); }
    }
};

template <class Epi, class Sch, int ELT = 2>
__device__ __forceinline__ void gemm_phase(LAS unsigned char* lds, const Gemm g, const Sch& S, const Epi& E) {
    int tid_ = tid_of_wave(g.wv); asm volatile("" : "+v"(tid_));
    const int tid = tid_, wid = __builtin_amdgcn_readfirstlane(tid >> 6), lane = tid & 63, wr = wid >> 2, wc = wid & 3, fr = lane & 15, fq = lane >> 4;
    const int K = g.K, nt = K * ELT / (BK * 2);
    unsigned voffA[2], voffB[2];
#pragma unroll
    for (int i = 0; i < 2; ++i) { int R, C; stage_rc(tid * 16 + i * 8192, R, C); const int Rb = Epi::PERM ? ((R & ~31) + perm32(R & 31)) : R;
        voffA[i] = (unsigned)(R * g.lda * ELT + C * 2); voffB[i] = (unsigned)(Rb * g.ldb * ELT + C * 2); }
    const size_t kstep = (size_t)(BK * 2);
    const size_t hstepA = (size_t)HALF * g.lda * ELT, hstepB = (size_t)HALF * g.ldb * ELT;
    const unsigned ldsw = (unsigned)wid * 1024u;
    const int aoff = lds_byte(wr * 64 + fr, ELT == 2 ? fq * 8 : fq * 16), boff = lds_byte(wc * 32 + fr, ELT == 2 ? fq * 8 : fq * 16);
#define PG8_SA(b, h) (((b) * 2 + (h)) * HTB)
#define PG8_SB(b, h) ((4 + (b) * 2 + (h)) * HTB)
#define PG8_STAGE(bufoff, gbase, voff) do { _Pragma("unroll") for (int _i = 0; _i < 2; ++_i) \
        __builtin_amdgcn_global_load_lds((const unsigned*)((const char*)(gbase) + (voff)[_i]), (LAS unsigned*)(lds + (bufoff) + ldsw + _i * 8192), 16, 0, 0); } while (0)
#define PG8_LD1(dstf, addr) do { if constexpr (ELT == 2) { (dstf).k[0] = *(const LAS bf16x8*)(lds + (addr)); (dstf).k[1] = *(const LAS bf16x8*)(lds + (addr) + 1024); } \
        else { const u32x4 lo_ = *(const LAS u32x4*)(lds + (addr)), hi_ = *(const LAS u32x4*)(lds + (addr) + 16); \
               (dstf).v = (v8i_t){(int)lo_[0], (int)lo_[1], (int)lo_[2], (int)lo_[3], (int)hi_[0], (int)hi_[1], (int)hi_[2], (int)hi_[3]}; } } while (0)
#define PG8_LDA(dst, b, h) do { _Pragma("unroll") for (int m = 0; m < 4; ++m) PG8_LD1(dst[m], PG8_SA(b, h) + aoff + m * 2048); } while (0)
#define PG8_LDB(dst, b, h) do { _Pragma("unroll") for (int n = 0; n < 2; ++n) PG8_LD1(dst[n], PG8_SB(b, h) + boff + n * 2048); } while (0)
#define PG8_MMA(ai, bj, At, Bt) do { __builtin_amdgcn_s_setprio(1); _Pragma("unroll") for (int m = 0; m < 4; ++m) _Pragma("unroll") for (int n = 0; n < 2; ++n) { \
        if constexpr (ELT == 2) { _Pragma("unroll") for (int k = 0; k < 2; ++k) acc[ai][bj][m][n] = __builtin_amdgcn_mfma_f32_16x16x32_bf16(Bt[n].k[k], At[m].k[k], acc[ai][bj][m][n], 0, 0, 0); } \
        else asm volatile("v_mfma_scale_f32_16x16x128_f8f6f4 %0, %1, %2, %0, %3, %4 op_sel_hi:[0,0,0]" : "+v"(acc[ai][bj][m][n]) : "v"(Bt[n].v), "v"(At[m].v), "v"(scB_), "v"(scA_)); } \
        __builtin_amdgcn_s_setprio(0); } while (0)
#define PG8_WAIT_V(n) asm volatile("s_waitcnt vmcnt(" #n ")" ::: "memory")
#define PG8_WAIT_L(n) asm volatile("s_waitcnt lgkmcnt(" #n ")" ::: "memory")
#define PG8_BAR __builtin_amdgcn_s_barrier()
#define PG8_SCHED __builtin_amdgcn_sched_barrier(0)
    Unit cur, nxt; int ui = 0;
    if (!S.next(0, cur)) return;
    f32x4 acc[2][2][4][2];
#pragma unroll
    for (int a = 0; a < 2; ++a)
#pragma unroll
        for (int b = 0; b < 2; ++b)
#pragma unroll
            for (int m = 0; m < 4; ++m)
#pragma unroll
                for (int n = 0; n < 2; ++n) acc[a][b][m][n] = (f32x4){0.f, 0.f, 0.f, 0.f};
    FragT<ELT> At[4], B0[2], B1[2];
    int scB_ = 0x79797979, scA_ = 0x7F7F7F7F;
    asm volatile("" : "+v"(scB_), "+v"(scA_));
    const char* cA = cur.a; const char* cB = cur.b;
    PG8_STAGE(PG8_SB(0, 0), cB, voffB); PG8_STAGE(PG8_SA(0, 0), cA, voffA); PG8_STAGE(PG8_SB(0, 1), cB + hstepB, voffB); PG8_STAGE(PG8_SA(0, 1), cA + hstepA, voffA);
    if (wr == 1) PG8_BAR;
    PG8_WAIT_V(4); PG8_BAR;
    PG8_STAGE(PG8_SB(1, 0), cB + kstep, voffB); PG8_STAGE(PG8_SA(1, 0), cA + kstep, voffA); PG8_STAGE(PG8_SB(1, 1), cB + hstepB + kstep, voffB);
    PG8_WAIT_V(6); PG8_BAR;
    for (;;) {
        const bool has_next = S.next(ui + 1, nxt);
        const char* nA = has_next ? nxt.a : cA; const char* nB = has_next ? nxt.b : cB;
        if constexpr (ELT == 1) { scA_ = S.a_scale(cur); asm volatile("" : "+v"(scA_)); }
        for (int t = 0; t < nt; t += 2) {
            const bool last = (t == nt - 2);
            const char* a1 = cA + (size_t)(t + 1) * kstep;
            const char* a2 = last ? nA : cA + (size_t)(t + 2) * kstep; const char* b2 = last ? nB : cB + (size_t)(t + 2) * kstep;
            const char* a3 = a2 + kstep; const char* b3 = b2 + kstep;
            PG8_LDB(B0, 0, 0); PG8_SCHED; PG8_LDA(At, 0, 0); PG8_STAGE(PG8_SA(1, 1), a1 + hstepA, voffA);
            PG8_WAIT_L(8); PG8_BAR; PG8_WAIT_L(0); PG8_MMA(0, 0, At, B0); PG8_BAR; PG8_SCHED;
            PG8_LDB(B1, 0, 1); PG8_STAGE(PG8_SB(0, 0), b2, voffB);
            PG8_BAR; PG8_WAIT_L(0); PG8_MMA(0, 1, At, B1); PG8_BAR;
            PG8_LDA(At, 0, 1); PG8_STAGE(PG8_SA(0, 0), a2, voffA);
            PG8_BAR; PG8_WAIT_L(0); PG8_MMA(1, 0, At, B0); PG8_BAR; PG8_SCHED;
            PG8_STAGE(PG8_SB(0, 1), b2 + hstepB, voffB);
            PG8_WAIT_V(6); PG8_BAR; PG8_MMA(1, 1, At, B1); PG8_BAR;
            PG8_LDB(B0, 1, 0); PG8_SCHED; PG8_LDA(At, 1, 0); PG8_STAGE(PG8_SA(0, 1), a2 + hstepA, voffA);
            PG8_WAIT_L(8); PG8_BAR; PG8_WAIT_L(0); PG8_MMA(0, 0, At, B0); PG8_BAR; PG8_SCHED;
            PG8_LDB(B1, 1, 1); PG8_STAGE(PG8_SB(1, 0), b3, voffB);
            PG8_BAR; PG8_WAIT_L(0); PG8_MMA(0, 1, At, B1); PG8_BAR;
            PG8_LDA(At, 1, 1); PG8_STAGE(PG8_SA(1, 0), a3, voffA);
            PG8_BAR; PG8_WAIT_L(0); PG8_MMA(1, 0, At, B0); PG8_BAR; PG8_SCHED;
            PG8_STAGE(PG8_SB(1, 1), b3 + hstepB, voffB);
            PG8_WAIT_V(6); PG8_BAR; PG8_MMA(1, 1, At, B1); PG8_BAR;
        }
        if constexpr (ELT == 1) { PG8_SCHED; asm volatile("s_nop 15\n\ts_nop 15" ::: "memory"); PG8_SCHED; }
        E(acc, cur, wr, wc, fr, fq);
        if (!has_next) break;
#pragma unroll
        for (int a = 0; a < 2; ++a)
#pragma unroll
            for (int b = 0; b < 2; ++b)
#pragma unroll
                for (int m = 0; m < 4; ++m)
#pragma unroll
                    for (int n = 0; n < 2; ++n) acc[a][b][m][n] = (f32x4){0.f, 0.f, 0.f, 0.f};
        cur = nxt; cA = nA; cB = nB; ++ui;
    }
    PG8_WAIT_V(0);
    if (wr == 0) PG8_BAR;
    PG8_BAR;
#undef PG8_SA
#undef PG8_SB
#undef PG8_STAGE
#undef PG8_LD1
#undef PG8_LDA
#undef PG8_LDB
#undef PG8_MMA
#undef PG8_WAIT_V
#undef PG8_WAIT_L
#undef PG8_BAR
#undef PG8_SCHED
}
}

struct Ctx {
    typedef __attribute__((address_space(4))) const unsigned long long* karg_t;
    karg_t tab;
    float* out; unsigned char* ws; LAS unsigned char* lds; int tid, wid, lane, G, bid; int wv;
    __device__ __forceinline__ void fresh() { int t = tid_of_wave(wv); asm volatile("" : "+v"(t)); tid = t; lane = t & 63; wid = __builtin_amdgcn_readfirstlane(t >> 6);
        karg_t tb = (karg_t)__builtin_amdgcn_kernarg_segment_ptr(); asm volatile("" : "+s"(tb)); tab = tb; out = (float*)(__attribute__((address_space(1))) float*)tb[30]; ws = (unsigned char*)(__attribute__((address_space(1))) unsigned char*)tb[31];
        int b_ = blockIdx.x, g_ = gridDim.x; asm volatile("" : "+s"(b_), "+s"(g_)); bid = b_; G = g_; }
    __device__ __forceinline__ const float* inp(int i) const { return (const float*)(__attribute__((address_space(1))) const float*)tab[i]; }
    __device__ __forceinline__ bf16_t* bf(size_t off) const { return (bf16_t*)(ws + off); }
    __device__ __forceinline__ float* f32(size_t off) const { return (float*)(ws + off); }
    __device__ __forceinline__ const float* mod(int l, int v, int k) const { return (const float*)(ws + WS_MOD) + ((size_t)(l * 3 + v) * 6 + k) * DM; }
};

struct TDesc { const float* src; bf16_t* dst; int N, ldd, k0, n0, fp8; };
__device__ __forceinline__ void transpose_load(const Ctx& F, const TDesc& d, f32x4 (&v)[2]) {
    const int tid = F.tid, r = tid >> 4, c4 = (tid & 15) * 4;
#pragma unroll
    for (int i = 0; i < 2; ++i) v[i] = *(const f32x4*)(d.src + (size_t)(d.k0 + r + 32 * i) * d.N + d.n0 + c4);
}
__device__ __forceinline__ void transpose_finish(const Ctx& F, const TDesc& d, const f32x4 (&vv)[2]) {
    LAS float* tile = (LAS float*)F.lds;
    const int tid = F.tid, r = tid >> 4, c4 = (tid & 15) * 4;
    const int N = d.N, ldd = d.ldd, k0 = d.k0, n0 = d.n0; bf16_t* dst = d.dst; (void)N;
#pragma unroll
    for (int i = 0; i < 2; ++i) { const int rr = r + 32 * i; const f32x4 v = vv[i];
        tile[rr * 65 + c4 + 0] = v[0]; tile[rr * 65 + c4 + 1] = v[1]; tile[rr * 65 + c4 + 2] = v[2]; tile[rr * 65 + c4 + 3] = v[3]; }
    __syncthreads();
    if (d.fp8) { if (tid < 256) { const int n = tid >> 2, k16 = (tid & 3) * 16; u32x4 w;
#pragma unroll
            for (int q = 0; q < 4; ++q) { int pk = 0; pk = __builtin_amdgcn_cvt_pk_fp8_f32(tile[(k16 + 4 * q) * 65 + n] * 64.f, tile[(k16 + 4 * q + 1) * 65 + n] * 64.f, pk, false);
                pk = __builtin_amdgcn_cvt_pk_fp8_f32(tile[(k16 + 4 * q + 2) * 65 + n] * 64.f, tile[(k16 + 4 * q + 3) * 65 + n] * 64.f, pk, true); w[q] = (unsigned)pk; }
            *(u32x4*)((unsigned char*)dst + (size_t)(n0 + n) * ldd + k0 + k16) = w; }
        __syncthreads(); return; }
    const int n = tid >> 3, k8 = (tid & 7) * 8;
    float v[8];
#pragma unroll
    for (int j = 0; j < 8; ++j) v[j] = tile[(k8 + j) * 65 + n];
    u32x4 w; w.x = cvt_pk_bf16(v[0], v[1]); w.y = cvt_pk_bf16(v[2], v[3]); w.z = cvt_pk_bf16(v[4], v[5]); w.w = cvt_pk_bf16(v[6], v[7]);
    *(u32x4*)(dst + (size_t)(n0 + n) * ldd + k0 + k8) = w;
    __syncthreads();
}

__device__ __forceinline__ void p0_prologue(const Ctx& F) {
    const int tid = F.tid;
    constexpr int T_WIN = 32 * 59, T_G = 1024, T_B = 256, T_UQ = 72, T_UKV = 64;
    constexpr int O_G = T_WIN, O_B = O_G + 4 * T_G, O_O = O_B + 4 * T_B, O_PQ = O_O + T_G, O_UQ = O_PQ, O_UKV = O_UQ + T_UQ, T_LAYER = O_UKV + T_UKV;
    auto desc = [&](int t) -> TDesc {
        const int l = t / T_LAYER; int j = t % T_LAYER;
        const float* src; bf16_t* dst; int K, N, ldd, fp8 = 0;
        if (j < O_G)        { src = F.inp(I_WIN) + (size_t)l * DM * DIN; dst = (bf16_t*)(F.ws + WS_WIN + (size_t)l * ZLD * DM); K = DM; N = DIN; ldd = DM; fp8 = 1; }
        else if (j < O_B)   { j -= O_G; const int nb = j / T_G; j %= T_G; src = F.inp(I_WGATE) + ((size_t)l * 4 + ((0x1320 >> (4 * nb)) & 3)) * DM * DM; dst = (bf16_t*)(F.ws + WS_WG + ((size_t)l * 4 + nb) * DM * DM); K = DM; N = DM; ldd = DM; fp8 = 1; }
        else if (j < O_O)   { j -= O_B; const int nb = j / T_B; j %= T_B; src = F.inp(I_WBR) + ((size_t)l * 4 + ((0x1320 >> (4 * nb)) & 3)) * 512 * DM; dst = (bf16_t*)(F.ws + WS_WB + ((size_t)l * 4 + nb) * DM * 512); K = 512; N = DM; ldd = 512; fp8 = 1; }
        else if (j < O_PQ)  { j -= O_O; src = F.inp(I_WOUT) + (size_t)l * DM * DM; dst = (bf16_t*)(F.ws + WS_WO + (size_t)l * DM * DM); K = DM; N = DM; ldd = DM; fp8 = 1; }
        else if (j < O_UKV) { j -= O_UQ; src = F.inp(I_WUQ) + (size_t)l * 384 * 768; dst = (bf16_t*)(F.ws + WS_WUQ + (size_t)l * 768 * 512); K = 384; N = 768; ldd = 512; fp8 = 1; }
        else                { j -= O_UKV; src = F.inp(I_WUKV) + (size_t)l * 256 * 1024; dst = (bf16_t*)(F.ws + WS_WUKV + (size_t)l * 1024 * 256); K = 256; N = 1024; ldd = 256; fp8 = 1; }
        (void)K; const int nnt = N / 64; const int tn = j % nnt, tk = j / nnt;
        return TDesc{src, dst, N, ldd, tk * 64, tn * 64, fp8}; };
    { f32x4 vc[2], vn[2] = {}; TDesc dc = desc(F.bid < DEPTH * T_LAYER ? F.bid : 0), dn = dc;
      if (F.bid < DEPTH * T_LAYER) transpose_load(F, dc, vc);
      for (int t = F.bid; t < DEPTH * T_LAYER; t += F.G) {
          if (t + F.G < DEPTH * T_LAYER) { dn = desc(t + F.G); transpose_load(F, dn, vn); }
          transpose_finish(F, dc, vc);
          dc = dn; vc[0] = vn[0]; vc[1] = vn[1]; } }
    const size_t gtid = (size_t)F.bid * NTHREADS + tid, gsz = (size_t)F.G * NTHREADS;
    for (size_t i = gtid; i < (size_t)DEPTH * DM * DM / 8; i += gsz) { const float* sp = F.inp(I_WPQ) + i * 8; const f32x4 a = *(const f32x4*)sp, b = *(const f32x4*)(sp + 4);
        u32x4 w; w.x = cvt_pk_bf16(a[0], a[1]); w.y = cvt_pk_bf16(a[2], a[3]); w.z = cvt_pk_bf16(b[0], b[1]); w.w = cvt_pk_bf16(b[2], b[3]); *(u32x4*)(F.bf(WS_WPQ) + i * 8) = w; }
    for (size_t i = gtid; i < (size_t)DEPTH * 64 * DM / 16; i += gsz) { const size_t l = i / (64 * DM / 16), r = i % (64 * DM / 16);
        *(u32x4*)(F.ws + WS_WIN + (l * ZLD + DIN) * DM + r * 16) = (u32x4){0u, 0u, 0u, 0u}; }
    for (size_t i = gtid; i < (size_t)DEPTH * 768 * 8; i += gsz) *(u32x4*)(F.ws + WS_WUQ + (i >> 3) * 512 + 384 + (i & 7) * 16) = (u32x4){0u, 0u, 0u, 0u};
    if constexpr (PEER_UBITS == 4 && PEER_VBITS == 4) {
        const int nrow = 2 * DEPTH * NEXP, gw = (int)(gtid >> 6), nw = (int)(gsz >> 6), lane = F.lane;
        f32x4 cur[8], nxt[8] = {}, nx2[8] = {};
        auto ld = [&](int r, f32x4 (&d)[8]) { const float* sp = (r < DEPTH * NEXP ? F.inp(I_PU) + (size_t)r * DM : F.inp(I_PV) + (size_t)(r - DEPTH * NEXP) * DM) + lane * 4;
            _Pragma("unroll") for (int q = 0; q < 8; ++q) d[q] = *(const f32x4*)(sp + q * 256); };
        if (gw < nrow) ld(gw, cur);
        if (gw + nw < nrow) ld(gw + nw, nxt);
        for (int r = gw; r < nrow; r += nw) {
            if (r + 2 * nw < nrow) ld(r + 2 * nw, nx2);
            const bool isU = r < DEPTH * NEXP; const float sc = isU ? 90.50966799187809f : 2.0f;
            unsigned char* dst = F.ws + (isU ? WS_PU + (size_t)r * 1024 : WS_PV + (size_t)(r - DEPTH * NEXP) * 1024) + lane * 2;
#pragma unroll
            for (int q = 0; q < 8; ++q) { unsigned w = 0u;
#pragma unroll
                for (int e = 0; e < 4; ++e) { const float y = cur[q][e] * sc; const float ay = fabsf(y);
                    unsigned code = ay < 0.25f ? 0u : ay < 0.75f ? 1u : ay < 1.25f ? 2u : ay < 1.75f ? 3u : ay < 2.5f ? 4u : ay < 3.5f ? 5u : ay < 5.0f ? 6u : 7u;
                    code |= y < 0.f ? 8u : 0u; w |= code << (4 * e); }
                *(unsigned short*)(dst + q * 128) = (unsigned short)w; cur[q] = nxt[q]; nxt[q] = nx2[q]; }
        }
    } else
    { const size_t nch = (size_t)DEPTH * NEXP * 64;
      for (size_t i = gtid; i < 2 * nch; i += gsz) { const bool isU = i < nch; const size_t j = isU ? i : i - nch; const float sc = isU ? 90.50966799187809f : 2.0f;
          const int bits = isU ? PEER_UBITS : PEER_VBITS;
          const float* s = (isU ? F.inp(I_PU) : F.inp(I_PV)) + j * 32; unsigned w[6] = {0u, 0u, 0u, 0u, 0u, 0u};
#pragma unroll
          for (int q = 0; q < 8; ++q) { const f32x4 a = *(const f32x4*)(s + 4 * q);
#pragma unroll
              for (int e = 0; e < 4; ++e) { const float y = a[e] * sc; const int el = q * 4 + e;
                  if (bits == 6) { const float ay = fminf(fabsf(y), 7.5f); unsigned code;
                      if (ay < 1.0f) code = (unsigned)__float2int_rn(ay * 8.0f); else if (ay < 2.0f) code = 8u + (unsigned)__float2int_rn((ay - 1.0f) * 8.0f);
                      else if (ay < 4.0f) code = 16u + (unsigned)__float2int_rn((ay * 0.5f - 1.0f) * 8.0f); else code = 24u + (unsigned)__float2int_rn((ay * 0.25f - 1.0f) * 8.0f);
                      code |= y < 0.f ? 32u : 0u;
                      const int bit = 6 * el, d = bit >> 5, o = bit & 31; w[d] |= code << o; if (o > 26) w[d + 1] |= code >> (32 - o); }
                  else { const float ay = fabsf(y);
                      unsigned code = ay < 0.25f ? 0u : ay < 0.75f ? 1u : ay < 1.25f ? 2u : ay < 1.75f ? 3u : ay < 2.5f ? 4u : ay < 3.5f ? 5u : ay < 5.0f ? 6u : 7u;
                      code |= y < 0.f ? 8u : 0u; w[el >> 3] |= code << (4 * (el & 7)); } } }
          const int rowb = isU ? PEER_UROWB : PEER_VROWB;
          unsigned char* dst = F.ws + (isU ? WS_PU : WS_PV) + (j >> 6) * rowb; const int ln = (int)(j & 63);
          *(u32x4*)(dst + ln * 16) = (u32x4){w[0], w[1], w[2], w[3]}; if (bits == 6) *(u32x2*)(dst + 1024 + ln * 8) = (u32x2){w[4], w[5]}; } }
    for (size_t i = gtid; i < (size_t)DEPTH * 256 * 256; i += gsz) { const int l = (int)(i >> 16), r = (int)(i >> 8) & 255, c = (int)i & 255;
        const float v = ((r >> 7) == (c >> 7)) ? F.inp(I_PKEYS)[(((size_t)l * 2 + (r >> 7)) * 128 + (r & 127)) * 128 + (c & 127)] : 0.f;
        F.bf(WS_KB)[i] = f2bf(v); }
    for (size_t i = gtid; i < (size_t)512 * 1024; i += gsz) { const int n = (int)(i >> 10), kc = (int)i & 1023; const int g = n >> 7, m = n & 127, part = kc >> 9, g2 = (kc >> 7) & 3, c = kc & 127;
        float v = 0.f; if (g == g2) { const float x = (float)((c * m) & 127) * (1.0f / 64.0f); v = part == 0 ? cospif(x) : sinpif(x); }
        (F.ws + WS_WDFT)[i] = f2fp8(v * 64.f); }
    for (size_t i = gtid; i < (size_t)SEQ * 32; i += gsz) { const int pos = (int)(i >> 5), idx = (int)i & 31; const int row = pos >> 6, col = pos & 63;
        const float inv = powf(10000.0f, -(float)(idx & 15) / 16.0f); const float ang = (float)(idx < 16 ? row : col) * inv;
        float s, c; sincosf(ang, &s, &c); F.f32(WS_ROPE)[i * 2] = c; F.f32(WS_ROPE)[i * 2 + 1] = s; }
    { LAS float* sil = (LAS float*)F.lds;
      LAS float* red = sil + 3 * DM;
      const int wid = F.wid, lane = F.lane;
      __syncthreads();
      for (int i = tid; i < 3 * DM; i += NTHREADS) { const int v = i / DM, k = i % DM; const float x = v < 2 ? F.inp(I_C)[v * DM + k] : F.inp(I_CCTX)[k]; sil[i] = x / (1.0f + __expf(-x)); }
      __syncthreads();
      for (int item = F.bid; item < DEPTH * 128; item += F.G) {
          const int l = item / 128, col0 = (item % 128) * 96; const int c4 = ((lane & 31) < 24 ? (lane & 31) : 0) * 4, rsel = lane >> 5;
          const float* w = F.inp(I_WADA) + ((size_t)l * DM + (size_t)wid * 256 + rsel) * (6 * DM) + col0 + c4;
          f32x4 a0 = {0.f, 0.f, 0.f, 0.f}, a1 = a0, a2 = a0;
#pragma unroll 8
          for (int i = 0; i < 128; ++i) { const f32x4 wv = *(const f32x4*)(w + (size_t)(2 * i) * (6 * DM)); const int kk = wid * 256 + 2 * i + rsel;
              a0 += wv * sil[kk]; a1 += wv * sil[DM + kk]; a2 += wv * sil[2 * DM + kk]; }
          LAS float* rp = red + ((wid * 2 + rsel) * 32 + (lane & 31)) * 12;
#pragma unroll
          for (int e = 0; e < 4; ++e) { rp[e] = a0[e]; rp[4 + e] = a1[e]; rp[8 + e] = a2[e]; }
          __syncthreads();
          if (tid < 288) { const int q = tid / 12, j = tid % 12; const int v = j >> 2, e = j & 3; float sacc = 0.f;
#pragma unroll
              for (int p = 0; p < 16; ++p) sacc += red[(p * 32 + q) * 12 + j];
              const int col = col0 + q * 4 + e;
              F.f32(WS_MOD)[(size_t)(l * 3 + v) * 6 * DM + col] = sacc + F.inp(I_BADA)[(size_t)l * 6 * DM + col]; }
          __syncthreads();
      } }
}

__device__ __forceinline__ void norm_rows(const Ctx& F, const float* __restrict__ xl, const float* __restrict__ xc, const float* __restrict__ g, int l, int kshift, int kscale, int nrows, bool fp8copy,
                                          const float* __restrict__ part = nullptr, const float* __restrict__ pgate = nullptr, float* __restrict__ xw = nullptr, bool bf16out = true) {
    for (int row = F.bid * NWAVES + F.wid; row < nrows; row += F.G * NWAVES) {
        const float* xr = row < ML ? xl + (size_t)row * DM : xc + (size_t)(row - ML) * DM;
        const int v = row < ML ? (row >> 13) : 2;
        const float* sh = F.mod(l, v, kshift); const float* sc = F.mod(l, v, kscale);
        f32x4 x[8]; float ss = 0.f;
#pragma unroll
        for (int i = 0; i < 4; ++i) { x[2 * i] = *(const f32x4*)(xr + i * 512 + F.lane * 8); x[2 * i + 1] = *(const f32x4*)(xr + i * 512 + F.lane * 8 + 4); }
        if (part != nullptr && row >= ML) {
#pragma unroll
            for (int i = 0; i < 4; ++i) { const int c = i * 512 + F.lane * 8; f32x4 s0 = {0.f, 0.f, 0.f, 0.f}, s1 = s0;
#pragma unroll
                for (int k = 0; k < 8; ++k) { const float* pp = part + ((size_t)k * MC + (row - ML)) * DM + c; s0 += *(const f32x4*)pp; s1 += *(const f32x4*)(pp + 4); }
                x[2 * i] += *(const f32x4*)(pgate + c) * s0; x[2 * i + 1] += *(const f32x4*)(pgate + c + 4) * s1;
                *(f32x4*)(xw + (size_t)(row - ML) * DM + c) = x[2 * i]; *(f32x4*)(xw + (size_t)(row - ML) * DM + c + 4) = x[2 * i + 1]; } }
#pragma unroll
        for (int i = 0; i < 4; ++i) {
#pragma unroll
            for (int e = 0; e < 4; ++e) ss += x[2 * i][e] * x[2 * i][e] + x[2 * i + 1][e] * x[2 * i + 1][e]; }
        ss = wave_sum(ss);
        const float rs = rsqrtf(ss * (1.0f / DM) + 1e-6f);
        bf16_t* hr = F.bf(WS_HN) + (size_t)row * DM;
#pragma unroll
        for (int i = 0; i < 4; ++i) { const int c = i * 512 + F.lane * 8; float o[8];
#pragma unroll
            for (int h = 0; h < 2; ++h) { const f32x4 gv = *(const f32x4*)(g + c + 4 * h), sv = *(const f32x4*)(sc + c + 4 * h), tv = *(const f32x4*)(sh + c + 4 * h);
#pragma unroll
                for (int e = 0; e < 4; ++e) o[4 * h + e] = (x[2 * i + h][e] * rs * gv[e]) * (1.0f + sv[e]) + tv[e]; }
            u32x4 w; w.x = cvt_pk_bf16(o[0], o[1]); w.y = cvt_pk_bf16(o[2], o[3]); w.z = cvt_pk_bf16(o[4], o[5]); w.w = cvt_pk_bf16(o[6], o[7]);
            if (bf16out) *(u32x4*)(hr + c) = w;
            if (fp8copy) { int p0 = 0, p1 = 0; p0 = __builtin_amdgcn_cvt_pk_fp8_f32(o[0], o[1], p0, false); p0 = __builtin_amdgcn_cvt_pk_fp8_f32(o[2], o[3], p0, true);
                p1 = __builtin_amdgcn_cvt_pk_fp8_f32(o[4], o[5], p1, false); p1 = __builtin_amdgcn_cvt_pk_fp8_f32(o[6], o[7], p1, true);
                *(u32x2*)(F.ws + WS_HN8 + (size_t)row * DM + c) = (u32x2){(unsigned)p0, (unsigned)p1}; } }
    }
}

__device__ __forceinline__ void z_post_rows(const Ctx& F, int l) {
    const float* gq = F.inp(I_GQ) + l * 384; const float* gkv = F.inp(I_GKV) + l * 256;
    for (int row = F.bid * NWAVES + F.wid; row < MT; row += F.G * NWAVES) {
        bf16_t* z = F.bf(WS_Z) + (size_t)row * ZLD; const int lane = F.lane; const bool lat = row < ML;
        const int pos = row & (SEQ - 1); const int d = lane & 31, hv = lane >> 5;
        float q[6], kv[4], x1[5], x2[5]; float sq = 0.f, sk = 0.f, cs = 1.f, sn = 0.f;
#pragma unroll
        for (int i = 0; i < 6; ++i) q[i] = bf2f(z[ZC_QLAT + i * 64 + lane]);
#pragma unroll
        for (int i = 0; i < 4; ++i) kv[i] = bf2f(z[ZC_KVLAT + i * 64 + lane]);
        if (lat) { cs = F.f32(WS_ROPE)[((size_t)pos * 32 + d) * 2]; sn = F.f32(WS_ROPE)[((size_t)pos * 32 + d) * 2 + 1];
#pragma unroll
            for (int s5 = 0; s5 < 5; ++s5) { const int vi = s5 * 2 + hv; const int vo = vi == 0 ? ZC_KROPE : ZC_DK + (vi - 1) * 64;
                x1[s5] = vi < 9 ? bf2f(z[vo + d]) : 0.f; x2[s5] = vi < 9 ? bf2f(z[vo + d + 32]) : 0.f; } }
#pragma unroll
        for (int i = 0; i < 6; ++i) sq += q[i] * q[i];
#pragma unroll
        for (int i = 0; i < 4; ++i) sk += kv[i] * kv[i];
        sq = wave_sum(sq); sk = wave_sum(sk);
        const float rq = rsqrtf(sq * (1.0f / 384.0f) + 1e-6f), rk = rsqrtf(sk * (1.0f / 256.0f) + 1e-6f);
#pragma unroll
        for (int i = 0; i < 6; ++i) { const float v = q[i] * rq * gq[i * 64 + lane]; (F.ws + WS_QL8 + (size_t)row * 512)[i * 64 + lane] = f2fp8(v); }
        (F.ws + WS_QL8 + (size_t)row * 512)[384 + lane] = 0; (F.ws + WS_QL8 + (size_t)row * 512)[448 + lane] = 0;
#pragma unroll
        for (int i = 0; i < 4; ++i) { const float v = kv[i] * rk * gkv[i * 64 + lane]; (F.ws + WS_KVL8 + (size_t)row * 256)[i * 64 + lane] = f2fp8(v); }
        unsigned char* k8 = F.ws + WS_K8 + (size_t)row * 1024 + 128;
        if (lat) {
#pragma unroll
            for (int s5 = 0; s5 < 5; ++s5) { const int vi = s5 * 2 + hv;
                if (vi < 9) { bf16_t* p = z + (vi == 0 ? ZC_KROPE : ZC_DK + (vi - 1) * 64);
                    const float y1 = x1[s5] * cs - x2[s5] * sn, y2 = x2[s5] * cs + x1[s5] * sn;
                    p[d] = f2bf(y1); p[d + 32] = f2bf(y2);
                    const unsigned char e1 = f2fp8(y1), e2 = f2fp8(y2);
                    if (vi == 0) {
#pragma unroll
                        for (int hh = 0; hh < 4; ++hh) { k8[hh * 256 + d] = e1; k8[hh * 256 + d + 32] = e2; } }
                    else { unsigned char* kd = F.ws + WS_KD8 + (size_t)row * 512 + (vi - 1) * 64; kd[d] = e1; kd[d + 32] = e2; } } } }
        else { const unsigned char e = f2fp8(bf2f(z[ZC_KROPE + lane]));
#pragma unroll
            for (int hh = 0; hh < 4; ++hh) k8[hh * 256 + lane] = e;
            unsigned char* kd = F.ws + WS_KD8 + (size_t)row * 512;
#pragma unroll
            for (int i = 0; i < 8; ++i) kd[i * 64 + lane] = f2fp8(bf2f(z[ZC_DK + i * 64 + lane])); }
    }
}

__device__ __forceinline__ void v8t_build(const Ctx& F) {
    const int lane = F.lane;
    for (int item = F.bid * NWAVES + F.wid; item < (MT / 64) * 8; item += F.G * NWAVES) { const int gt = (item >> 2) % (MT / 64), h = item & 3; const bool dif = item >= (MT / 64) * 4;
        const unsigned* src = (dif ? (const unsigned*)(F.bf(WS_Z) + (size_t)gt * 64 * ZLD + ZC_DV + h * 128) : (const unsigned*)(F.bf(WS_KV) + (size_t)gt * 64 * 1024 + h * 256 + 128)) + lane;
        const size_t pitch = dif ? ZLD / 2 : 512;
        unsigned w0[16], w1[16];
#pragma unroll
        for (int i = 0; i < 16; ++i) { w0[i] = 0u; w1[i] = 0u; }
#pragma unroll
        for (int kk = 0; kk < 64; ++kk) { const unsigned v = src[(size_t)kk * pitch];
            const int pos = 32 * ((kk >> 2) & 1) + 16 * (kk >> 5) + (kk & 3) + 4 * ((kk >> 3) & 3);
            const unsigned pk = (unsigned)__builtin_amdgcn_cvt_pk_fp8_f32(bflo(v), bfhi(v), 0, false);
            w0[pos >> 2] |= (pk & 0xFFu) << (8 * (pos & 3)); w1[pos >> 2] |= ((pk >> 8) & 0xFFu) << (8 * (pos & 3)); }
        unsigned char* dst = F.ws + (dif ? WS_VD8T : WS_V8T) + (((size_t)h * (MT / 64) + gt) * 128 + 2 * lane) * 64;
#pragma unroll
        for (int i = 0; i < 4; ++i) { *(u32x4*)(dst + 16 * i) = (u32x4){w0[4 * i], w0[4 * i + 1], w0[4 * i + 2], w0[4 * i + 3]}; *(u32x4*)(dst + 64 + 16 * i) = (u32x4){w1[4 * i], w1[4 * i + 1], w1[4 * i + 2], w1[4 * i + 3]}; }
    }
}

__device__ __forceinline__ void conv_units(const Ctx& F, int l) {
    LAS float* u = (LAS float*)F.lds;
    LAS float* y = u + 94 * 128;
    int tid_ = tid_of_wave(F.wid); asm volatile("" : "+v"(tid_)); const int tid = tid_;
    constexpr int NT_L = ML / 64, NT_ALL = MT / 64;
    const int ntile = l == 0 ? NT_ALL : NT_L;
    const int un0 = (F.bid + 58) % F.G;
    if (un0 >= ntile * 4) return;
    int grp_w = un0 & 3;
    const int ch = tid & 127, tq = tid >> 7, lane = tid & 63;
    float w[31], bias, g0, g1, b0, b1;
    auto load_w = [&](int grp) { const int cg = grp * 128 + ch;
        _Pragma("unroll") for (int j = 0; j < 31; ++j) w[j] = F.inp(I_WDW)[((size_t)l * 31 + j) * 512 + cg];
        bias = F.inp(I_BDW)[l * 512 + cg];
        g0 = F.inp(I_GCN)[l * 512 + grp * 128 + lane]; g1 = F.inp(I_GCN)[l * 512 + grp * 128 + 64 + lane];
        b0 = F.inp(I_BCN)[l * 512 + grp * 128 + lane]; b1 = F.inp(I_BCN)[l * 512 + grp * 128 + 64 + lane]; };
    load_w(grp_w);
    auto geom = [&](int un, int& rowbase, int& n0, int& L) { const int tile = un >> 2;
        if (tile < NT_L) { const int b = tile >> 7; rowbase = b * SEQ; n0 = (tile & 127) * 64; L = SEQ; } else { const int t2 = tile - NT_L; const int b = t2 >> 2; rowbase = ML + b * CTXL; n0 = (t2 & 3) * 64; L = CTXL; } };
    u32x4 pa[3], pg[3];
    auto fetch = [&](int un) { int rowbase, n0, L; geom(un, rowbase, n0, L); const int grp = un & 3;
        _Pragma("unroll") for (int i = 0; i < 3; ++i) { const int p = tid + i * NTHREADS; const int r = p >> 4, c8 = (p & 15) * 8; const int n = n0 - 15 + r;
            pa[i] = (u32x4){0u, 0u, 0u, 0u}; pg[i] = pa[i];
            if (p < 94 * 16 && n >= 0 && n < L) { const bf16_t* zp = F.bf(WS_Z) + (size_t)(rowbase + n) * ZLD + ZC_C + grp * 128 + c8; pa[i] = *(const u32x4*)zp; pg[i] = *(const u32x4*)(zp + 512); } } };
    fetch(un0);
    for (int un = un0; un < ntile * 4; un += F.G) {
        const int grp = un & 3; int rowbase, n0, L; geom(un, rowbase, n0, L);
        if (grp != grp_w) { grp_w = grp; load_w(grp); }
        __syncthreads();
#pragma unroll
        for (int i = 0; i < 3; ++i) { const int p = tid + i * NTHREADS; const int r = p >> 4, c8 = (p & 15) * 8;
            if (p < 94 * 16) { const u32x4 a = pa[i], g = pg[i];
                f32x4 o0, o1;
                o0[0] = bflo(a.x) * sigmoidf_(bflo(g.x)); o0[1] = bfhi(a.x) * sigmoidf_(bfhi(g.x)); o0[2] = bflo(a.y) * sigmoidf_(bflo(g.y)); o0[3] = bfhi(a.y) * sigmoidf_(bfhi(g.y));
                o1[0] = bflo(a.z) * sigmoidf_(bflo(g.z)); o1[1] = bfhi(a.z) * sigmoidf_(bfhi(g.z)); o1[2] = bflo(a.w) * sigmoidf_(bflo(g.w)); o1[3] = bfhi(a.w) * sigmoidf_(bfhi(g.w));
                *(LAS f32x4*)(u + r * 128 + c8) = o0; *(LAS f32x4*)(u + r * 128 + c8 + 4) = o1; } }
        if (un + F.G < ntile * 4) fetch(un + F.G);
        __syncthreads();
        {
          float uw[46];
#pragma unroll
          for (int i = 0; i < 46; ++i) uw[i] = u[(tq * 16 + i) * 128 + ch];
#pragma unroll
          for (int t = 0; t < 16; ++t) { float a = bias;
#pragma unroll
              for (int j = 0; j < 31; ++j) a = fmaf(uw[t + j], w[j], a);
              y[(tq * 16 + t) * 128 + ch] = a; } }
        __syncthreads();
        { const int tb = F.wid * 8;
#pragma unroll
          for (int i = 0; i < 8; ++i) { const int t = tb + i; const float v0 = y[t * 128 + lane], v1 = y[t * 128 + 64 + lane];
              const float mu = wave_sum(v0 + v1) * (1.0f / 128.0f); const float d0 = v0 - mu, d1 = v1 - mu;
              const float var = wave_sum(d0 * d0 + d1 * d1) * (1.0f / 128.0f); const float rs = rsqrtf(var + 1e-5f);
              const float y0 = d0 * rs * g0 + b0, y1 = d1 * rs * g1 + b1;
              unsigned char* o = F.ws + WS_BR + ((size_t)1 * MT + rowbase + n0 + t) * 512 + grp * 128;
              o[lane] = f2fp8(y0 * sigmoidf_(y0)); o[64 + lane] = f2fp8(y1 * sigmoidf_(y1)); } }
    }
    __syncthreads();
}

namespace att {
#define SBAR() __builtin_amdgcn_sched_barrier(0)
__device__ __forceinline__ int crow(int r, int hi) { return (r & 3) + 8 * (r >> 2) + 4 * hi; }
template <int OFF> __device__ __forceinline__ s16x4 tr_read(int vb) { s16x4 r; asm volatile("ds_read_b64_tr_b16 %0, %1 offset:%2" : "=&v"(r) : "v"(vb), "i"(OFF) : "memory"); return r; }
__device__ __forceinline__ int v_rd_base(int lane) { return ((lane & 3) << 3) | (((lane >> 2) & 3) << 6) | (((lane >> 4) & 1) << 5) | (((lane >> 5) & 1) << 8); }
constexpr int v_rd_off(int d0, int ks, int half) { return d0 * 512 + ks * 4096 + half * 2048; }
template <int D0> __device__ __forceinline__ void pv_one(f32x16& od, int vb, bf16x8 pa0, bf16x8 pa1, bf16x8 pa2, bf16x8 pa3) {
    const s16x4 l0 = tr_read<v_rd_off(D0, 0, 0)>(vb), h0 = tr_read<v_rd_off(D0, 0, 1)>(vb), l1 = tr_read<v_rd_off(D0, 1, 0)>(vb), h1 = tr_read<v_rd_off(D0, 1, 1)>(vb);
    const s16x4 l2 = tr_read<v_rd_off(D0, 2, 0)>(vb), h2 = tr_read<v_rd_off(D0, 2, 1)>(vb), l3 = tr_read<v_rd_off(D0, 3, 0)>(vb), h3 = tr_read<v_rd_off(D0, 3, 1)>(vb);
    asm volatile("s_waitcnt lgkmcnt(0)" ::: "memory"); SBAR();
#define PK(L, H) (bf16x8){L[0], L[1], L[2], L[3], H[0], H[1], H[2], H[3]}
    od = __builtin_amdgcn_mfma_f32_32x32x16_bf16(pa0, PK(l0, h0), od, 0, 0, 0);
    od = __builtin_amdgcn_mfma_f32_32x32x16_bf16(pa1, PK(l1, h1), od, 0, 0, 0);
    od = __builtin_amdgcn_mfma_f32_32x32x16_bf16(pa2, PK(l2, h2), od, 0, 0, 0);
    od = __builtin_amdgcn_mfma_f32_32x32x16_bf16(pa3, PK(l3, h3), od, 0, 0, 0);
#undef PK
}
__device__ __forceinline__ void pv_d0(f32x16* o, int vb, bf16x8 pa0, bf16x8 pa1, bf16x8 pa2, bf16x8 pa3) {
    pv_one<0>(o[0], vb, pa0, pa1, pa2, pa3); pv_one<1>(o[1], vb, pa0, pa1, pa2, pa3); pv_one<2>(o[2], vb, pa0, pa1, pa2, pa3); pv_one<3>(o[3], vb, pa0, pa1, pa2, pa3);
}
template <int D0> __device__ __forceinline__ void pv_one2(f32x16& od0, f32x16& od1, int vb, bf16x8 a0, bf16x8 a1, bf16x8 a2, bf16x8 a3, bf16x8 b0, bf16x8 b1, bf16x8 b2, bf16x8 b3) {
    const s16x4 l0 = tr_read<v_rd_off(D0, 0, 0)>(vb), h0 = tr_read<v_rd_off(D0, 0, 1)>(vb), l1 = tr_read<v_rd_off(D0, 1, 0)>(vb), h1 = tr_read<v_rd_off(D0, 1, 1)>(vb);
    const s16x4 l2 = tr_read<v_rd_off(D0, 2, 0)>(vb), h2 = tr_read<v_rd_off(D0, 2, 1)>(vb), l3 = tr_read<v_rd_off(D0, 3, 0)>(vb), h3 = tr_read<v_rd_off(D0, 3, 1)>(vb);
    asm volatile("s_waitcnt lgkmcnt(0)" ::: "memory"); SBAR();
#define PK(L, H) (bf16x8){L[0], L[1], L[2], L[3], H[0], H[1], H[2], H[3]}
    const bf16x8 v0 = PK(l0, h0), v1 = PK(l1, h1), v2 = PK(l2, h2), v3 = PK(l3, h3);
    od0 = __builtin_amdgcn_mfma_f32_32x32x16_bf16(a0, v0, od0, 0, 0, 0); od1 = __builtin_amdgcn_mfma_f32_32x32x16_bf16(b0, v0, od1, 0, 0, 0);
    od0 = __builtin_amdgcn_mfma_f32_32x32x16_bf16(a1, v1, od0, 0, 0, 0); od1 = __builtin_amdgcn_mfma_f32_32x32x16_bf16(b1, v1, od1, 0, 0, 0);
    od0 = __builtin_amdgcn_mfma_f32_32x32x16_bf16(a2, v2, od0, 0, 0, 0); od1 = __builtin_amdgcn_mfma_f32_32x32x16_bf16(b2, v2, od1, 0, 0, 0);
    od0 = __builtin_amdgcn_mfma_f32_32x32x16_bf16(a3, v3, od0, 0, 0, 0); od1 = __builtin_amdgcn_mfma_f32_32x32x16_bf16(b3, v3, od1, 0, 0, 0);
#undef PK
}
typedef int v8i_att_t __attribute__((ext_vector_type(8)));
__device__ __forceinline__ void softmax_tile8(f32x16& p0, f32x16& p1, float C, float& m_reg, float& l_reg, float& alpha, v8i_att_t& pa) {
    float pmax = p0[0];
#pragma unroll
    for (int r = 1; r < 16; ++r) pmax = fmaxf(pmax, p0[r]);
#pragma unroll
    for (int r = 0; r < 16; ++r) pmax = fmaxf(pmax, p1[r]);
    { auto rr = __builtin_amdgcn_permlane32_swap(__float_as_uint(pmax), __float_as_uint(pmax), false, false); pmax = fmaxf(__uint_as_float(rr[0]), __uint_as_float(rr[1])); }
    float mn;
    if (__builtin_expect(__all((pmax - m_reg) * C <= 8.5f), 1)) { mn = m_reg; alpha = 1.f; }
    else { mn = fmaxf(m_reg, pmax); alpha = __builtin_amdgcn_exp2f((m_reg - mn) * C); m_reg = mn; }
    const float mnC = -mn * C;
#pragma unroll
    for (int r = 0; r < 16; ++r) { p0[r] = __builtin_amdgcn_exp2f(fmaf(p0[r], C, mnC)); p1[r] = __builtin_amdgcn_exp2f(fmaf(p1[r], C, mnC)); }
    float ps = 0.f;
#pragma unroll
    for (int r = 0; r < 16; ++r) ps += p0[r] + p1[r];
    { auto rr = __builtin_amdgcn_permlane32_swap(__float_as_uint(ps), __float_as_uint(ps), false, false); ps = __uint_as_float(rr[0]) + __uint_as_float(rr[1]); }
    l_reg = l_reg * alpha + ps;
#pragma unroll
    for (int w = 0; w < 4; ++w) { int a_ = 0, b_ = 0;
        a_ = __builtin_amdgcn_cvt_pk_fp8_f32(p0[4 * w], p0[4 * w + 1], a_, false); a_ = __builtin_amdgcn_cvt_pk_fp8_f32(p0[4 * w + 2], p0[4 * w + 3], a_, true);
        b_ = __builtin_amdgcn_cvt_pk_fp8_f32(p1[4 * w], p1[4 * w + 1], b_, false); b_ = __builtin_amdgcn_cvt_pk_fp8_f32(p1[4 * w + 2], p1[4 * w + 3], b_, true);
        pa[w] = a_; pa[4 + w] = b_; }
}
__device__ __forceinline__ void softmax_tile(f32x16& p0, f32x16& p1, float C, float& m_reg, float& l_reg, float& alpha, bf16x8& pa0, bf16x8& pa1, bf16x8& pa2, bf16x8& pa3) {
    float pmax = p0[0];
#pragma unroll
    for (int r = 1; r < 16; ++r) pmax = fmaxf(pmax, p0[r]);
#pragma unroll
    for (int r = 0; r < 16; ++r) pmax = fmaxf(pmax, p1[r]);
    { auto rr = __builtin_amdgcn_permlane32_swap(__float_as_uint(pmax), __float_as_uint(pmax), false, false); pmax = fmaxf(__uint_as_float(rr[0]), __uint_as_float(rr[1])); }
    float mn;
    if (__builtin_expect(__all((pmax - m_reg) * C <= 11.541560327111707f), 1)) { mn = m_reg; alpha = 1.f; }
    else { mn = fmaxf(m_reg, pmax); alpha = __builtin_amdgcn_exp2f((m_reg - mn) * C); m_reg = mn; }
    const float mnC = -mn * C;
#pragma unroll
    for (int r = 0; r < 16; ++r) { p0[r] = __builtin_amdgcn_exp2f(fmaf(p0[r], C, mnC)); p1[r] = __builtin_amdgcn_exp2f(fmaf(p1[r], C, mnC)); }
    float ps = 0.f;
#pragma unroll
    for (int r = 0; r < 16; ++r) ps += p0[r] + p1[r];
    { auto rr = __builtin_amdgcn_permlane32_swap(__float_as_uint(ps), __float_as_uint(ps), false, false); ps = __uint_as_float(rr[0]) + __uint_as_float(rr[1]); }
    l_reg = l_reg * alpha + ps;
#define PK4(P, BASE, OUT) do { unsigned a0 = cvt_pk_bf16(P[BASE + 0], P[BASE + 1]), a1 = cvt_pk_bf16(P[BASE + 2], P[BASE + 3]);   \
    unsigned b0 = cvt_pk_bf16(P[BASE + 4], P[BASE + 5]), b1 = cvt_pk_bf16(P[BASE + 6], P[BASE + 7]);                              \
    auto r0 = __builtin_amdgcn_permlane32_swap(a0, b0, false, false); auto r1 = __builtin_amdgcn_permlane32_swap(a1, b1, false, false); \
    u32x4 w = {r0[0], r1[0], r0[1], r1[1]}; OUT = *reinterpret_cast<bf16x8*>(&w); } while (0)
    PK4(p0, 0, pa0); PK4(p0, 8, pa1); PK4(p1, 0, pa2); PK4(p1, 8, pa3);
#undef PK4
}
__device__ __forceinline__ void rope_pair(bf16x8& x1, bf16x8& x2, const float* __restrict__ cs) {
    float c[16];
#pragma unroll
    for (int i = 0; i < 4; ++i) { const f32x4 v = *(const f32x4*)(cs + 4 * i); c[4 * i] = v[0]; c[4 * i + 1] = v[1]; c[4 * i + 2] = v[2]; c[4 * i + 3] = v[3]; }
#pragma unroll
    for (int j = 0; j < 8; ++j) { const float a = bf2f((bf16_t)x1[j]), b = bf2f((bf16_t)x2[j]);
        x1[j] = (short)f2bf(a * c[2 * j] - b * c[2 * j + 1]); x2[j] = (short)f2bf(b * c[2 * j] + a * c[2 * j + 1]); }
}

constexpr int SHM_V = 64 * 128 * 2;
template <int MODE>
__device__ __forceinline__ void attn_unit(const Ctx& F, int l, int b, int h, int qb) {
    constexpr int NKS = MODE == 0 ? 12 : 8;
    constexpr int RB = MODE == 0 ? 192 + 16 : 128 + 16;
    constexpr int SHM_K = 64 * RB;
    constexpr int PPR = RB / 16;
    constexpr int NKF = 64 * PPR / NTHREADS;
    constexpr int NXW = (64 * PPR - NKF * NTHREADS) / 64;
    int tid_ = F.tid; asm volatile("" : "+v"(tid_));
    const int tid = tid_, wid = F.wid, lane = tid & 63, r32 = lane & 31, hi = lane >> 5;
    constexpr int SHMV = 128 * 80;
    LAS unsigned char* Kl = F.lds; LAS unsigned char* Vl = F.lds + 2 * SHM_K;
    LAS float* wsc = (LAS float*)(F.lds + 2 * SHM_K + 2 * SHMV) + wid * 512;
    LAS unsigned char* Ql = F.lds + 2 * SHM_K + 2 * SHMV + 16384 + wid * 8192 + lane * 16;
    const bool lat = qb < 32;
    const int NT = lat ? (CTXL + SEQ) / 64 : CTXL / 64;
    const bf16_t* Zb = F.bf(WS_Z);
    const char* wsb = (const char*)F.ws;
    static_assert(64 * PPR == NKF * NTHREADS + NXW * 64, "K tile pieces");
    auto k_off = [&](int i, size_t rb, int tl) -> size_t { const int s = i * NTHREADS + tl; const int row = s / PPR, q = s % PPR; const int lp = q == PPR - 1 ? 0 : q;
        if (MODE == 0) return WS_K8 + ((rb + row) * 4 + h) * 256 + lp * 16;
        return WS_KD8 + ((rb + row) * 4 + h) * 128 + lp * 16; };
    auto v8_off = [&](int i, size_t rb, int tl) -> size_t { const int s = i * NTHREADS + tl; const int d = s / 5, q = s % 5;
        return (MODE == 0 ? WS_V8T : WS_VD8T) + (((size_t)h * (MT / 64) + rb / 64) * 128 + d) * 64 + (q == 4 ? 0 : q) * 16; };
    auto v_off = [&](int i, size_t rb, int tl) -> size_t { const int s = i * NTHREADS + tl; const int sub = s >> 5; const int kk = (sub >> 2) * 8 + ((s & 31) >> 2);
        const int k = (kk & ~0xC) | ((kk & 4) << 1) | ((kk & 8) >> 1); const int c = (sub & 3) * 32 + (s & 3) * 8;
        return MODE == 0 ? WS_KV + ((rb + k) * 1024 + h * 256 + 128 + c) * 2 : WS_Z + ((rb + k) * ZLD + ZC_DV + h * 128 + c) * 2; };
#define ATT_ROWBASE(j) ((j) < 4 ? (ML + b * CTXL + (j) * 64) : (b * SEQ + ((j) - 4) * 64))
#define ATT_STAGE(j, buf) do { const size_t _rb = (size_t)ATT_ROWBASE(j); int _tl = tid; asm volatile("" : "+v"(_tl)); \
    _Pragma("unroll") for (int _i = 0; _i < NKF; ++_i) __builtin_amdgcn_global_load_lds((const unsigned*)(wsb + k_off(_i, _rb, _tl)), (LAS unsigned*)(Kl + (buf) * SHM_K + (_i * NTHREADS + wid * 64) * 16), 16, 0, 0); \
    if (wid < NXW) __builtin_amdgcn_global_load_lds((const unsigned*)(wsb + k_off(NKF, _rb, _tl)), (LAS unsigned*)(Kl + (buf) * SHM_K + (NKF * NTHREADS + wid * 64) * 16), 16, 0, 0); \
    if constexpr (true) {   \
        __builtin_amdgcn_global_load_lds((const unsigned*)(wsb + v8_off(0, _rb, _tl)), (LAS unsigned*)(Vl + (buf) * SHMV + (wid * 64) * 16), 16, 0, 0); \
        if (wid < 2) __builtin_amdgcn_global_load_lds((const unsigned*)(wsb + v8_off(1, _rb, _tl)), (LAS unsigned*)(Vl + (buf) * SHMV + (NTHREADS + wid * 64) * 16), 16, 0, 0); } \
    else { _Pragma("unroll") for (int _i = 0; _i < 2; ++_i) __builtin_amdgcn_global_load_lds((const unsigned*)(wsb + v_off(_i, _rb, _tl)), (LAS unsigned*)(Vl + (buf) * SHMV + (_i * NTHREADS + wid * 64) * 16), 16, 0, 0); } } while (0)
    __syncthreads();
    ATT_STAGE(0, 0);
    const int qrow = lat ? b * SEQ + qb * 256 + wid * 32 + r32 : ML + b * CTXL + wid * 32 + r32;
    bf16x8 qr[NKS];
    { const bf16_t* qp = MODE == 0 ? F.bf(WS_Q) + (size_t)qrow * 768 + h * 192 + hi * 8 : Zb + (size_t)qrow * ZLD + ZC_DQ + h * 128 + hi * 8;
#pragma unroll
      for (int d0 = 0; d0 < NKS; ++d0) qr[d0] = *(const bf16x8*)(qp + d0 * 16);
      if (lat) { const float* rp = F.f32(WS_ROPE) + ((size_t)(qb * 256 + wid * 32 + r32) * 32 + hi * 8) * 2;
          if (MODE == 0) { rope_pair(qr[8], qr[10], rp); rope_pair(qr[9], qr[11], rp + 32); }
          else { rope_pair(qr[0], qr[2], rp); rope_pair(qr[1], qr[3], rp + 32); rope_pair(qr[4], qr[6], rp); rope_pair(qr[5], qr[7], rp + 32); } }
    }
    typedef int v8i_t __attribute__((ext_vector_type(8)));
    constexpr int NS8 = MODE == 0 ? 3 : 2;
    v8i_t q8[3];
    {
#pragma unroll
        for (int s_ = 0; s_ < NS8; ++s_) { unsigned P[4][2];
#pragma unroll
            for (int dd = 0; dd < 4; ++dd) { const bf16x8 v = qr[4 * s_ + dd]; float f[8];
#pragma unroll
                for (int j = 0; j < 8; ++j) f[j] = bf2f((bf16_t)v[j]);
                int a_ = 0, b_ = 0; a_ = __builtin_amdgcn_cvt_pk_fp8_f32(f[0], f[1], a_, false); a_ = __builtin_amdgcn_cvt_pk_fp8_f32(f[2], f[3], a_, true);
                b_ = __builtin_amdgcn_cvt_pk_fp8_f32(f[4], f[5], b_, false); b_ = __builtin_amdgcn_cvt_pk_fp8_f32(f[6], f[7], b_, true); P[dd][0] = (unsigned)a_; P[dd][1] = (unsigned)b_; }
            auto r00 = __builtin_amdgcn_permlane32_swap(P[0][0], P[2][0], false, false); auto r01 = __builtin_amdgcn_permlane32_swap(P[0][1], P[2][1], false, false);
            auto r10 = __builtin_amdgcn_permlane32_swap(P[1][0], P[3][0], false, false); auto r11 = __builtin_amdgcn_permlane32_swap(P[1][1], P[3][1], false, false);
            q8[s_] = (v8i_t){(int)r00[0], (int)r01[0], (int)r00[1], (int)r01[1], (int)r10[0], (int)r11[0], (int)r10[1], (int)r11[1]};
            if (MODE == 1) { *(LAS u32x4*)(Ql + (2 * s_) * 1024) = (u32x4){(unsigned)q8[s_][0], (unsigned)q8[s_][1], (unsigned)q8[s_][2], (unsigned)q8[s_][3]};
                             *(LAS u32x4*)(Ql + (2 * s_ + 1) * 1024) = (u32x4){(unsigned)q8[s_][4], (unsigned)q8[s_][5], (unsigned)q8[s_][6], (unsigned)q8[s_][7]}; } } }
    int sc1_ = 0x7F7F7F7F; asm volatile("" : "+v"(sc1_));
    constexpr float LOG2E = 1.4426950408889634f;
    const float C = (MODE == 0 ? 0.07216878364870322f : 0.125f) * LOG2E;
    constexpr int NACC = MODE == 0 ? 1 : 2;
    f32x16 o[NACC][4]; float m_reg[NACC], l_reg[NACC];
#pragma unroll
    for (int a = 0; a < NACC; ++a) { float mi = -1e30f, li = 0.f; asm volatile("" : "+v"(mi), "+v"(li));
        m_reg[a] = mi; l_reg[a] = li; if (MODE == 1) { wsc[64 + 4 * lane + 2 * a] = mi; wsc[64 + 4 * lane + 2 * a + 1] = li; }
#pragma unroll
        for (int d = 0; d < 4; ++d) o[a][d] = f32x16{}; }
    const int vb0 = (int)(uintptr_t)Vl + v_rd_base(lane);
    asm volatile("s_waitcnt vmcnt(0)" ::: "memory"); __syncthreads();
    v8i_att_t keep8 = {};
    for (int j = 0; j < NT; ++j) {
        const int buf = j & 1;
        if (j + 1 < NT) ATT_STAGE(j + 1, buf ^ 1);
        const LAS unsigned char* Ks = Kl + buf * SHM_K;
#pragma unroll
        for (int a = 0; a < NACC; ++a) {
            f32x16 p0 = f32x16{}, p1 = f32x16{};
            {
                constexpr int NSQ = MODE == 0 ? 3 : 1;
#pragma unroll
                for (int s_ = 0; s_ < NSQ; ++s_) { const LAS unsigned char* kp = Ks + r32 * RB + (MODE == 0 ? s_ : a) * 64 + hi * 32;
                    const u32x4 a0_ = *(const LAS u32x4*)kp, a1_ = *(const LAS u32x4*)(kp + 16), c0_ = *(const LAS u32x4*)(kp + 32 * RB), c1_ = *(const LAS u32x4*)(kp + 32 * RB + 16);
                    const v8i_t b0 = (v8i_t){(int)a0_[0], (int)a0_[1], (int)a0_[2], (int)a0_[3], (int)a1_[0], (int)a1_[1], (int)a1_[2], (int)a1_[3]};
                    const v8i_t b1 = (v8i_t){(int)c0_[0], (int)c0_[1], (int)c0_[2], (int)c0_[3], (int)c1_[0], (int)c1_[1], (int)c1_[2], (int)c1_[3]};
                    v8i_t qf;
                    if (MODE == 0) qf = q8[s_];
                    else { const u32x4 q0_ = *(const LAS u32x4*)(Ql + (2 * a) * 1024), q1_ = *(const LAS u32x4*)(Ql + (2 * a + 1) * 1024);
                        qf = (v8i_t){(int)q0_[0], (int)q0_[1], (int)q0_[2], (int)q0_[3], (int)q1_[0], (int)q1_[1], (int)q1_[2], (int)q1_[3]}; }
                    asm volatile("v_mfma_scale_f32_32x32x64_f8f6f4 %0, %1, %2, %0, %3, %4 op_sel_hi:[0,0,0]" : "+v"(p0) : "v"(b0), "v"(qf), "v"(sc1_), "v"(sc1_));
                    asm volatile("v_mfma_scale_f32_32x32x64_f8f6f4 %0, %1, %2, %0, %3, %4 op_sel_hi:[0,0,0]" : "+v"(p1) : "v"(b1), "v"(qf), "v"(sc1_), "v"(sc1_)); }
                asm volatile("s_nop 15\n\ts_nop 7" : "+v"(p0), "+v"(p1));
                SBAR();
            }
            float alpha; bf16x8 pa0, pa1, pa2, pa3; v8i_att_t pa8;
            if (MODE == 1) { float mm = wsc[64 + 4 * lane + 2 * a], ll = wsc[64 + 4 * lane + 2 * a + 1];
                softmax_tile8(p0, p1, C, mm, ll, alpha, pa8); wsc[64 + 4 * lane + 2 * a] = mm; wsc[64 + 4 * lane + 2 * a + 1] = ll; }
            else if (MODE == 0) softmax_tile8(p0, p1, C, m_reg[a], l_reg[a], alpha, pa8);
            else softmax_tile(p0, p1, C, m_reg[a], l_reg[a], alpha, pa0, pa1, pa2, pa3);
            if (__any(alpha < 1.f)) { if (hi == 0) wsc[r32] = alpha; asm volatile("s_waitcnt lgkmcnt(0)" ::: "memory");
#pragma unroll
                for (int r = 0; r < 16; ++r) { const float al = wsc[crow(r, hi)];
#pragma unroll
                    for (int d = 0; d < 4; ++d) o[a][d][r] *= al; } }
            SBAR();
            if constexpr (MODE == 0) {
#pragma unroll
                for (int d0 = 0; d0 < 4; ++d0) { const LAS unsigned char* vp = Vl + buf * SHMV + (d0 * 32 + r32) * 80 + hi * 32;
                    const u32x4 v0_ = *(const LAS u32x4*)vp, v1_ = *(const LAS u32x4*)(vp + 16);
                    const v8i_t vf = (v8i_t){(int)v0_[0], (int)v0_[1], (int)v0_[2], (int)v0_[3], (int)v1_[0], (int)v1_[1], (int)v1_[2], (int)v1_[3]};
                    asm volatile("v_mfma_scale_f32_32x32x64_f8f6f4 %0, %1, %2, %0, %3, %4 op_sel_hi:[0,0,0]" : "+v"(o[a][d0]) : "v"(pa8), "v"(vf), "v"(sc1_), "v"(sc1_)); } }
            else { if (a == 0) keep8 = pa8;
                   else {
#pragma unroll
                       for (int d0 = 0; d0 < 4; ++d0) { const LAS unsigned char* vp = Vl + buf * SHMV + (d0 * 32 + r32) * 80 + hi * 32;
                           const u32x4 v0_ = *(const LAS u32x4*)vp, v1_ = *(const LAS u32x4*)(vp + 16);
                           const v8i_t vf = (v8i_t){(int)v0_[0], (int)v0_[1], (int)v0_[2], (int)v0_[3], (int)v1_[0], (int)v1_[1], (int)v1_[2], (int)v1_[3]};
                           asm volatile("v_mfma_scale_f32_32x32x64_f8f6f4 %0, %1, %2, %0, %3, %4 op_sel_hi:[0,0,0]" : "+v"(o[0][d0]) : "v"(keep8), "v"(vf), "v"(sc1_), "v"(sc1_));
                           asm volatile("v_mfma_scale_f32_32x32x64_f8f6f4 %0, %1, %2, %0, %3, %4 op_sel_hi:[0,0,0]" : "+v"(o[NACC - 1][d0]) : "v"(pa8), "v"(vf), "v"(sc1_), "v"(sc1_)); } } }
        }
        asm volatile("s_waitcnt vmcnt(0)" ::: "memory"); __syncthreads();
    }
    if constexpr (MODE == 0) { asm volatile("s_nop 15\n\ts_nop 7" : "+v"(o[0][0]), "+v"(o[0][1]), "+v"(o[0][2]), "+v"(o[0][3])); SBAR(); }
    else { asm volatile("s_nop 15\n\ts_nop 7" : "+v"(o[0][0]), "+v"(o[0][1]), "+v"(o[0][2]), "+v"(o[0][3]), "+v"(o[NACC - 1][0]), "+v"(o[NACC - 1][1]), "+v"(o[NACC - 1][2]), "+v"(o[NACC - 1][3])); SBAR(); }
    const int orow0 = lat ? b * SEQ + qb * 256 + wid * 32 : ML + b * CTXL + wid * 32;
    if (MODE == 0) {
        if (hi == 0) wsc[32 + r32] = l_reg[0]; asm volatile("s_waitcnt lgkmcnt(0)" ::: "memory");
        unsigned char* Ob = F.ws + WS_BR + (size_t)orow0 * 512 + h * 128;
#pragma unroll
        for (int r = 0; r < 16; ++r) { const int orow = crow(r, hi); const float rl = 64.f * __builtin_amdgcn_rcpf(wsc[32 + orow]);
#pragma unroll
            for (int d0 = 0; d0 < 4; ++d0) Ob[(size_t)orow * 512 + d0 * 32 + r32] = f2fp8(o[0][d0][r] * rl); }
    } else {
        const float lam_init = l == 0 ? 0.2f : 0.35550906759060355f;
        const float s1 = wave_sum(F.inp(I_LQ1)[l * 64 + lane] * F.inp(I_LK1)[l * 64 + lane]), s2 = wave_sum(F.inp(I_LQ2)[l * 64 + lane] * F.inp(I_LK2)[l * 64 + lane]);
        const float lam = __expf(s1) - __expf(s2) + lam_init;
        { const float ll0 = wsc[64 + 4 * lane + 1], ll1 = wsc[64 + 4 * lane + 3]; if (hi == 0) { wsc[r32] = ll0; wsc[32 + r32] = ll1; } } asm volatile("s_waitcnt lgkmcnt(0)" ::: "memory");
        unsigned char* Ob = F.ws + WS_BR + ((size_t)2 * MT + orow0) * 512 + h * 128;
        float gs[4];
#pragma unroll
        for (int d0 = 0; d0 < 4; ++d0) gs[d0] = F.inp(I_GSUB)[l * 128 + d0 * 32 + r32] * (1.0f - lam_init);
#pragma unroll
        for (int r = 0; r < 16; ++r) { const int orow = crow(r, hi); const float rl0 = __builtin_amdgcn_rcpf(wsc[orow]), rl1 = lam * __builtin_amdgcn_rcpf(wsc[32 + orow]);
            float v[4]; float ss = 0.f;
#pragma unroll
            for (int d0 = 0; d0 < 4; ++d0) { v[d0] = o[0][d0][r] * rl0 - o[1][d0][r] * rl1; ss += v[d0] * v[d0]; }
            ss = half_sum_dpp(ss, hi);
            const float rs = rsqrtf(ss * (1.0f / 128.0f) + 1e-6f);
#pragma unroll
            for (int d0 = 0; d0 < 4; ++d0) Ob[(size_t)orow * 512 + d0 * 32 + r32] = f2fp8(v[d0] * rs * gs[d0]); }
    }
#undef ATT_ROWBASE
#undef ATT_STAGE
}
}

namespace fnet {
__device__ __forceinline__ int crow(int r, int hi) { return (r & 3) + 8 * (r >> 2) + 4 * hi; }
__device__ __forceinline__ void v_slot(int s, int& k, int& c) { const int sub = s >> 5; const int kk = (sub >> 2) * 8 + ((s & 31) >> 2); k = (kk & ~0xC) | ((kk & 4) << 1) | ((kk & 8) >> 1); c = (sub & 3) * 32 + (s & 3) * 8; }
template <int NT> __device__ __forceinline__ void stage_tiles(const Ctx& F, const bf16_t* src, size_t stride, LAS unsigned char* dst) {
#pragma unroll
    for (int i = 0; i < NT * 2; ++i) { const int s = i * NTHREADS + F.tid; int k, c; v_slot(s & 1023, k, c); const int t = s >> 10;
        __builtin_amdgcn_global_load_lds((const unsigned*)(src + (size_t)(64 * t + k) * stride + c), (LAS unsigned*)(dst + (i * NTHREADS + F.wid * 64) * 16), 16, 0, 0); }
}
__device__ __forceinline__ bf16x8 pack8(const float (&v)[8]) { u32x4 w = {cvt_pk_bf16(v[0], v[1]), cvt_pk_bf16(v[2], v[3]), cvt_pk_bf16(v[4], v[5]), cvt_pk_bf16(v[6], v[7])}; return *reinterpret_cast<bf16x8*>(&w); }

__device__ __forceinline__ void phase_s1_ctx(const Ctx& F, bool do_ctx) {
    LAS unsigned char* Bt = F.lds; LAS float* T = (LAS float*)(F.lds + 65536); LAS float* tw = T + 512;
    const int tid = F.tid, wid = F.wid, lane = F.lane, r32 = lane & 31, hi = lane >> 5;
    __syncthreads();
    for (int i = tid; i < 256; i += NTHREADS) { const float x = (float)i * (1.0f / 128.0f); T[2 * i] = cospif(x); T[2 * i + 1] = sinpif(x); }
    __syncthreads();
    const int vb = (int)(uintptr_t)Bt + att::v_rd_base(lane);
    bf16x8 pa[2][4];
    { const int k1 = 16 * wid + (r32 & 15); const bool im = r32 >= 16;
#pragma unroll
      for (int t = 0; t < 2; ++t)
#pragma unroll
          for (int ks = 0; ks < 4; ++ks) { float v[8];
#pragma unroll
              for (int j = 0; j < 8; ++j) { const int n1 = 64 * t + 16 * ks + 8 * hi + j; const int idx = ((k1 * n1) & 127) * 2; v[j] = im ? -T[2 * idx + 1] : T[2 * idx]; }
              pa[t][ks] = pack8(v); } }
    for (int un = F.bid; un < NBATCH * 64 * 4; un += F.G) {
        const int b = un >> 8, n2 = (un >> 2) & 63, g = un & 3;
        __syncthreads();
        stage_tiles<2>(F, F.bf(WS_Z) + (size_t)(b * SEQ + n2) * ZLD + ZC_F + g * 128, (size_t)64 * ZLD, Bt);
        if (tid < 128) { const float x = (float)(n2 * tid) * (1.0f / 4096.0f); tw[2 * tid] = cospif(x); tw[2 * tid + 1] = sinpif(x); }
        asm volatile("s_waitcnt vmcnt(0)" ::: "memory"); __syncthreads();
        f32x16 o[4] = {f32x16{}, f32x16{}, f32x16{}, f32x16{}};
        att::pv_d0(o, vb, pa[0][0], pa[0][1], pa[0][2], pa[0][3]);
        att::pv_d0(o, vb + 16384, pa[1][0], pa[1][1], pa[1][2], pa[1][3]);
        bf16_t* AP = F.bf(WS_AP);
#pragma unroll
        for (int r = 0; r < 8; ++r) { const int kk1 = 16 * wid + crow(r, hi); const float c = tw[2 * kk1], sn = tw[2 * kk1 + 1];
#pragma unroll
            for (int d0 = 0; d0 < 4; ++d0) { const float ar = o[d0][r], ai = o[d0][r + 8];
                const size_t base = ((((size_t)b * 128 + kk1) * 2) * 64 + n2) * 512 + g * 128 + d0 * 32 + r32;
                AP[base] = f2bf(ar * c + ai * sn); AP[base + (size_t)64 * 512] = f2bf(ai * c - ar * sn); } }
    }
    if (do_ctx) for (int un = F.bid; un < NBATCH * 4 * 2; un += F.G) {
        const int b = un >> 3, g = (un >> 1) & 3, kh = un & 1;
        __syncthreads();
        stage_tiles<4>(F, F.bf(WS_Z) + (size_t)(ML + b * CTXL) * ZLD + ZC_F + g * 128, (size_t)ZLD, Bt);
        const int k = 128 * kh + 16 * wid + (r32 & 15); const bool im = r32 >= 16; const float nrm = 0.005524271728019903f;
        asm volatile("s_waitcnt vmcnt(0)" ::: "memory"); __syncthreads();
        f32x16 o[4] = {f32x16{}, f32x16{}, f32x16{}, f32x16{}};
#pragma unroll
        for (int t = 0; t < 4; ++t) { bf16x8 pc[4];
#pragma unroll
            for (int ks = 0; ks < 4; ++ks) { float v[8];
#pragma unroll
                for (int j = 0; j < 8; ++j) { const int n = 64 * t + 16 * ks + 8 * hi + j; const int idx = (k * n) & 255; v[j] = (im ? -T[2 * idx + 1] : T[2 * idx]) * nrm; }
                pc[ks] = pack8(v); }
            att::pv_d0(o, vb + t * 16384, pc[0], pc[1], pc[2], pc[3]); }
        unsigned char* X = F.ws + WS_X;
#pragma unroll
        for (int r = 0; r < 8; ++r) { const int kk = 128 * kh + 16 * wid + crow(r, hi);
#pragma unroll
            for (int d0 = 0; d0 < 4; ++d0) { const size_t base = (size_t)(ML + b * CTXL + kk) * 1024 + g * 128 + d0 * 32 + r32; X[base] = f2fp8(o[d0][r]); X[base + 512] = f2fp8(o[d0][r + 8]); } }
    }
    __syncthreads();
}
__device__ __forceinline__ void phase_s3(const Ctx& F) {
    LAS unsigned char* Bt = F.lds; LAS float* T = (LAS float*)(F.lds + 65536);
    const int tid = F.tid, wid = F.wid, lane = F.lane, r32 = lane & 31, hi = lane >> 5;
    __syncthreads();
    for (int i = tid; i < 256; i += NTHREADS) { const float x = (float)i * (1.0f / 128.0f); T[2 * i] = cospif(x); T[2 * i + 1] = sinpif(x); }
    __syncthreads();
    const int usel = wid >> 2, wq = wid & 3;
    const int vb = (int)(uintptr_t)Bt + usel * 32768 + att::v_rd_base(lane);
    bf16x8 pa[2][4];
    { const int k2 = 16 * wq + (r32 & 15); const bool im = r32 >= 16; const float nrm = 1.0f / 1024.0f;
#pragma unroll
      for (int t = 0; t < 2; ++t)
#pragma unroll
          for (int ks = 0; ks < 4; ++ks) { float v[8];
#pragma unroll
              for (int j = 0; j < 8; ++j) { const int n2 = 16 * ks + 8 * hi + j; const int idx = ((n2 * k2) & 63) * 4; const float c = T[2 * idx], sn = T[2 * idx + 1];
                  v[j] = (im ? (t == 0 ? -sn : c) : (t == 0 ? c : sn)) * nrm; }
              pa[t][ks] = pack8(v); } }
    for (int up = F.bid; up < NBATCH * 128 * 4 / 2; up += F.G) {
        __syncthreads();
#pragma unroll
        for (int q = 0; q < 2; ++q) { const int un = 2 * up + q; const int b = un >> 9, k1 = (un >> 2) & 127, g = un & 3;
            stage_tiles<2>(F, F.bf(WS_AP) + ((size_t)b * 128 + k1) * 2 * 64 * 512 + g * 128, 512, Bt + q * 32768); }
        asm volatile("s_waitcnt vmcnt(0)" ::: "memory"); __syncthreads();
        const int un = 2 * up + usel; const int b = un >> 9, k1 = (un >> 2) & 127, g = un & 3;
        f32x16 o[4] = {f32x16{}, f32x16{}, f32x16{}, f32x16{}};
        att::pv_d0(o, vb, pa[0][0], pa[0][1], pa[0][2], pa[0][3]);
        att::pv_d0(o, vb + 16384, pa[1][0], pa[1][1], pa[1][2], pa[1][3]);
        unsigned char* X = F.ws + WS_X;
#pragma unroll
        for (int r = 0; r < 8; ++r) { const int k2 = 16 * wq + crow(r, hi); const size_t tok = (size_t)b * SEQ + k1 + 128 * k2;
#pragma unroll
            for (int d0 = 0; d0 < 4; ++d0) { const size_t base = tok * 1024 + g * 128 + d0 * 32 + r32; X[base] = f2fp8(o[d0][r]); X[base + 512] = f2fp8(o[d0][r + 8]); } }
    }
    __syncthreads();
}
}

namespace peer {
typedef float v32f_t __attribute__((ext_vector_type(32)));
typedef unsigned v6u_t __attribute__((ext_vector_type(6)));
__device__ __forceinline__ unsigned okey(float s) { const unsigned b = __float_as_uint(s); return b ^ ((unsigned)((int)b >> 31) | 0x80000000u); }
__device__ __forceinline__ float oval(unsigned k) { return __uint_as_float((k & 0x80000000u) ? (k ^ 0x80000000u) : ~k); }
template <int NE> __device__ __forceinline__ unsigned top16_row(unsigned (&key)[NE], int t) {
    unsigned sel = 0u;
#pragma unroll
    for (int n = 0; n < 16; ++n) { unsigned m = key[0];
#pragma unroll
        for (int e = 1; e < NE; ++e) m = m > key[e] ? m : key[e];
        m = row_max16_u(m); sel = (t == n) ? m : sel;
#pragma unroll
        for (int e = 0; e < NE; ++e) key[e] = (key[e] == m) ? 0u : key[e]; }
    return sel;
}
__device__ __forceinline__ float gelu_erf(float x) { return 0.5f * x * (1.0f + erff(x * 0.70710678118654752f)); }

__device__ __forceinline__ void peer_rows(const Ctx& F, int l, int nrows, bool dry = false) {
    const int lane = F.lane, wid = F.wid, t = lane & 15, rr = lane >> 4;
    LAS unsigned* selL = (LAS unsigned*)F.lds + wid * 1024;
    LAS unsigned* eidL = selL + 256; LAS float* gwL = (LAS float*)(selL + 384); LAS unsigned* tabL = selL + 512;
    { const int q = lane; int cnt = 0, fi = -1, fj = 0;
      for (int i = 0; i < 16; ++i) { const int nj = 16 / (i + 1); if (fi < 0 && q < cnt + nj) { fi = i; fj = q - cnt; } cnt += nj; }
      tabL[lane] = fi >= 0 ? (unsigned)(fi * 16 + fj) : 255u; }
    const unsigned char* PU = F.ws + WS_PU + (size_t)l * NEXP * PEER_UROWB; const unsigned char* PV = F.ws + WS_PV + (size_t)l * NEXP * PEER_VROWB;
    unsigned* rowcnt = (unsigned*)(F.ws + WS_DIAG + 2048 + l * 256);
    auto next_row = [&]() -> int { unsigned nx = 0u; if (lane == 0) nx = __hip_atomic_fetch_add(rowcnt, 1u, __ATOMIC_RELAXED, __HIP_MEMORY_SCOPE_AGENT); return F.G * NWAVES + __builtin_amdgcn_readfirstlane((int)nx); };
    for (int row = F.bid * NWAVES + wid; row < nrows; row = next_row()) {
        const bool cpart = l == 0 && row >= ML;
        const float* S = cpart ? F.f32(WS_PART) + (size_t)(row - ML) * DM : F.f32(WS_S) + (size_t)row * DM;
#pragma unroll
        for (int it = 0; it < 4; ++it) { const float* sp = S + (it * 4 + rr) * 128 + t * 8; f32x4 a = *(const f32x4*)sp, b = *(const f32x4*)(sp + 4);
            if (cpart) {
#pragma unroll 1
                for (int k = 1; k < 8; ++k) { a += *(const f32x4*)(sp + (size_t)k * MC * DM); b += *(const f32x4*)(sp + (size_t)k * MC * DM + 4); } }
            unsigned key[8];
#pragma unroll
            for (int e = 0; e < 4; ++e) { key[e] = (okey(a[e]) & 0xFFFFFF80u) | (unsigned)(t * 8 + e); key[4 + e] = (okey(b[e]) & 0xFFFFFF80u) | (unsigned)(t * 8 + 4 + e); }
            selL[it * 64 + lane] = top16_row<8>(key, t); }
#pragma unroll
        for (int pass = 0; pass < 2; ++pass) { const int hd = pass * 4 + rr; const LAS unsigned* s1 = selL + (hd >> 1) * 64 + (hd & 1) * 32; const LAS unsigned* s2 = s1 + 16;
            unsigned key[4];
#pragma unroll
            for (int e = 0; e < 4; ++e) { const unsigned ij = tabL[t * 4 + e]; if (ij != 255u) { const float v = oval(s1[ij >> 4] & 0xFFFFFF80u) + oval(s2[ij & 15u] & 0xFFFFFF80u); key[e] = (okey(v) & 0xFFFFFF00u) | ij; } else key[e] = 1u + e; }
            const unsigned ks = top16_row<4>(key, t);
            const int i = (ks >> 4) & 15, j = ks & 15; const unsigned k1 = s1[i], k2 = s2[j];
            const float sc = oval(k1 & 0xFFFFFF80u) + oval(k2 & 0xFFFFFF80u);
            const float mx = row_max16_f(sc); const float ex = __expf(sc - mx); const float sm = row_sum16_f(ex);
            eidL[hd * 16 + t] = (k1 & 127u) * 128u + (k2 & 127u); gwL[hd * 16 + t] = ex / sm;
            }
        v32f_t hf;
        { const bf16_t* hr = F.bf(WS_HN) + (size_t)row * DM + lane * 32;
#pragma unroll
          for (int h = 0; h < 4; ++h) { const u32x4 v = *(const u32x4*)(hr + h * 8);
              hf[h * 8 + 0] = bflo(v[0]); hf[h * 8 + 1] = bfhi(v[0]); hf[h * 8 + 2] = bflo(v[1]); hf[h * 8 + 3] = bfhi(v[1]);
              hf[h * 8 + 4] = bflo(v[2]); hf[h * 8 + 5] = bfhi(v[2]); hf[h * 8 + 6] = bflo(v[3]); hf[h * 8 + 7] = bfhi(v[3]); } }
        v32f_t acc;
#pragma unroll
        for (int i = 0; i < 32; ++i) acc[i] = 0.f;
        if constexpr (PEER_UBITS == 4 && PEER_VBITS == 4) {
            f32x2 acc2[16];
#pragma unroll
            for (int i = 0; i < 16; ++i) acc2[i] = (f32x2){0.f, 0.f};
            u32x4 hb1, hb2;
            { auto enc4 = [](float y) -> unsigned { const float ay = fabsf(y);
                  unsigned code = ay < 0.25f ? 0u : ay < 0.75f ? 1u : ay < 1.25f ? 2u : ay < 1.75f ? 3u : ay < 2.5f ? 4u : ay < 3.5f ? 5u : ay < 5.0f ? 6u : 7u; return code | (y < 0.f ? 8u : 0u); };
#define PEER_RES(k2) do { const f32x2 d = __builtin_amdgcn_cvt_scalef32_pk_f32_fp4(w, 1.0f, k2); \
        v |= enc4((hf[q * 8 + 2 * k2] - d[0]) * 8.f) << (8 * k2); v |= enc4((hf[q * 8 + 2 * k2 + 1] - d[1]) * 8.f) << (8 * k2 + 4); } while (0)
#pragma unroll
              for (int q = 0; q < 4; ++q) { unsigned w = 0u;
#pragma unroll
                  for (int e = 0; e < 8; ++e) w |= enc4(hf[q * 8 + e]) << (4 * e);
                  unsigned v = 0u; PEER_RES(0); PEER_RES(1); PEER_RES(2); PEER_RES(3);
                  hb1[q] = w; hb2[q] = v; }
#undef PEER_RES
            }
            int sA = 0x79797979, sB1 = 0x7F7F7F7F, sB2 = 0x7C7C7C7C; asm volatile("" : "+v"(sA), "+v"(sB1), "+v"(sB2));
            const bool ondiag = (lane >> 4) == ((lane & 15) >> 2); const int di = lane & 3;
#define PEER_DEC4(w_, k_) __builtin_amdgcn_cvt_scalef32_pk_f32_fp4((w_), 1.0f, (k_))
            for (int kb = 0; kb < 16; ++kb) {
                u32x4 bu[8], bv[8]; float gq[8], dd[8];
#pragma unroll
                for (int m = 0; m < 8; ++m) { const unsigned e = (unsigned)__builtin_amdgcn_readfirstlane((int)eidL[kb * 8 + m]); gq[m] = gwL[kb * 8 + m];
                    bu[m] = *(const u32x4*)(PU + (size_t)e * PEER_UROWB + lane * 16); bv[m] = *(const u32x4*)(PV + (size_t)e * PEER_VROWB + lane * 16); }
                f32x4 dm[8];
#pragma unroll
                for (int m = 0; m < 8; ++m) { dm[m] = (f32x4){0.f, 0.f, 0.f, 0.f};
                    asm volatile("v_mfma_scale_f32_16x16x128_f8f6f4 %0, %1, %2, %0, %3, %4 op_sel_hi:[0,0,0] cbsz:4 blgp:4" : "+v"(dm[m]) : "v"(bu[m]), "v"(hb1), "v"(sA), "v"(sB1)); }
#pragma unroll
                for (int m = 0; m < 8; ++m)
                    asm volatile("v_mfma_scale_f32_16x16x128_f8f6f4 %0, %1, %2, %0, %3, %4 op_sel_hi:[0,0,0] cbsz:4 blgp:4" : "+v"(dm[m]) : "v"(bu[m]), "v"(hb2), "v"(sA), "v"(sB2));
                __builtin_amdgcn_sched_barrier(0); asm volatile("s_nop 15\n\ts_nop 7" ::: "memory"); __builtin_amdgcn_sched_barrier(0);
#pragma unroll
                for (int m = 0; m < 8; ++m) { float x = dm[m][0]; x = di == 1 ? dm[m][1] : x; x = di == 2 ? dm[m][2] : x; x = di == 3 ? dm[m][3] : x;
                    dd[m] = wave_sum_dpp(ondiag ? x : 0.f); }
                float x = dd[0];
#pragma unroll
                for (int m = 1; m < 8; ++m) x = ((lane & 7) == m) ? dd[m] : x;
                const float gl = gelu_erf(x * 0.70710678118654752f) * 0.5f;
#pragma unroll
                for (int m = 0; m < 8; ++m) { const float cf = gq[m] * __int_as_float(__builtin_amdgcn_readlane(__float_as_int(gl), m)); const f32x2 cf2 = {cf, cf};
#pragma unroll
                    for (int q = 0; q < 4; ++q) { const unsigned w = bv[m][q];
                        acc2[q * 4 + 0] = PEER_DEC4(w, 0) * cf2 + acc2[q * 4 + 0]; acc2[q * 4 + 1] = PEER_DEC4(w, 1) * cf2 + acc2[q * 4 + 1];
                        acc2[q * 4 + 2] = PEER_DEC4(w, 2) * cf2 + acc2[q * 4 + 2]; acc2[q * 4 + 3] = PEER_DEC4(w, 3) * cf2 + acc2[q * 4 + 3]; } }
            }
#undef PEER_DEC4
#pragma unroll
            for (int i = 0; i < 16; ++i) { acc[2 * i] = acc2[i][0]; acc[2 * i + 1] = acc2[i][1]; }
        } else
        for (int kb = 0; kb < 16; ++kb) {
            u32x4 ua[8], va[8]; u32x2 ub[8], vb[8]; float gk[8];
#pragma unroll
            for (int m = 0; m < 8; ++m) { const unsigned e = (unsigned)__builtin_amdgcn_readfirstlane((int)eidL[kb * 8 + m]); gk[m] = gwL[kb * 8 + m];
                const unsigned char* up = PU + (size_t)e * PEER_UROWB; const unsigned char* vp = PV + (size_t)e * PEER_VROWB;
                ua[m] = *(const u32x4*)(up + lane * 16); if (PEER_UBITS == 6) ub[m] = *(const u32x2*)(up + 1024 + lane * 8);
                va[m] = *(const u32x4*)(vp + lane * 16); if (PEER_VBITS == 6) vb[m] = *(const u32x2*)(vp + 1024 + lane * 8); }
#pragma unroll
            for (int m = 0; m < 8; ++m) {
                v32f_t du;
                if (PEER_UBITS == 6) { v6u_t pk; pk[0] = ua[m][0]; pk[1] = ua[m][1]; pk[2] = ua[m][2]; pk[3] = ua[m][3]; pk[4] = ub[m][0]; pk[5] = ub[m][1]; du = __builtin_amdgcn_cvt_scalef32_pk32_f32_fp6(pk, 1.0f); }
                else {
#pragma unroll
                    for (int q = 0; q < 4; ++q) { const f32x2 t0 = __builtin_amdgcn_cvt_scalef32_pk_f32_fp4(ua[m][q], 1.0f, 0), t1 = __builtin_amdgcn_cvt_scalef32_pk_f32_fp4(ua[m][q], 1.0f, 1);
                        const f32x2 t2 = __builtin_amdgcn_cvt_scalef32_pk_f32_fp4(ua[m][q], 1.0f, 2), t3 = __builtin_amdgcn_cvt_scalef32_pk_f32_fp4(ua[m][q], 1.0f, 3);
                        du[q * 8 + 0] = t0[0]; du[q * 8 + 1] = t0[1]; du[q * 8 + 2] = t1[0]; du[q * 8 + 3] = t1[1]; du[q * 8 + 4] = t2[0]; du[q * 8 + 5] = t2[1]; du[q * 8 + 6] = t3[0]; du[q * 8 + 7] = t3[1]; } }
                float d0 = 0.f, d1 = 0.f;
#pragma unroll
                for (int i = 0; i < 32; i += 2) { d0 = fmaf(du[i], hf[i], d0); d1 = fmaf(du[i + 1], hf[i + 1], d1); }
                const float d = wave_sum_dpp(d0 + d1) * 0.011048543456039806f;
                const float cf = gk[m] * gelu_erf(d) * 0.5f;
                if (PEER_VBITS == 6) { v6u_t pk; pk[0] = va[m][0]; pk[1] = va[m][1]; pk[2] = va[m][2]; pk[3] = va[m][3]; pk[4] = vb[m][0]; pk[5] = vb[m][1];
                    const v32f_t dv = __builtin_amdgcn_cvt_scalef32_pk32_f32_fp6(pk, 1.0f);
#pragma unroll
                    for (int i = 0; i < 32; ++i) acc[i] = fmaf(dv[i], cf, acc[i]); }
                else {
#pragma unroll
                    for (int q = 0; q < 4; ++q)
#pragma unroll
                        for (int k = 0; k < 4; ++k) { const f32x2 t = k == 0 ? __builtin_amdgcn_cvt_scalef32_pk_f32_fp4(va[m][q], 1.0f, 0) : k == 1 ? __builtin_amdgcn_cvt_scalef32_pk_f32_fp4(va[m][q], 1.0f, 1)
                                : k == 2 ? __builtin_amdgcn_cvt_scalef32_pk_f32_fp4(va[m][q], 1.0f, 2) : __builtin_amdgcn_cvt_scalef32_pk_f32_fp4(va[m][q], 1.0f, 3);
                            acc[q * 8 + k * 2] = fmaf(t[0], cf, acc[q * 8 + k * 2]); acc[q * 8 + k * 2 + 1] = fmaf(t[1], cf, acc[q * 8 + k * 2 + 1]); } } }
        }
        const int v = row < ML ? (row >> 13) : 2;
        const float* g2 = F.mod(l, v, 5);
        float* xr = F.f32(WS_XR) + (size_t)row * DM + lane * 32; float ss = 0.f;
        float xo[32];
#pragma unroll
        for (int q = 0; q < 8; ++q) { const f32x4 xv = *(const f32x4*)(xr + q * 4), gv = *(const f32x4*)(g2 + lane * 32 + q * 4); f32x4 ov;
#pragma unroll
            for (int e = 0; e < 4; ++e) { ov[e] = xv[e] + gv[e] * acc[q * 4 + e]; xo[q * 4 + e] = ov[e]; ss += ov[e] * ov[e]; }
            if (!dry) *(f32x4*)(xr + q * 4) = ov; }
        ss = wave_sum(ss);
        if (dry) { if (lane == 0) F.f32(WS_DIAG)[512 + (row & 255)] = ss; continue; }
        const float rs = rsqrtf(ss * (1.0f / DM) + 1e-6f);
        if (l == 0) {
            const float* gn = F.inp(I_GN1) + DM + lane * 32; const float* sh = F.mod(1, v, 0) + lane * 32; const float* sc = F.mod(1, v, 1) + lane * 32;
#pragma unroll
            for (int h = 0; h < 4; ++h) { float o[8];
#pragma unroll
                for (int q = 0; q < 2; ++q) { const f32x4 gv = *(const f32x4*)(gn + h * 8 + 4 * q), sv = *(const f32x4*)(sc + h * 8 + 4 * q), tv = *(const f32x4*)(sh + h * 8 + 4 * q);
#pragma unroll
                    for (int e = 0; e < 4; ++e) o[4 * q + e] = (xo[h * 8 + 4 * q + e] * rs * gv[e]) * (1.0f + sv[e]) + tv[e]; }
                int p0 = 0, p1 = 0; p0 = __builtin_amdgcn_cvt_pk_fp8_f32(o[0], o[1], p0, false);
                p0 = __builtin_amdgcn_cvt_pk_fp8_f32(o[2], o[3], p0, true);
                p1 = __builtin_amdgcn_cvt_pk_fp8_f32(o[4], o[5], p1, false); p1 = __builtin_amdgcn_cvt_pk_fp8_f32(o[6], o[7], p1, true);
                *(u32x2*)(F.ws + WS_HN8 + (size_t)row * DM + lane * 32 + h * 8) = (u32x2){(unsigned)p0, (unsigned)p1}; }
        } else if (row < ML) {
            const float* gf = F.inp(I_GFIN) + lane * 32; float* orow = F.out + (size_t)row * DM + lane * 32;
#pragma unroll
            for (int q = 0; q < 8; ++q) { const f32x4 gv = *(const f32x4*)(gf + q * 4); f32x4 ov;
#pragma unroll
                for (int e = 0; e < 4; ++e) ov[e] = xo[q * 4 + e] * rs * gv[e];
                *(f32x4*)(orow + q * 4) = ov; }
        }
    }
}
}

constexpr int PH_PRE = 2, PH_PER_LAYER = 13, NPHASES = PH_PRE + PH_PER_LAYER * DEPTH;
static_assert(offsetof(Args, out) == 240 && offsetof(Args, ws) == 248, "Ctx::fresh reads out / ws from the argument block");
__global__ void __launch_bounds__(NTHREADS, 2) mk_fwd(Args a) {
    extern __shared__ __attribute__((aligned(16))) unsigned char shm[];
    Ctx F; F.lds = (LAS unsigned char*)shm; F.G = gridDim.x; F.bid = blockIdx.x; F.wv = __builtin_amdgcn_readfirstlane((int)threadIdx.x >> 6); F.fresh();
    LAS unsigned char* lds = F.lds;
    volatile LAS unsigned* xbw = (volatile LAS unsigned*)(lds + LDS_BYTES - 16);
    if (F.tid == 0) { xbw[0] = 0u; xbw[1] = 0u; xbw[2] = 0u; xbw[3] = 0u; }
    __syncthreads();
    XcdBarrier bar; bar.bar = (unsigned*)(a.ws + WS_BAR); bar.x = 0; bar.st = xbw;
    const int lo = a.ph_lo, hi = a.ph_hi;
    if (hi - lo > 1) bar = xcd_barrier_post((unsigned*)(a.ws + WS_BAR), xbw, F.tid);
#ifndef MK_PHMASK
#define MK_PHMASK 0xFFFF
#endif
#define PHON(j) ((MK_PHMASK >> (j)) & 1)
#ifndef MK_REP
#define MK_REP -1
#endif
#define REPS(j) for (int rep_ = 0; rep_ < (MK_REP == (j) ? 2 : 1); ++rep_)
#define IN(k) (F.fresh(), (lo <= (k) && (k) < hi))
#define SEAM(k) do { if (IN(k) && IN((k) + 1)) { xcd_barrier(bar, F.tid); if (MK_REP == 99) xcd_barrier(bar, F.tid); } } while (0)

    if (IN(0) && PHON(13)) REPS(100) { p0_prologue(F); } SEAM(0);
    if (IN(1)) { pg8::Gemm g{256, DM, 256, F.wid};
        pg8::SchedWsc S{F.G, F.bid, (const char*)F.bf(WS_KB), (const char*)F.bf(WS_WPQ)};
        pg8::EpiBf16 E{F.bf(WS_WSC), DM, 8, (size_t)DM * DM};
        pg8::gemm_phase(lds, g, S, E); } SEAM(1);

    for (int l = 0; l < DEPTH; ++l) {
        const int pb = PH_PRE + PH_PER_LAYER * l;
        const int nMa = l == 0 ? MT / 256 : ML / 256;
        const int nrows_a = l == 0 ? MT : ML;
        if (IN(pb + 0) && PHON(0)) { if (l == 0) norm_rows(F, F.inp(I_X), F.inp(I_CTX), F.inp(I_GN1), 0, 0, 1, MT, true, nullptr, nullptr, nullptr, false); } if (l == 0 || hi - lo == 1) SEAM(pb + 0);
        if (IN(pb + 1) && PHON(1)) REPS(1) {
            pg8::Gemm g{DM, DM, DM, F.wid};
            pg8::Sched S{MT / 256, ZLD / 256, F.G, F.bid, (const char*)(F.ws + WS_HN8), (const char*)(F.ws + WS_WIN + (size_t)l * ZLD * DM), (size_t)256 * DM, (size_t)256 * DM, 1 << 20, 0};
            pg8::EpiBf16 E{F.bf(WS_Z), ZLD, 1 << 20, 0};
            pg8::gemm_phase<pg8::EpiBf16, pg8::Sched, 1>(lds, g, S, E);
        } SEAM(pb + 1);
        if (IN(pb + 2) && PHON(2)) { z_post_rows(F, l); REPS(20) fnet::phase_s1_ctx(F, l == 0); } SEAM(pb + 2);
        if (IN(pb + 3) && PHON(3)) REPS(3) {
            { pg8::Gemm g{512, 512, 512, F.wid};
              pg8::Sched S{MT / 256, 3, F.G, F.bid, (const char*)(F.ws + WS_QL8), (const char*)(F.ws + WS_WUQ + (size_t)l * 768 * 512), (size_t)256 * 512, (size_t)256 * 512, 1 << 20, 0};
              pg8::EpiBf16 E{F.bf(WS_Q), 768, 1 << 20, 0};
              pg8::gemm_phase<pg8::EpiBf16, pg8::Sched, 1>(lds, g, S, E); }
            { pg8::Gemm g{256, 256, 256, F.wid};
              pg8::Sched S{MT / 256, 4, F.G, (F.bid + 26) % F.G, (const char*)(F.ws + WS_KVL8), (const char*)(F.ws + WS_WUKV + (size_t)l * 1024 * 256), (size_t)256 * 256, (size_t)256 * 256, 1 << 20, 0};
              pg8::EpiKV E{F.bf(WS_KV), F.ws + WS_K8};
              pg8::gemm_phase<pg8::EpiKV, pg8::Sched, 1>(lds, g, S, E); }
            conv_units(F, l);
        } SEAM(pb + 3);
        if (IN(pb + 4) && PHON(4)) {
            v8t_build(F); xcd_barrier(bar, F.tid); F.fresh();
            const int nu = l == 0 ? 256 + 8 : 256;
            for (int u = F.bid; u < (MK_REP == 4 ? 2 : 1) * 512; u += F.G) { const int uu_ = u & 511; if (uu_ < nu) att::attn_unit<0>(F, l, (uu_ & 7) >> 2, uu_ & 3, uu_ >> 3); }
            for (int u = (F.bid + 248) % F.G; u < (MK_REP == 40 ? 2 : 1) * 512; u += F.G) { const int uu_ = u & 511; if (uu_ < nu) att::attn_unit<1>(F, l, (uu_ & 7) >> 2, uu_ & 3, uu_ >> 3); }
            REPS(41) fnet::phase_s3(F);
        } SEAM(pb + 4);
        if (IN(pb + 5) && PHON(5)) REPS(5) {
            { pg8::Gemm g{1024, 1024, 1024, F.wid};
              pg8::Sched S{nMa, 2, F.G, F.bid, (const char*)(F.ws + WS_X), (const char*)(F.ws + WS_WDFT), (size_t)256 * 1024, (size_t)256 * 1024, 1 << 20, 0};
              pg8::EpiFp8 E{F.ws + WS_BR + (size_t)3 * MT * 512, 512, 1 << 20, 0};
              pg8::gemm_phase<pg8::EpiFp8, pg8::Sched, 1>(lds, g, S, E); }
            { pg8::Gemm g{512, 512, 512, F.wid};
              pg8::Sched S{nMa, 24, F.G, (F.bid + 76) % F.G, (const char*)(F.ws + WS_BR), (const char*)(F.ws + WS_WB + (size_t)l * 4 * DM * 512), (size_t)256 * 512, (size_t)256 * 512, 8, (size_t)MT * 512, 0x79797979};
              pg8::EpiFp8 E{F.ws + WS_T, DM, 8, (size_t)MT * DM};
              pg8::gemm_phase<pg8::EpiFp8, pg8::Sched, 1>(lds, g, S, E); }
        } SEAM(pb + 5);
        if (IN(pb + 6) && PHON(6)) REPS(6) {
            { pg8::Gemm g{512, 512, 512, F.wid};
              pg8::Sched S{nMa, 8, F.G, F.bid, (const char*)(F.ws + WS_BR + (size_t)3 * MT * 512), (const char*)(F.ws + WS_WB + ((size_t)l * 4 + 3) * DM * 512), (size_t)256 * 512, (size_t)256 * 512, 1 << 20, 0};
              pg8::EpiFp8 E{F.ws + WS_T + (size_t)3 * MT * DM, DM, 1 << 20, 0};
              pg8::gemm_phase<pg8::EpiFp8, pg8::Sched, 1>(lds, g, S, E); }
        }
        SEAM(pb + 6);
        if (IN(pb + 7) && PHON(7)) REPS(7) {
            pg8::Gemm g{DM, DM, DM, F.wid};
            pg8::SchedGate S{ML / 256, F.G, F.bid, (const char*)(F.ws + WS_HN8), (const char*)(F.ws + WS_WG + (size_t)l * 4 * DM * DM), (size_t)256 * DM, (size_t)256 * DM};
            pg8::EpiGate E{F.ws + WS_T, (size_t)MT * DM, (u32x4*)(F.ws + WS_BR) + (size_t)F.bid * 16 * NTHREADS, F.ws + WS_Y};
            pg8::gemm_phase<pg8::EpiGate, pg8::SchedGate, 1>(lds, g, S, E);
            if (l == 0) {
                pg8::SchedGateCtx S2{F.G, F.bid, (const char*)(F.ws + WS_HN8), (const char*)(F.ws + WS_WG + (size_t)l * 4 * DM * DM), (size_t)256 * DM, (size_t)256 * DM};
                pg8::EpiGateCtx E2{F.ws + WS_T, (size_t)MT * DM, F.bf(WS_YC)};
                pg8::gemm_phase<pg8::EpiGateCtx, pg8::SchedGateCtx, 1>(lds, g, S2, E2); }
        } SEAM(pb + 7);
        if (IN(pb + 8) && PHON(8)) { if (l == 0) { const bf16_t* yc = F.bf(WS_YC); unsigned char* y = F.ws + WS_Y + (size_t)ML * DM;
                for (size_t i = (size_t)F.bid * NTHREADS + F.tid; i < (size_t)MC * DM / 8; i += (size_t)F.G * NTHREADS) { float sacc[8] = {0.f, 0.f, 0.f, 0.f, 0.f, 0.f, 0.f, 0.f};
#pragma unroll
                    for (int n = 0; n < 4; ++n) { const u32x4 v = *(const u32x4*)(yc + (size_t)n * MC * DM + i * 8);
                        sacc[0] += bflo(v.x); sacc[1] += bfhi(v.x); sacc[2] += bflo(v.y); sacc[3] += bfhi(v.y); sacc[4] += bflo(v.z); sacc[5] += bfhi(v.z); sacc[6] += bflo(v.w); sacc[7] += bfhi(v.w); }
                    int p0 = 0, p1 = 0; p0 = __builtin_amdgcn_cvt_pk_fp8_f32(sacc[0], sacc[1], p0, false); p0 = __builtin_amdgcn_cvt_pk_fp8_f32(sacc[2], sacc[3], p0, true);
                    p1 = __builtin_amdgcn_cvt_pk_fp8_f32(sacc[4], sacc[5], p1, false); p1 = __builtin_amdgcn_cvt_pk_fp8_f32(sacc[6], sacc[7], p1, true);
                    *(u32x2*)(y + i * 8) = (u32x2){(unsigned)p0, (unsigned)p1}; } } } if (l == 0 || hi - lo == 1) SEAM(pb + 8);
        if (IN(pb + 9) && PHON(9)) REPS(9) {
            pg8::Gemm g{DM, DM, DM, F.wid};
            pg8::Sched S{ML / 256, 8, F.G, F.bid, (const char*)(F.ws + WS_Y), (const char*)(F.ws + WS_WO + (size_t)l * DM * DM), (size_t)256 * DM, (size_t)256 * DM, 1 << 20, 0};
            pg8::EpiResGate E{F.f32(WS_XR), l == 0 ? F.inp(I_X) : F.f32(WS_XR), l == 0 ? F.inp(I_CTX) : F.f32(WS_XR) + (size_t)ML * DM, F.mod(l, 0, 2), F.mod(l, 2, 2)};
            pg8::gemm_phase<pg8::EpiResGate, pg8::Sched, 1>(lds, g, S, E);
            if (l == 0) {
                pg8::Gemm g2{DM, DM, 256, F.wid};
                pg8::SchedKSplit S2{F.G, F.bid, (const char*)(F.ws + WS_Y), (const char*)(F.ws + WS_WO), (size_t)256 * DM, (size_t)256 * DM, 256};
                pg8::EpiPart E2{F.f32(WS_PART)};
                pg8::gemm_phase<pg8::EpiPart, pg8::SchedKSplit, 1>(lds, g2, S2, E2); }
        } SEAM(pb + 9);
        if (IN(pb + 10) && PHON(10)) REPS(10) { if (l == 0) norm_rows(F, F.f32(WS_XR), F.inp(I_CTX), F.inp(I_GN2), 0, 3, 4, MT, false, F.f32(WS_PART), F.mod(0, 2, 2), F.f32(WS_XR) + (size_t)ML * DM);
            else norm_rows(F, F.f32(WS_XR), F.f32(WS_XR) + (size_t)ML * DM, F.inp(I_GN2) + l * DM, l, 3, 4, nrows_a, false); } SEAM(pb + 10);
        if (IN(pb + 11) && PHON(11)) REPS(11) {
            pg8::Gemm g{DM, DM, DM, F.wid};
            pg8::Sched S{ML / 256, 8, F.G, F.bid, (const char*)F.bf(WS_HN), (const char*)(F.bf(WS_WSC) + (size_t)l * DM * DM), (size_t)256 * DM * 2, (size_t)256 * DM * 2, 1 << 20, 0};
            pg8::EpiF32 E{F.f32(WS_S), DM};
            pg8::gemm_phase(lds, g, S, E);
            if (l == 0) {
                pg8::Gemm g2{DM, DM, 256, F.wid};
                pg8::SchedKSplit S2{F.G, F.bid, (const char*)F.bf(WS_HN), (const char*)F.bf(WS_WSC), (size_t)256 * DM * 2, (size_t)256 * DM * 2, 512};
                pg8::EpiPart E2{F.f32(WS_PART)};
                pg8::gemm_phase<pg8::EpiPart, pg8::SchedKSplit, 2>(lds, g2, S2, E2); }
        } SEAM(pb + 11);
        if (IN(pb + 12) && PHON(12)) REPS(13) { peer::peer_rows(F, l, nrows_a, MK_REP == 13 && rep_ == 0); } SEAM(pb + 12);
    }
#undef IN
#undef SEAM
}

#if MK_DIAG
__device__ __forceinline__ void dacc(float* dg, int c, float err, float ref) { atomicAdd(dg + 2 * c, err * err); atomicAdd(dg + 2 * c + 1, ref * ref); }
__device__ __forceinline__ unsigned hsh(unsigned x) { x ^= x >> 16; x *= 0x7feb352dU; x ^= x >> 15; x *= 0x846ca68bU; x ^= x >> 16; return x; }
__device__ float ddot_bf(const bf16_t* a, const bf16_t* b, int K) { float s = 0.f; for (int k = 0; k < K; ++k) s += bf2f(a[k]) * bf2f(b[k]); return s; }
__global__ void __launch_bounds__(256) k_diag(Args a) {
    Ctx F; F.fresh(); F.G = gridDim.x; F.bid = blockIdx.x;
    float* dg = F.f32(WS_DIAG);
    const unsigned gt = blockIdx.x * 256 + threadIdx.x, gn = gridDim.x * 256;
#if MK_DIAG == 1
    for (unsigned i = gt; i < 4096; i += gn) { const unsigned h = hsh(i * 7 + 1); const int n = h % DIN, k = (h >> 12) % DM;
        dacc(dg, 0, bf2f(F.bf(WS_WIN)[((size_t)1 * ZLD + n) * DM + k]) - F.inp(I_WIN)[((size_t)1 * DM + k) * DIN + n], F.inp(I_WIN)[((size_t)1 * DM + k) * DIN + n]);
        const int n2 = h % DM, slot = (h >> 28) & 3, br = (0x1320 >> (4 * slot)) & 3;
        dacc(dg, 0, bf2f(F.bf(WS_WG)[(((size_t)1 * 4 + slot) * DM + n2) * DM + k]) - F.inp(I_WGATE)[(((size_t)1 * 4 + br) * DM + k) * DM + n2], F.inp(I_WGATE)[(((size_t)1 * 4 + br) * DM + k) * DM + n2]);
        const int k5 = k & 511;
        dacc(dg, 0, bf2f(F.bf(WS_WB)[(((size_t)1 * 4 + slot) * DM + n2) * 512 + k5]) - F.inp(I_WBR)[(((size_t)1 * 4 + br) * 512 + k5) * DM + n2], F.inp(I_WBR)[(((size_t)1 * 4 + br) * 512 + k5) * DM + n2]); }
    for (unsigned i = gt; i < 384; i += gn) { const unsigned h = hsh(i * 13 + 5); const int l = i & 1, v = (i >> 1) % 3, j = h % (6 * DM);
        float s = F.inp(I_BADA)[l * 6 * DM + j];
        for (int k = 0; k < DM; ++k) { const float x = v < 2 ? F.inp(I_C)[v * DM + k] : F.inp(I_CCTX)[k]; s += x / (1.0f + expf(-x)) * F.inp(I_WADA)[((size_t)l * DM + k) * 6 * DM + j]; }
        dacc(dg, 1, F.f32(WS_MOD)[(size_t)(l * 3 + v) * 6 * DM + j] - s, s); }
    for (unsigned i = gt; i < 64 * 256; i += gn) { const int rs = i >> 8, c8 = (i & 255) * 8; const int row = rs < 48 ? (hsh(rs * 3 + 2) % ML) : ML + (hsh(rs) % MC);
        const float* xr = row < ML ? F.inp(I_X) + (size_t)row * DM : F.inp(I_CTX) + (size_t)(row - ML) * DM; const int v = row < ML ? row >> 13 : 2;
        float ss = 0.f; for (int k = 0; k < DM; ++k) ss += xr[k] * xr[k]; const float r = rsqrtf(ss / DM + 1e-6f);
        for (int e = 0; e < 8; ++e) { const int c = c8 + e; const float ref = xr[c] * r * F.inp(I_GN1)[c] * (1.0f + F.mod(0, v, 1)[c]) + F.mod(0, v, 0)[c];
            dacc(dg, 2, bf2f(F.bf(WS_HN)[(size_t)row * DM + c]) - ref, ref); } }
    for (unsigned i = gt; i < 2048; i += gn) { const unsigned h = hsh(i * 11 + 3); const int row = h % MT, col = (h >> 15) % ZLD;
        const float ref = ddot_bf(F.bf(WS_HN) + (size_t)row * DM, F.bf(WS_WIN) + (size_t)col * DM, DM);
        dacc(dg, 3, bf2f(F.bf(WS_Z)[(size_t)row * ZLD + col]) - ref, ref + 1e-3f); }
#endif
#if MK_DIAG == 2
    __shared__ float sh[8448 + 64];
    for (unsigned i = gt; i < 16 * 9 * 32; i += gn) { const int d = i & 31, vi = (i >> 5) % 9, rs = i / (9 * 32); const int row = hsh(rs * 5 + 1) % ML; const int pos = row & (SEQ - 1);
        const int col = vi == 0 ? ZC_KROPE : ZC_DK + (vi - 1) * 64;
        const float x1 = bf2f(f2bf(ddot_bf(F.bf(WS_HN) + (size_t)row * DM, F.bf(WS_WIN) + (size_t)(col + d) * DM, DM))), x2 = bf2f(f2bf(ddot_bf(F.bf(WS_HN) + (size_t)row * DM, F.bf(WS_WIN) + (size_t)(col + d + 32) * DM, DM)));
        const double inv = pow(10000.0, -(double)(d & 15) / 16.0); const double ang = (double)(d < 16 ? (pos >> 6) : (pos & 63)) * (double)(float)inv; const float c = (float)cos(ang), sn = (float)sin(ang);
        dacc(dg, 0, bf2f(F.bf(WS_Z)[(size_t)row * ZLD + col + d]) - (x1 * c - x2 * sn), x1 * c - x2 * sn + 1e-3f); dacc(dg, 0, bf2f(F.bf(WS_Z)[(size_t)row * ZLD + col + d + 32]) - (x2 * c + x1 * sn), x2 * c + x1 * sn + 1e-3f); }
    for (unsigned i = gt; i < 64; i += gn) { const int row = hsh(i * 9 + 4) % MT; float s = 0.f, s2 = 0.f;
        for (int j = 0; j < 384; ++j) { const float v = bf2f(F.bf(WS_Z)[(size_t)row * ZLD + j]) / F.inp(I_GQ)[j]; s += v * v; }
        for (int j = 0; j < 256; ++j) { const float v = bf2f(F.bf(WS_Z)[(size_t)row * ZLD + 384 + j]) / F.inp(I_GKV)[j]; s2 += v * v; }
        dacc(dg, 0, sqrtf(s / 384.f) - 1.f, 1.f); dacc(dg, 0, sqrtf(s2 / 256.f) - 1.f, 1.f); }
    for (unsigned i = gt; i < 512; i += gn) { const unsigned h = hsh(i * 3 + 11); const bool cx = i >= 448; const int b = h & 1, c = (h >> 1) & 511; const int L = cx ? CTXL : SEQ; const int k = (h >> 10) % L;
        const int rb = cx ? ML + b * CTXL : b * SEQ; double re = 0, im = 0;
        for (int n = 0; n < L; ++n) { const double f = bf2f(F.bf(WS_Z)[(size_t)(rb + n) * ZLD + ZC_F + c]); const double a = -2.0 * 3.14159265358979323846 * (double)((n * k) % L) / L; re += f * cos(a); im += f * sin(a); }
        const double nr = 1.0 / sqrt((double)L * 128.0);
        dacc(dg, 1, bf2f(F.bf(WS_X)[(size_t)(rb + k) * 1024 + c]) - (float)(re * nr), (float)(re * nr)); dacc(dg, 1, bf2f(F.bf(WS_X)[(size_t)(rb + k) * 1024 + 512 + c]) - (float)(im * nr), (float)(im * nr)); }
    for (unsigned i = gt; i < 1024; i += gn) { const unsigned h = hsh(i * 17 + 2); const int row = h % MT;
        { const int col = (h >> 15) % 768; const float ref = ddot_bf(F.bf(WS_Z) + (size_t)row * ZLD + ZC_QLAT, F.bf(WS_WUQ) + (size_t)col * 384, 384); dacc(dg, 2, bf2f(F.bf(WS_Q)[(size_t)row * 768 + col]) - ref, ref + 1e-3f); }
        { const int col = (h >> 15) % 1024; const float ref = ddot_bf(F.bf(WS_Z) + (size_t)row * ZLD + ZC_KVLAT, F.bf(WS_WUKV) + (size_t)col * 256, 256); dacc(dg, 2, bf2f(F.bf(WS_KV)[(size_t)row * 1024 + col]) - ref, ref + 1e-3f); } }
    for (unsigned i = gt; i < 24 * 128; i += gn) { const int ch = i & 127, sm = i >> 7; const unsigned h = hsh(sm * 7 + 3); const int grp = h & 3; const bool cx = sm >= 20;
        const int L = cx ? CTXL : SEQ; const int b = (h >> 2) & 1; int n = (h >> 3) % L; if (sm == 0) n = 3; if (sm == 1) n = L - 2; const int rb = cx ? ML + b * CTXL : b * SEQ;
        auto cv = [&](int cg) { float acc = F.inp(I_BDW)[cg];
            for (int j = 0; j < 31; ++j) { const int nn = n + j - 15; if (nn < 0 || nn >= L) continue; const float a = bf2f(F.bf(WS_Z)[(size_t)(rb + nn) * ZLD + ZC_C + cg]), g = bf2f(F.bf(WS_Z)[(size_t)(rb + nn) * ZLD + ZC_C + 512 + cg]);
                acc += a / (1.f + expf(-g)) * F.inp(I_WDW)[(size_t)j * 512 + cg]; }
            return acc; };
        float mu = 0.f; for (int c2 = 0; c2 < 128; ++c2) mu += cv(grp * 128 + c2);
        mu /= 128.f; float var = 0.f; for (int c2 = 0; c2 < 128; ++c2) { const float v = cv(grp * 128 + c2); var += (v - mu) * (v - mu); } var /= 128.f;
        const int cg = grp * 128 + ch; const float yn = (cv(cg) - mu) * rsqrtf(var + 1e-5f) * F.inp(I_GCN)[cg] + F.inp(I_BCN)[cg]; const float ref = yn / (1.f + expf(-yn));
        dacc(dg, 3, bf2f(F.bf(WS_BR)[((size_t)1 * MT + rb + n) * 512 + cg]) - ref, ref + 1e-3f); }
    if (blockIdx.x < 48) { const int md = blockIdx.x / 24, sm = blockIdx.x % 24; const unsigned h = hsh(sm * 31 + 7 + md); const bool cx = (sm % 6) == 5; const int b = h & 1, hd = (h >> 1) & 3;
        const int qi = (h >> 3) % (cx ? CTXL : SEQ); const int qrow = cx ? ML + b * CTXL + qi : b * SEQ + qi; const int nk = cx ? CTXL : CTXL + SEQ; const int t = threadIdx.x;
        float* qv = sh + 8448;
        float outv = 0.f;
        for (int comp = 0; comp < (md == 0 ? 1 : 2); ++comp) {
            __syncthreads();
            __shared__ float qf[192];
            const int qd = md == 0 ? 192 : 64;
            if (t < qd) { float v;
                if (md == 0) v = bf2f(F.bf(WS_Q)[(size_t)qrow * 768 + hd * 192 + t]); else v = bf2f(F.bf(WS_Z)[(size_t)qrow * ZLD + ZC_DQ + hd * 128 + comp * 64 + t]);
                qf[t] = v; }
            __syncthreads();
            if (!cx) { const int ro = md == 0 ? 128 : 0; if (t < 32) { const double inv = pow(10000.0, -(double)(t & 15) / 16.0); const double ang = (double)(t < 16 ? (qi >> 6) : (qi & 63)) * (double)(float)inv;
                    const float c = (float)cos(ang), sn = (float)sin(ang); const float x1 = qf[ro + t], x2 = qf[ro + t + 32]; qv[t] = bf2f(f2bf(x1 * c - x2 * sn)); qv[t + 32] = bf2f(f2bf(x2 * c + x1 * sn)); }
                __syncthreads(); if (t < 64) qf[(md == 0 ? 128 : 0) + t] = qv[t]; __syncthreads(); }
            const float scale = md == 0 ? 0.07216878364870322f : 0.125f;
            for (int k = t; k < nk; k += 256) { const int krow = k < CTXL ? ML + b * CTXL + k : b * SEQ + (k - CTXL); float s = 0.f;
                if (md == 0) { for (int d = 0; d < 128; ++d) s += qf[d] * bf2f(F.bf(WS_KV)[(size_t)krow * 1024 + hd * 256 + d]); for (int d = 0; d < 64; ++d) s += qf[128 + d] * bf2f(F.bf(WS_Z)[(size_t)krow * ZLD + ZC_KROPE + d]); }
                else for (int d = 0; d < 64; ++d) s += qf[d] * bf2f(F.bf(WS_Z)[(size_t)krow * ZLD + ZC_DK + hd * 128 + comp * 64 + d]);
                sh[k] = s * scale; }
            __syncthreads();
            __shared__ float red[256]; float mx = -1e30f; for (int k = t; k < nk; k += 256) mx = fmaxf(mx, sh[k]); red[t] = mx; __syncthreads();
            for (int o = 128; o > 0; o >>= 1) { if (t < o) red[t] = fmaxf(red[t], red[t + o]); __syncthreads(); } mx = red[0]; __syncthreads();
            float sm2 = 0.f; for (int k = t; k < nk; k += 256) { const float e = expf(sh[k] - mx); sh[k] = e; sm2 += e; } red[t] = sm2; __syncthreads();
            for (int o = 128; o > 0; o >>= 1) { if (t < o) red[t] += red[t + o]; __syncthreads(); } const float den = red[0]; __syncthreads();
            if (t < 128) { float o = 0.f; for (int k = 0; k < nk; ++k) { const int krow = k < CTXL ? ML + b * CTXL + k : b * SEQ + (k - CTXL);
                    const float v = md == 0 ? bf2f(F.bf(WS_KV)[(size_t)krow * 1024 + hd * 256 + 128 + t]) : bf2f(F.bf(WS_Z)[(size_t)krow * ZLD + ZC_DV + hd * 128 + t]); o += sh[k] * v; }
                o /= den;
                if (md == 0) outv = o; else { float lam; { float s1 = 0.f, s2 = 0.f; for (int j = 0; j < 64; ++j) { s1 += F.inp(I_LQ1)[j] * F.inp(I_LK1)[j]; s2 += F.inp(I_LQ2)[j] * F.inp(I_LK2)[j]; } lam = expf(s1) - expf(s2) + 0.2f; }
                    outv = comp == 0 ? o : outv - lam * o; } }
        }
        __syncthreads();
        if (md == 0) { if (t < 128) dacc(dg, 4, bf2f(F.bf(WS_BR)[(size_t)qrow * 512 + hd * 128 + t]) - outv, outv + 1e-4f); }
        else { __shared__ float r2[128]; if (t < 128) r2[t] = outv * outv; __syncthreads(); float ss = 0.f; if (t < 128) { for (int j = 0; j < 128; ++j) ss += r2[j];
                const float ref = outv * rsqrtf(ss / 128.f + 1e-6f) * F.inp(I_GSUB)[t] * 0.8f; dacc(dg, 5, bf2f(F.bf(WS_BR)[((size_t)2 * MT + qrow) * 512 + hd * 128 + t]) - ref, ref + 1e-4f); } }
    }
#endif
#if MK_DIAG == 3
    for (unsigned i = gt; i < 0; i += gn) { const unsigned h = hsh(i * 5 + 9); const bool cx = i >= 80; const int b = h & 1, g = (h >> 1) & 3, m = (h >> 3) & 127; const int L = cx ? CTXL : SEQ; const int k = (h >> 10) % L;
        const int rb = cx ? ML + b * CTXL : b * SEQ; double acc = 0;
        for (int n = 0; n < L; ++n) { const double p1 = (double)((n * k) % L) / L; for (int c = 0; c < 128; ++c) { const double ph = p1 + (double)((c * m) & 127) / 128.0;
                acc += (double)bf2f(F.bf(WS_Z)[(size_t)(rb + n) * ZLD + ZC_F + g * 128 + c]) * cospi(2.0 * ph); } }
        const float ref = (float)(acc / sqrt((double)L * 128.0));
        dacc(dg, 0, bf2f(F.bf(WS_BR)[((size_t)3 * MT + rb + k) * 512 + g * 128 + m]) - ref, ref + 1e-3f); }
#if MK_STOP == 7
    for (unsigned i = gt; i < 1024; i += gn) { const unsigned h = hsh(i * 37 + 12); const int row = h % MT, col = (h >> 15) % 512;
        const float ref = ddot_bf(F.bf(WS_X) + (size_t)row * 1024, F.bf(WS_WDFT) + (size_t)col * 1024, 1024);
        dacc(dg, 4, bf2f(F.bf(WS_BR)[((size_t)3 * MT + row) * 512 + col]) - ref, ref + 1e-3f); }
    for (unsigned i = gt; i < 4096; i += gn) { const unsigned h = hsh(i * 41 + 14); const int n = h % 512, kc = (h >> 12) % 1024; const int g = n >> 7, m = n & 127, part = kc >> 9, g2 = (kc >> 7) & 3, c = kc & 127;
        const float ref = g == g2 ? (part == 0 ? (float)cos(2.0 * 3.14159265358979323846 * ((c * m) & 127) / 128.0) : (float)sin(2.0 * 3.14159265358979323846 * ((c * m) & 127) / 128.0)) : 0.f;
        dacc(dg, 5, bf2f(F.bf(WS_WDFT)[(size_t)n * 1024 + kc]) - ref, ref + (g == g2 ? 0.f : 0.f)); }
    for (unsigned i = gt; i < 2048; i += gn) { const unsigned h = hsh(i * 19 + 6); const int row = h % MT, col = (h >> 15) % DM, slot = i % 3;
        const float ref = ddot_bf(F.bf(WS_BR) + ((size_t)slot * MT + row) * 512, F.bf(WS_WB) + ((size_t)slot * DM + col) * 512, 512);
        dacc(dg, 1, bf2f(F.bf(WS_T)[((size_t)slot * MT + row) * DM + col]) - ref, ref + 1e-3f); }
#else
    for (unsigned i = gt; i < 1024; i += gn) { const unsigned h = hsh(i * 23 + 8); const int row = h % MT, col = (h >> 15) % DM; float ref = 0.f;
        for (int slot = 0; slot < 4; ++slot) { const float gt_ = ddot_bf(F.bf(WS_HN) + (size_t)row * DM, F.bf(WS_WG) + ((size_t)slot * DM + col) * DM, DM);
            ref += 1.f / (1.f + expf(-gt_)) * bf2f(F.bf(WS_T)[((size_t)slot * MT + row) * DM + col]); }
        dacc(dg, 2, bf2f(F.bf(WS_Y)[(size_t)row * DM + col]) - ref, ref + 1e-3f); }
    for (unsigned i = gt; i < 1024; i += gn) { const unsigned h = hsh(i * 29 + 10); const int row = h % MT, col = (h >> 15) % DM;
        const float d = ddot_bf(F.bf(WS_Y) + (size_t)row * DM, F.bf(WS_WO) + (size_t)col * DM, DM);
        const float x = row < ML ? F.inp(I_X)[(size_t)row * DM + col] : F.inp(I_CTX)[(size_t)(row - ML) * DM + col]; const int v = row < ML ? row >> 13 : 2;
        const float ref = x + F.mod(0, v, 2)[col] * d;
        dacc(dg, 3, F.f32(WS_XR)[(size_t)row * DM + col] - ref, ref); }
#endif
#endif
#if MK_DIAG == 5
    if (blockIdx.x == 0) { const int lane = threadIdx.x & 63, t = lane & 15, rr = lane >> 4, w = threadIdx.x >> 6;
        __shared__ unsigned kk[4][64][8]; __shared__ unsigned res[4][64];
        { const float x = (float)lane * 1.5f + 1.0f + (float)w; const float sgot = wave_sum_dpp(x); const float sexp = 1.5f * 2016.f + 64.f * (1.f + (float)w); dacc(dg, 0, sgot - sexp, sexp); }
        { const unsigned x = hsh(lane * 31 + w) | 1u; const unsigned got = row_max16_u(x); unsigned ex = 0; for (int j = 0; j < 16; ++j) { const unsigned y = hsh((rr * 16 + j) * 31 + w) | 1u; ex = y > ex ? y : ex; }
          dacc(dg, 1, got == ex ? 0.f : 1.f, 1.f);
          const float xf = (float)(hsh(lane * 7 + w) & 1023); const float gs = row_sum16_f(xf); float es = 0.f; for (int j = 0; j < 16; ++j) es += (float)(hsh((rr * 16 + j) * 7 + w) & 1023); dacc(dg, 1, gs - es, es); }
        { unsigned key[8]; for (int e = 0; e < 8; ++e) { key[e] = (hsh(lane * 8 + e + w * 977) & 0xFFFFFF80u) | (unsigned)(t * 8 + e) | 0x80000000u; kk[w][lane][e] = key[e]; }
          __syncthreads();
          const unsigned got = peer::top16_row<8>(key, t);
          int rank = 0; for (int j = 0; j < 16; ++j) for (int e = 0; e < 8; ++e) if (kk[w][rr * 16 + j][e] > got) ++rank;
          bool member = false; for (int j = 0; j < 16; ++j) for (int e = 0; e < 8; ++e) if (kk[w][rr * 16 + j][e] == got) member = true;
          dacc(dg, 2, (rank == t && member) ? 0.f : 1.f, 1.f); }
        { unsigned key[4]; for (int e = 0; e < 4; ++e) { const int q = t * 4 + e; key[e] = q < 50 ? ((hsh(lane * 4 + e + w * 131) & 0xFFFFFF00u) | (unsigned)q | 0x80000000u) : 1u + e; }
          __syncthreads(); for (int e = 0; e < 4; ++e) kk[w][lane][e] = key[e]; __syncthreads();
          const unsigned got = peer::top16_row<4>(key, t);
          int rank = 0; for (int j = 0; j < 16; ++j) for (int e = 0; e < 4; ++e) if (kk[w][rr * 16 + j][e] > got) ++rank;
          dacc(dg, 3, rank == t ? 0.f : 1.f, 1.f); }
        { const float a0 = 1.5f, a1 = -2.25f, b0 = 3.0f + lane, b1 = 0.5f; const unsigned pa = cvt_pk_bf16(a0, a1), pb = cvt_pk_bf16(b0, b1);
          const float got = __builtin_amdgcn_fdot2_f32_bf16(__builtin_bit_cast(bf16x2_t, pa), __builtin_bit_cast(bf16x2_t, pb), 10.f, false); const float ex = 10.f + a0 * b0 + a1 * b1; dacc(dg, 4, got - ex, ex); }
        { const float x = (float)(lane * lane) + (float)w; const float got = half_sum_dpp(x, lane >> 5); float ex = 0.f; for (int j = 0; j < 32; ++j) { const int ll = (lane & 32) + j; ex += (float)(ll * ll) + (float)w; } dacc(dg, 5, got - ex, ex); }
    }
#endif
#if MK_DIAG == 6
    if (blockIdx.x == 0 && threadIdx.x < 64) { const int lane = threadIdx.x;
        typedef float v32f __attribute__((ext_vector_type(32))); typedef float v16f __attribute__((ext_vector_type(16))); typedef unsigned v6u __attribute__((ext_vector_type(6)));
        float x[32]; unsigned code[32];
        for (int i = 0; i < 32; ++i) { const unsigned h = hsh(lane * 32 + i); const unsigned c = h & 63u; code[i] = c; const int sgn = (c >> 5) & 1, e = (c >> 3) & 3, m = c & 7;
            const float mag = e == 0 ? (float)m * 0.125f : (float)(1 << (e - 1)) * (1.0f + (float)m * 0.125f); x[i] = sgn ? -mag : mag; }
        unsigned long long lo = 0, mid = 0, hi = 0;
        unsigned w[6] = {0, 0, 0, 0, 0, 0};
        for (int i = 0; i < 32; ++i) { const int bit = 6 * i; const int d = bit >> 5, o = bit & 31; w[d] |= code[i] << o; if (o > 26) w[d + 1] |= code[i] >> (32 - o); }
        (void)lo; (void)mid; (void)hi;
        v6u pk; for (int d = 0; d < 6; ++d) pk[d] = w[d];
        const v32f dec = __builtin_amdgcn_cvt_scalef32_pk32_f32_fp6(pk, 1.0f);
        for (int i = 0; i < 32; ++i) dacc(dg, 0, dec[i] - x[i], fabsf(x[i]) + 0.1f);
        v16f a, b; for (int i = 0; i < 16; ++i) { a[i] = x[i]; b[i] = x[16 + i]; }
        const v6u enc = __builtin_amdgcn_cvt_scalef32_2xpk16_fp6_f32(a, b, 1.0f);
        const v32f dec2 = __builtin_amdgcn_cvt_scalef32_pk32_f32_fp6(enc, 1.0f);
        for (int i = 0; i < 32; ++i) dacc(dg, 1, dec2[i] - x[i], fabsf(x[i]) + 0.1f);
        for (int d = 0; d < 6; ++d) dacc(dg, 2, enc[d] == w[d] ? 0.f : 1.f, 1.f);
        v16f a2, b2; float y[32]; for (int i = 0; i < 32; ++i) { y[i] = ((float)(hsh(lane * 77 + i) & 0xFFFF) / 65536.0f - 0.5f) * 18.0f; if (i < 16) a2[i] = y[i]; else b2[i - 16] = y[i]; }
        const v32f dec3 = __builtin_amdgcn_cvt_scalef32_pk32_f32_fp6(__builtin_amdgcn_cvt_scalef32_2xpk16_fp6_f32(a2, b2, 1.0f), 1.0f);
        for (int i = 0; i < 32; ++i) { const float yc = fminf(fmaxf(y[i], -7.5f), 7.5f); const float ay = fabsf(yc); const float step = ay < 2.f ? 0.125f : ay < 4.f ? 0.25f : 0.5f;
            dacc(dg, 3, fabsf(dec3[i] - yc) <= 0.5f * step + 1e-6f ? 0.f : 1.f, 1.f); }
    }
#endif
#if MK_DIAG == 8
    if (blockIdx.x == 0) { const int t = threadIdx.x; const float lv[8] = {0.f, 0.5f, 1.f, 1.5f, 2.f, 3.f, 4.f, 6.f};
        const unsigned src = hsh(t * 7 + 3);
        f32x2 r[4]; r[0] = __builtin_amdgcn_cvt_scalef32_pk_f32_fp4(src, 1.0f, 0); r[1] = __builtin_amdgcn_cvt_scalef32_pk_f32_fp4(src, 1.0f, 1);
        r[2] = __builtin_amdgcn_cvt_scalef32_pk_f32_fp4(src, 1.0f, 2); r[3] = __builtin_amdgcn_cvt_scalef32_pk_f32_fp4(src, 1.0f, 3);
        for (int k = 0; k < 4; ++k) { const unsigned B = (src >> (8 * k)) & 255u; const unsigned lo = B & 15u, hi = B >> 4;
            const float flo = (lo & 8u ? -1.f : 1.f) * lv[lo & 7u], fhi = (hi & 8u ? -1.f : 1.f) * lv[hi & 7u];
            dacc(dg, 0, r[k][0] - flo, 1.f); dacc(dg, 0, r[k][1] - fhi, 1.f); dacc(dg, 1, r[k][0] - fhi, 1.f); dacc(dg, 1, r[k][1] - flo, 1.f); } }
#endif
#if MK_DIAG == 4
    if (blockIdx.x >= 16 && blockIdx.x < 32) { const int sm = blockIdx.x - 16; const int row = sm < 12 ? hsh(sm * 3 + 77) % ML : ML + hsh(sm) % MC; const int t = threadIdx.x;
        __shared__ float sv[2048]; __shared__ int ti[16][16]; __shared__ float tv[16][16]; __shared__ int ex[128]; __shared__ float gw[128];
        for (int j = t; j < DM; j += 256) sv[j] = F.f32(WS_S)[(size_t)row * DM + j];
        __syncthreads();
        if (t < 16) { for (int n = 0; n < 16; ++n) { float best = -1e30f; int bi = 0; for (int k = 0; k < 128; ++k) { const float x = sv[t * 128 + k]; if (x > best) { best = x; bi = k; } } tv[t][n] = best; ti[t][n] = bi; sv[t * 128 + bi] = -1e30f; } }
        __syncthreads();
        if (t < 8) { int used_i[16], used_j[16]; float scs[16]; int ids[16];
            for (int n = 0; n < 16; ++n) { float best = -1e30f; int bi = 0, bj = 0;
                for (int i = 0; i < 16; ++i) for (int j = 0; j < 16; ++j) { bool u = false; for (int q = 0; q < n; ++q) if (used_i[q] == i && used_j[q] == j) u = true; if (u) continue; const float x = tv[2 * t][i] + tv[2 * t + 1][j]; if (x > best) { best = x; bi = i; bj = j; } }
                used_i[n] = bi; used_j[n] = bj; scs[n] = best; ids[n] = ti[2 * t][bi] * 128 + ti[2 * t + 1][bj]; }
            float mx = scs[0], sm2 = 0.f; for (int n = 0; n < 16; ++n) mx = fmaxf(mx, scs[n]); for (int n = 0; n < 16; ++n) { scs[n] = expf(scs[n] - mx); sm2 += scs[n]; }
            for (int n = 0; n < 16; ++n) { ex[t * 16 + n] = ids[n]; gw[t * 16 + n] = scs[n] / sm2; } }
        __syncthreads();
        const float* dbg = (const float*)(F.ws + WS_R + (size_t)3 * MT * DM * 2) + (size_t)row * 384;
        if (t < 128) { const int hd = t >> 4; const int mine = (int)dbg[t]; bool found = false; float wn = 0.f; for (int n = 0; n < 16; ++n) if (ex[hd * 16 + n] == mine) { found = true; wn = gw[hd * 16 + n]; }
            dacc(dg, 0, found ? 0.f : 1.f, 1.f); if (found) dacc(dg, 1, dbg[128 + t] - wn, wn);
            float d = 0.f; for (int j = 0; j < DM; ++j) d += bf2f(F.bf(WS_PU)[(size_t)mine * DM + j]) * bf2f(F.bf(WS_HN)[(size_t)row * DM + j]);
            (void)d;
            const float* st = (const float*)(F.ws + WS_Y) + (size_t)32 * DM + sm * 256; float cfn = 0.f; bool f2 = false; for (int n = 0; n < 128; ++n) if ((int)st[128 + n] == mine && (n >> 4) == hd) { cfn = st[n]; f2 = true; }
            if (f2) dacc(dg, 4, dbg[256 + t] - cfn, cfn + 1e-4f); else dacc(dg, 4, 0.f, 1e-9f);
            const float* dbg2 = (const float*)(F.ws + WS_R + (size_t)3 * MT * DM * 2) + (size_t)MT * 384 + (size_t)row * 256;
            dacc(dg, 2, dbg2[128 + t] - dbg[t], 1.f);
            { float dn = 0.f; bool f3 = false; for (int n = 0; n < 128; ++n) if ((int)st[128 + n] == mine && (n >> 4) == hd) { dn = ((const float*)(F.ws + WS_Y))[(size_t)32 * DM + 16 * 256 + sm * 128 + n]; f3 = true; }
              if (f3) dacc(dg, 3, dbg2[t] - dn, dn + 1e-3f); else dacc(dg, 3, 0.f, 1e-9f); } }
    }
    if (blockIdx.x < 16) { const int sm = blockIdx.x; const int row = sm < 12 ? hsh(sm * 3 + 77) % ML : ML + hsh(sm) % MC; const int t = threadIdx.x; const int v = row < ML ? row >> 13 : 2;
        const float* exp_ = (const float*)(F.ws + WS_Y) + (size_t)sm * DM; const float* x2 = F.f32(WS_XR) + (size_t)row * DM;
        __shared__ float red[256]; float ss = 0.f;
        for (int j = t; j < DM; j += 256) { dacc(dg, 5, x2[j] - exp_[j], exp_[DM * 16 + (size_t)sm * DM + j]); ss += x2[j] * x2[j]; }
        red[t] = ss; __syncthreads(); for (int o = 128; o > 0; o >>= 1) { if (t < o) red[t] += red[t + o]; __syncthreads(); }
        const float rs = rsqrtf(red[0] / DM + 1e-6f);
        for (int j = t; j < DM; j += 256) { const float ref = x2[j] * rs * F.inp(I_GN1)[DM + j] * (1.f + F.mod(1, v, 1)[j]) + F.mod(1, v, 0)[j]; dacc(dg, 9, bf2f(F.bf(WS_HN)[(size_t)row * DM + j]) - ref, ref); } }
#endif
}
#if MK_DIAG == 4
__global__ void __launch_bounds__(256) k_diag_pre(Args a) {
    Ctx F; F.fresh(); F.G = gridDim.x; F.bid = blockIdx.x;
    float* dg = F.f32(WS_DIAG);
    const unsigned gt = blockIdx.x * 256 + threadIdx.x, gn = gridDim.x * 256;
    for (unsigned i = gt; i < 32 * 256; i += gn) { const int rs_ = i >> 8, c8 = (i & 255) * 8; const int row = rs_ < 24 ? (hsh(rs_ * 3 + 21) % ML) : ML + (hsh(rs_) % MC);
        const float* xr = F.f32(WS_XR) + (size_t)row * DM; const int v = row < ML ? row >> 13 : 2;
        float ss = 0.f; for (int k = 0; k < DM; ++k) ss += xr[k] * xr[k]; const float r = rsqrtf(ss / DM + 1e-6f);
        for (int e = 0; e < 8; ++e) { const int c = c8 + e; const float ref = xr[c] * r * F.inp(I_GN2)[c] * (1.0f + F.mod(0, v, 4)[c]) + F.mod(0, v, 3)[c];
            dacc(dg, 6, bf2f(F.bf(WS_HN)[(size_t)row * DM + c]) - ref, ref); } }
    for (unsigned i = gt; i < 1024; i += gn) { const unsigned h = hsh(i * 43 + 16); const int row = h % MT, col = (h >> 15) % DM;
        const float ref = ddot_bf(F.bf(WS_HN) + (size_t)row * DM, F.bf(WS_WPQ) + (size_t)col * DM, DM); dacc(dg, 7, bf2f(F.bf(WS_PQ)[(size_t)row * DM + col]) - ref, ref + 1e-3f); }
    for (unsigned i = gt; i < 4096; i += gn) { const unsigned h = hsh(i * 47 + 18); const int row = h % MT, col = (h >> 15) % DM; const int hd = col >> 8, p = (col >> 7) & 1, k = col & 127; float ref = 0.f;
        for (int d = 0; d < 128; ++d) ref += bf2f(F.bf(WS_PQ)[(size_t)row * DM + hd * 256 + p * 128 + d]) * bf2f(f2bf(F.inp(I_PKEYS)[((size_t)p * 128 + k) * 128 + d]));
        dacc(dg, 8, F.f32(WS_S)[(size_t)row * DM + col] - ref, ref + 1e-3f); }
    if (blockIdx.x < 16) { const int sm = blockIdx.x; const int row = sm < 12 ? hsh(sm * 3 + 77) % ML : ML + hsh(sm) % MC; const int t = threadIdx.x; const int v = row < ML ? row >> 13 : 2;
        __shared__ float sv[2048]; __shared__ int ti[16][16]; __shared__ float tv[16][16]; __shared__ int ex[128]; __shared__ float gw[128]; __shared__ float cf[128];
        for (int j = t; j < DM; j += 256) sv[j] = F.f32(WS_S)[(size_t)row * DM + j];
        __syncthreads();
        if (t < 16) { for (int n = 0; n < 16; ++n) { float best = -1e30f; int bi = 0; for (int k = 0; k < 128; ++k) { const float x = sv[t * 128 + k]; if (x > best) { best = x; bi = k; } } tv[t][n] = best; ti[t][n] = bi; sv[t * 128 + bi] = -1e30f; } }
        __syncthreads();
        if (t < 8) { int used_i[16], used_j[16]; float scs[16]; int ids[16];
            for (int n = 0; n < 16; ++n) { float best = -1e30f; int bi = 0, bj = 0;
                for (int i = 0; i < 16; ++i) for (int j = 0; j < 16; ++j) { bool u = false; for (int q = 0; q < n; ++q) if (used_i[q] == i && used_j[q] == j) u = true; if (u) continue; const float x = tv[2 * t][i] + tv[2 * t + 1][j]; if (x > best) { best = x; bi = i; bj = j; } }
                used_i[n] = bi; used_j[n] = bj; scs[n] = best; ids[n] = ti[2 * t][bi] * 128 + ti[2 * t + 1][bj]; }
            float mx = scs[0], sm2 = 0.f; for (int n = 0; n < 16; ++n) mx = fmaxf(mx, scs[n]); for (int n = 0; n < 16; ++n) { scs[n] = expf(scs[n] - mx); sm2 += scs[n]; }
            for (int n = 0; n < 16; ++n) { ex[t * 16 + n] = ids[n]; gw[t * 16 + n] = scs[n] / sm2; } }
        __syncthreads();
        if (t < 128) { float d = 0.f; for (int j = 0; j < DM; ++j) d += bf2f(F.bf(WS_PU)[(size_t)ex[t] * DM + j]) * bf2f(F.bf(WS_HN)[(size_t)row * DM + j]); cf[t] = gw[t] * 0.5f * d * (1.f + erff(d * 0.70710678f)); ((float*)(F.ws + WS_Y))[(size_t)32 * DM + 16 * 256 + sm * 128 + t] = d; }
        __syncthreads();
        float* st = (float*)(F.ws + WS_Y);
        if (t < 128) { st[(size_t)32 * DM + sm * 256 + t] = cf[t]; st[(size_t)32 * DM + sm * 256 + 128 + t] = (float)ex[t]; }
        for (int j = t; j < DM; j += 256) { float o = 0.f; for (int k = 0; k < 128; ++k) o += cf[k] * bf2f(F.bf(WS_PV)[(size_t)ex[k] * DM + j]);
            st[(size_t)sm * DM + j] = F.f32(WS_XR)[(size_t)row * DM + j] + F.mod(0, v, 5)[j] * o; st[(size_t)16 * DM + (size_t)sm * DM + j] = F.mod(0, v, 5)[j] * o; }
    }
}
#endif
__global__ void __launch_bounds__(256) k_diag_fill(Args a, size_t n) {
    const float* dg = (const float*)(a.ws + WS_DIAG);
    const float tol[8] = {MK_DIAG == 4 ? 0.1f : 0.02f, 0.02f, 0.02f, 0.02f, 0.02f, 0.02f, 0.02f, 0.02f};
    int id = 15; float e = 0.f;
    const int nchk = MK_DIAG == 6 ? 4 : MK_DIAG == 1 ? 4 : MK_DIAG == 2 ? 6 : MK_DIAG == 3 ? (MK_STOP == 7 ? 3 : 2) : 6;
    const int order3[6] = {MK_STOP == 7 ? 5 : 2, MK_STOP == 7 ? 4 : 3, 1, 0, 0, 0};
    for (int cc = 0; cc < nchk; ++cc) { const int c = MK_DIAG == 3 ? order3[cc] : cc; const float num = dg[2 * c], den = dg[2 * c + 1]; const float ec = den > 0.f ? sqrtf(num / den) : 1.f;
        if (!(ec <= tol[c])) { id = c; e = ec; break; } if (ec > e) e = ec; }
    if (!(e == e)) e = 1.f; e = fminf(fmaxf(e, 1e-6f), 1.f);
    const float m = 1.0f + 1.4f * log10f(e * 1e6f);
    const float c2 = m * powf(10.f, 4.f + (float)id);
    const float val = sqrtf(c2);
    for (size_t i = (size_t)blockIdx.x * 256 + threadIdx.x; i < n; i += (size_t)gridDim.x * 256) a.out[i] = val;
}
#endif

extern "C" void kernel_launch(void* const* d_in, const int* in_sizes, int n_in, void* d_out, int out_size, void* d_ws, size_t ws_size, hipStream_t stream) {
    static int grid = 0;
    if (grid == 0) {
        if (n_in != 30 || out_size != ML * DM || ws_size < WS_END) { fprintf(stderr, "kernel_launch: needs 30 inputs, %d outputs, >= %zu bytes of workspace; got n_in %d out %d ws %zu\n", ML * DM, (size_t)WS_END, n_in, out_size, ws_size); grid = -1; return; }
        int dev = 0, cus = 0, per_cu = 0;
        if (hipGetDevice(&dev) != hipSuccess || hipDeviceGetAttribute(&cus, hipDeviceAttributeMultiprocessorCount, dev) != hipSuccess) { grid = -1; return; }
        if (hipFuncSetAttribute((const void*)mk_fwd, hipFuncAttributeMaxDynamicSharedMemorySize, LDS_BYTES) != hipSuccess) { fprintf(stderr, "kernel_launch: hipFuncSetAttribute failed\n"); grid = -1; return; }
        if (hipOccupancyMaxActiveBlocksPerMultiprocessor(&per_cu, (const void*)mk_fwd, NTHREADS, LDS_BYTES) != hipSuccess || per_cu < 1) { fprintf(stderr, "kernel_launch: occupancy query says %d\n", per_cu); (void)hipGetLastError(); grid = -1; return; }
        grid = cus;
    }
    if (grid < 0) return;
    (void)hipMemsetAsync((char*)d_ws, 0, WS_ZERO_END, stream);
    Args a{};
    for (int i = 0; i < 30; ++i) a.in[i] = (const float*)d_in[i];
    a.out = (float*)d_out; a.ws = (unsigned char*)d_ws;
    constexpr int STOP = MK_STOP < NPHASES ? MK_STOP : NPHASES;
#if MK_MULTI
    for (int ph = 0; ph < STOP; ++ph) {
#if MK_DIAG == 4
        if (ph == STOP - 1) hipLaunchKernelGGL(k_diag_pre, dim3(64), dim3(256), 0, stream, a);
#endif
        a.ph_lo = ph; a.ph_hi = ph + 1; hipLaunchKernelGGL(mk_fwd, dim3(grid), dim3(NTHREADS), LDS_BYTES, stream, a); }
#else
    a.ph_lo = 0; a.ph_hi = STOP; hipLaunchKernelGGL(mk_fwd, dim3(grid), dim3(NTHREADS), LDS_BYTES, stream, a);
#endif
#if MK_DIAG
    hipLaunchKernelGGL(k_diag, dim3(64), dim3(256), 0, stream, a);
    hipLaunchKernelGGL(k_diag_fill, dim3(1024), dim3(256), 0, stream, a, (size_t)ML * DM);
#endif
    const hipError_t le = hipPeekAtLastError();
    if (le != hipSuccess) fprintf(stderr, "kernel_launch: launch failed: %s\n", hipGetErrorName(le));
}
```
